# Optimizing an MI355X kernel written in HIP

```python
import math
import jax, jax.numpy as jnp
from jax import lax
import numpy as np

D_MODEL = 1024
BATCH = 16
SEQ = 2048
DEPTH = 2

GRID_W = 64
N_GROUPS = 4
GROUP_W = D_MODEL // N_GROUPS
MIX_W = N_GROUPS * GROUP_W
SSD_HEAD_DIM = 64
SSD_HEADS = GROUP_W // SSD_HEAD_DIM
SSD_BC_GROUPS = 2
SSD_STATE = 128
SSD_CONV = 3
SSD_CHUNK = 128
SSD_XBC = GROUP_W + 2 * SSD_BC_GROUPS * SSD_STATE
SSD_IN = GROUP_W + SSD_XBC + 2 * SSD_HEADS
NA_HEAD_DIM = 64
NA_HEADS = GROUP_W // NA_HEAD_DIM
NA_KH = 8
NA_KW = 16
NA_QB = 16
NA_KSPAN = 32
NA_IN = 3 * GROUP_W
ML_HEAD_DIM = 64
ML_HEADS = GROUP_W // ML_HEAD_DIM
ML_CHUNK = 128
ML_IN = 4 * GROUP_W + 4 * ML_HEADS
HY_CH = GROUP_W
HY_ORDER = 2
HY_CONV = 3
HY_EMB = 33
HY_FFN = 64
HY_SHORT_DECAY_FRAC = 0.3
HY_LONG_DECAY_FRAC = 1.5
HY_DECAY_TARGET = 1e-2
HY_IN = 3 * HY_CH
OFF_NA = SSD_IN
OFF_ML = OFF_NA + NA_IN
OFF_HY = OFF_ML + ML_IN
P_IN = OFF_HY + HY_IN
FFN_HIDDEN = int(math.ceil(8 * D_MODEL / 3 / 256)) * 256
NORM_EPS = 1e-6

kernel_name = "hybrid_parallel_mixer_encoder"

F32 = jnp.float32


def rms_norm(x, gain=None):
    xf = x.astype(F32)
    y = xf * lax.rsqrt(jnp.mean(xf * xf, axis=-1, keepdims=True) + NORM_EPS)
    if gain is not None:
        y = y * gain.astype(F32)
    return y.astype(x.dtype)


def depthwise_conv(x, w, b):
    K = w.shape[0]
    y = lax.conv_general_dilated(x, w[:, None, :].astype(x.dtype), window_strides=(1,),
                                 padding=[(K // 2, K // 2)],
                                 dimension_numbers=('NWC', 'WIO', 'NWC'),
                                 feature_group_count=x.shape[-1])
    return y + b.astype(x.dtype)


def ssd_chunk_scan(x, dt, A, Bm, Cm):
    b, L, H, P = x.shape
    N = Bm.shape[-1]
    T = SSD_CHUNK
    nc = L // T
    x = x.reshape(b, nc, T, H, P)
    Bm = Bm.reshape(b, nc, T, H, N)
    Cm = Cm.reshape(b, nc, T, H, N)
    dt = dt.reshape(b, nc, T, H)
    a_cum = jnp.cumsum(jnp.moveaxis(dt * A, -1, 1), axis=-1)
    xdt = x * dt[..., None]
    lower = jnp.tril(jnp.ones((T, T), bool))
    decay = jnp.exp(jnp.where(lower, a_cum[..., :, None] - a_cum[..., None, :], -jnp.inf))
    scores = jnp.einsum('bcthn,bcshn->bhcts', Cm, Bm) * decay
    y_diag = jnp.einsum('bhcts,bcshp->bcthp', scores, xdt)
    decay_to_end = jnp.exp(a_cum[..., -1:] - a_cum)
    chunk_states = jnp.einsum('bcshn,bhcs,bcshp->bchpn', Bm, decay_to_end, xdt)
    chunk_decay = jnp.exp(a_cum[..., -1])

    def step(state, inp):
        s_c, d_c = inp
        return state * d_c[..., None, None] + s_c, state

    _, prev = lax.scan(step, jnp.zeros((b, H, P, N), x.dtype),
                       (jnp.moveaxis(chunk_states, 1, 0), jnp.moveaxis(chunk_decay, 2, 0)))
    prev = jnp.moveaxis(prev, 0, 1)
    y_off = jnp.einsum('bcthn,bchpn,bhct->bcthp', Cm, prev, jnp.exp(a_cum))
    return (y_diag + y_off).reshape(b, L, H, P)


def ssd_mixer(u, conv_w, conv_b, dt_bias, a_log, d_skip, norm_g):
    b, L, _ = u.shape
    z = u[..., :GROUP_W]
    xbc = jax.nn.silu(depthwise_conv(u[..., GROUP_W:GROUP_W + SSD_XBC], conv_w, conv_b)).astype(F32)
    dt_raw = u[..., GROUP_W + SSD_XBC:].astype(F32).reshape(b, L, 2, SSD_HEADS)
    xs = xbc[..., :GROUP_W].reshape(b, L, SSD_HEADS, SSD_HEAD_DIM)
    rep = SSD_HEADS // SSD_BC_GROUPS
    nb = SSD_BC_GROUPS * SSD_STATE
    Bm = jnp.repeat(xbc[..., GROUP_W:GROUP_W + nb].reshape(b, L, SSD_BC_GROUPS, SSD_STATE), rep, axis=2)
    Cm = jnp.repeat(xbc[..., GROUP_W + nb:].reshape(b, L, SSD_BC_GROUPS, SSD_STATE), rep, axis=2)
    dt = jax.nn.softplus(dt_raw + dt_bias.astype(F32))
    A = -jnp.exp(a_log.astype(F32))
    flip = lambda t: jnp.flip(t, axis=1)
    y_fwd = ssd_chunk_scan(xs, dt[:, :, 0], A[0], Bm, Cm)
    y_bwd = flip(ssd_chunk_scan(flip(xs), flip(dt[:, :, 1]), A[1], flip(Bm), flip(Cm)))
    y = y_fwd + y_bwd + d_skip.astype(F32)[:, None] * xs
    y = y.reshape(b, L, GROUP_W) * jax.nn.silu(z.astype(F32))
    return rms_norm(y, norm_g).astype(u.dtype)


def neighborhood_attention(u, rpb):
    b, L, _ = u.shape
    rows = L // GRID_W
    kh = min(NA_KH, rows)
    q, k, v = [t.reshape(b, rows, GRID_W, NA_HEADS, NA_HEAD_DIM).transpose(0, 3, 1, 2, 4)
               for t in jnp.split(u, 3, axis=-1)]
    r = jnp.arange(rows)
    row_idx = jnp.clip(r - kh // 2, 0, rows - kh)[:, None] + jnp.arange(kh)[None, :]
    dr_idx = row_idx - r[:, None] + (NA_KH - 1)
    scale = NA_HEAD_DIM ** -0.5

    def col_block(j0):
        ks0 = jnp.clip(j0 - NA_KW // 2, 0, GRID_W - NA_KSPAN)
        qb = lax.dynamic_slice_in_dim(q, j0, NA_QB, axis=3)
        kb = lax.dynamic_slice_in_dim(k, ks0, NA_KSPAN, axis=3)[:, :, row_idx]
        vb = lax.dynamic_slice_in_dim(v, ks0, NA_KSPAN, axis=3)[:, :, row_idx]
        j = j0 + jnp.arange(NA_QB)
        cs = jnp.clip(j - NA_KW // 2, 0, GRID_W - NA_KW)
        kc = ks0 + jnp.arange(NA_KSPAN)
        valid = (kc[None, :] >= cs[:, None]) & (kc[None, :] < cs[:, None] + NA_KW)
        dc_idx = jnp.clip(kc[None, :] - j[:, None] + (NA_KW - 1), 0, 2 * NA_KW - 2)
        bias = rpb[:, dr_idx[:, None, :, None], dc_idx[None, :, None, :]]
        s = jnp.einsum('bhrqd,bhrkud->bhrqku', qb, kb).astype(F32) * scale + bias.astype(F32)
        s = jnp.where(valid[:, None, :], s, -jnp.inf)
        p = jax.nn.softmax(s.reshape(s.shape[:4] + (kh * NA_KSPAN,)), axis=-1)
        p = p.reshape(s.shape).astype(u.dtype)
        return jnp.einsum('bhrqku,bhrkud->bhrqd', p, vb)

    o = lax.map(col_block, jnp.arange(0, GRID_W, NA_QB))
    return o.transpose(1, 3, 0, 4, 2, 5).reshape(b, L, GROUP_W)


def mlstm_scan(q, k, v, log_i, log_f):
    b, H, L, d = q.shape
    T = ML_CHUNK
    nc = L // T
    to_chunks = lambda t: jnp.moveaxis(t.reshape(t.shape[:2] + (nc, T) + t.shape[3:]), 2, 0)
    lower = jnp.tril(jnp.ones((T, T), bool))

    def step(carry, inp):
        C, n, m = carry
        qc, kc, vc, li, lf = inp
        bcum = jnp.cumsum(lf, axis=-1)
        g_inter = bcum + m[..., None]
        g_intra = jnp.where(lower, bcum[..., :, None] - bcum[..., None, :] + li[..., None, :], -jnp.inf)
        m_t = jnp.maximum(g_inter, jnp.max(g_intra, axis=-1))
        w_inter = jnp.exp(g_inter - m_t)
        s = jnp.einsum('bhtd,bhsd->bhts', qc, kc) * jnp.exp(g_intra - m_t[..., None])
        num = w_inter[..., None] * jnp.einsum('bhtd,bhde->bhte', qc, C) + jnp.einsum('bhts,bhse->bhte', s, vc)
        den = w_inter * jnp.einsum('bhtd,bhd->bht', qc, n) + jnp.sum(s, axis=-1)
        h = num / jnp.maximum(jnp.abs(den), jnp.exp(-m_t))[..., None]
        g_state = bcum[..., -1] + m
        g_src = bcum[..., -1:] - bcum + li
        m_new = jnp.maximum(g_state, jnp.max(g_src, axis=-1))
        w_src = jnp.exp(g_src - m_new[..., None])
        carry_decay = jnp.exp(g_state - m_new)
        C_new = carry_decay[..., None, None] * C + jnp.einsum('bhs,bhsd,bhse->bhde', w_src, kc, vc)
        n_new = carry_decay[..., None] * n + jnp.einsum('bhs,bhsd->bhd', w_src, kc)
        return (C_new, n_new, m_new), h

    init = (jnp.zeros((b, H, d, d), F32), jnp.zeros((b, H, d), F32), jnp.zeros((b, H), F32))
    _, h = lax.scan(step, init, (to_chunks(q), to_chunks(k), to_chunks(v), to_chunks(log_i), to_chunks(log_f)))
    return jnp.moveaxis(h, 0, 2).reshape(b, H, L, d)


def mlstm_mixer(u, i_bias, f_bias, norm_g):
    b, L, _ = u.shape
    heads = lambda t: t.astype(F32).reshape(b, L, ML_HEADS, ML_HEAD_DIM).transpose(0, 2, 1, 3)
    q = heads(u[..., :GROUP_W])
    k = heads(u[..., GROUP_W:2 * GROUP_W]) * (ML_HEAD_DIM ** -0.5)
    v = heads(u[..., 2 * GROUP_W:3 * GROUP_W])
    o = u[..., 3 * GROUP_W:4 * GROUP_W].astype(F32)
    gates = u[..., 4 * GROUP_W:].astype(F32).reshape(b, L, 2, 2, ML_HEADS).transpose(2, 3, 0, 4, 1)
    log_i = gates[0] + i_bias.astype(F32)[:, None, :, None]
    log_f = jax.nn.log_sigmoid(gates[1] + f_bias.astype(F32)[:, None, :, None])
    flip = lambda t: jnp.flip(t, axis=2)
    h_fwd = mlstm_scan(q, k, v, log_i[0], log_f[0])
    h_bwd = flip(mlstm_scan(flip(q), flip(k), flip(v), flip(log_i[1]), flip(log_f[1])))
    h = rms_norm(h_fwd + h_bwd, norm_g.reshape(ML_HEADS, 1, ML_HEAD_DIM))
    h = h.transpose(0, 2, 1, 3).reshape(b, L, GROUP_W)
    return (jax.nn.sigmoid(o) * h).astype(u.dtype)


def hyena_filters(L, w1, b1, w2, b2, w3, freq):
    t = jnp.linspace(0.0, 1.0, L, dtype=F32)[:, None]
    bands = (HY_EMB - 1) // 2
    f = jnp.linspace(1e-4, bands - 1, bands, dtype=F32)
    ang = (2.0 * math.pi) * (jnp.arange(L, dtype=F32) / L)[:, None] * f[None, :]
    feats = jnp.concatenate([t, jnp.cos(ang), -jnp.sin(ang)], axis=-1)
    freq = freq.astype(F32)
    h = jnp.sin(freq[0] * (feats @ w1.astype(F32) + b1.astype(F32)))
    h = jnp.sin(freq[1] * (h @ w2.astype(F32) + b2.astype(F32)))
    h = (h @ w3.astype(F32)).reshape(L, HY_ORDER, 2, HY_CH)
    deltas = jnp.abs(jnp.linspace(math.log(HY_DECAY_TARGET) / HY_LONG_DECAY_FRAC,
                                  math.log(HY_DECAY_TARGET) / HY_SHORT_DECAY_FRAC, HY_CH, dtype=F32))
    h = h * jnp.exp(-t * deltas[None, :])[:, None, None, :]
    return h * lax.rsqrt(jnp.sum(h * h, axis=(0, 2), keepdims=True) + NORM_EPS)


def two_sided_fft_conv(z, h_fwd, h_bwd):
    L = z.shape[1]
    k = jnp.concatenate([h_fwd, jnp.zeros_like(h_fwd[:1]), jnp.flip(h_bwd[1:], axis=0)], axis=0)
    zf = jnp.fft.rfft(z, n=2 * L, axis=1)
    kf = jnp.fft.rfft(k, n=2 * L, axis=0)
    return jnp.fft.irfft(zf * kf[None], n=2 * L, axis=1)[:, :L]


def hyena_mixer(u, conv_w, conv_b, w1, b1, w2, b2, w3, freq, skip, norm_g):
    L = u.shape[1]
    uc = depthwise_conv(u, conv_w, conv_b).astype(F32)
    v, x1, x2 = jnp.split(uc, 3, axis=-1)
    h = hyena_filters(L, w1, b1, w2, b2, w3, freq)
    skip = skip.astype(F32)
    z = v
    for o, gate in enumerate((x1, x2)):
        z = gate * (two_sided_fft_conv(z, h[:, o, 0], h[:, o, 1]) + skip[o] * z)
    return rms_norm(z, norm_g).astype(u.dtype)


def setup_inputs(seed: int = 0) -> dict:
    key = jax.random.key(seed)
    ks = iter(jax.random.split(key, 40))
    nrm = lambda shape, s: jax.random.normal(next(ks), shape, F32) * s
    gain = lambda shape: 1.0 + nrm(shape, 0.02)
    Lr = DEPTH
    dt0 = jnp.exp(jax.random.uniform(next(ks), (Lr, 2, SSD_HEADS), F32, math.log(1e-3), math.log(1e-1)))
    return {
        "x": nrm((BATCH, SEQ, D_MODEL), 1.0),
        "c": nrm((BATCH, D_MODEL), 1.0),
        "mod_w": nrm((Lr, D_MODEL, 6 * D_MODEL), D_MODEL ** -0.5),
        "mod_b": nrm((Lr, 6 * D_MODEL), 0.02),
        "w_in": nrm((Lr, D_MODEL, P_IN), D_MODEL ** -0.5),
        "ssd_conv_w": nrm((Lr, SSD_CONV, SSD_XBC), SSD_CONV ** -0.5),
        "ssd_conv_b": nrm((Lr, SSD_XBC), 0.02),
        "ssd_dt_bias": dt0 + jnp.log(-jnp.expm1(-dt0)),
        "ssd_a_log": jnp.log(jax.random.uniform(next(ks), (Lr, 2, SSD_HEADS), F32, 1.0, 16.0)),
        "ssd_d": gain((Lr, SSD_HEADS)),
        "ssd_norm_g": gain((Lr, GROUP_W)),
        "na_rpb": nrm((Lr, NA_HEADS, 2 * NA_KH - 1, 2 * NA_KW - 1), 0.02),
        "na_norm_g": gain((Lr, GROUP_W)),
        "ml_i_bias": nrm((Lr, 2, ML_HEADS), 0.1),
        "ml_f_bias": jnp.linspace(3.0, 6.0, ML_HEADS, dtype=F32)[None, None, :] + nrm((Lr, 2, ML_HEADS), 0.1),
        "ml_norm_g": gain((Lr, GROUP_W)),
        "hy_conv_w": nrm((Lr, HY_CONV, HY_IN), HY_CONV ** -0.5),
        "hy_conv_b": nrm((Lr, HY_IN), 0.02),
        "hy_w1": nrm((Lr, HY_EMB, HY_FFN), HY_EMB ** -0.5),
        "hy_b1": nrm((Lr, HY_FFN), 0.1),
        "hy_w2": nrm((Lr, HY_FFN, HY_FFN), HY_FFN ** -0.5),
        "hy_b2": nrm((Lr, HY_FFN), 0.1),
        "hy_w3": nrm((Lr, HY_FFN, HY_ORDER * 2 * HY_CH), HY_FFN ** -0.5),
        "hy_freq": 1.0 + nrm((Lr, 2, HY_FFN), 0.1),
        "hy_skip": nrm((Lr, HY_ORDER, HY_CH), 0.1),
        "hy_norm_g": gain((Lr, GROUP_W)),
        "w_out": nrm((Lr, MIX_W, D_MODEL), MIX_W ** -0.5),
        "ffn_w_gate": nrm((Lr, D_MODEL, FFN_HIDDEN), D_MODEL ** -0.5),
        "ffn_w_up": nrm((Lr, D_MODEL, FFN_HIDDEN), D_MODEL ** -0.5),
        "ffn_w_down": nrm((Lr, FFN_HIDDEN, D_MODEL), FFN_HIDDEN ** -0.5),
        "final_norm_g": gain((D_MODEL,)),
    }


def reference(x, c, mod_w, mod_b, w_in, ssd_conv_w, ssd_conv_b, ssd_dt_bias, ssd_a_log, ssd_d,
              ssd_norm_g, na_rpb, na_norm_g, ml_i_bias, ml_f_bias, ml_norm_g, hy_conv_w, hy_conv_b,
              hy_w1, hy_b1, hy_w2, hy_b2, hy_w3, hy_freq, hy_skip, hy_norm_g, w_out,
              ffn_w_gate, ffn_w_up, ffn_w_down, final_norm_g):
    cond = jax.nn.silu(c)
    for l in range(DEPTH):
        mod = cond @ mod_w[l] + mod_b[l]
        sh1, sc1, g1, sh2, sc2, g2 = [m[:, None, :] for m in jnp.split(mod, 6, axis=-1)]
        h = rms_norm(x) * (1 + sc1) + sh1
        u = h @ w_in[l]
        y_ssd = ssd_mixer(u[..., :OFF_NA], ssd_conv_w[l], ssd_conv_b[l], ssd_dt_bias[l],
                          ssd_a_log[l], ssd_d[l], ssd_norm_g[l])
        y_na = rms_norm(neighborhood_attention(u[..., OFF_NA:OFF_ML], na_rpb[l]), na_norm_g[l])
        y_ml = mlstm_mixer(u[..., OFF_ML:OFF_HY], ml_i_bias[l], ml_f_bias[l], ml_norm_g[l])
        y_hy = hyena_mixer(u[..., OFF_HY:], hy_conv_w[l], hy_conv_b[l], hy_w1[l], hy_b1[l],
                           hy_w2[l], hy_b2[l], hy_w3[l], hy_freq[l], hy_skip[l], hy_norm_g[l])
        y = jnp.concatenate([y_ssd, y_na, y_ml, y_hy], axis=-1) @ w_out[l]
        x = x + g1 * y
        h = rms_norm(x) * (1 + sc2) + sh2
        x = x + g2 * ((jax.nn.silu(h @ ffn_w_gate[l]) * (h @ ffn_w_up[l])) @ ffn_w_down[l])
    return rms_norm(x, final_norm_g)
```

```cpp
#include <hip/hip_runtime.h>
#include <hip/hip_cooperative_groups.h>
#include <cstdio>
#include <cstdint>
namespace cg = cooperative_groups;
#define MK_MULTI 1
namespace pg8 {
#define PG8_LAS __attribute__((address_space(3)))
typedef unsigned short bf16_t;
typedef short bf16x8 __attribute__((ext_vector_type(8)));
typedef float f32x4 __attribute__((ext_vector_type(4)));
typedef unsigned u32x4 __attribute__((ext_vector_type(4)));
constexpr int BM = 256, BK = 64, HALF = 128, HTB = HALF * BK * 2  , STAGE_BYTES = 8 * HTB, NXCD = 8, WGM = 8;

__host__ __device__ __forceinline__ int lds_byte(int r, int c) { const int st = (r >> 4) * 2 + (c >> 5), rr = r & 15, cc = c & 31, ob = rr * 64 + cc * 2; return st * 1024 + (ob ^ (((ob >> 9) & 1) << 5)); }
__host__ __device__ __forceinline__ void stage_rc(int b, int& R, int& C) { const int st = b / 1024, sb = b % 1024, swz = sb ^ (((sb >> 9) & 1) << 5); R = (st >> 1) * 16 + swz / 64; C = (st & 1) * 32 + (swz % 64) / 2; }
__host__ __device__ __forceinline__ int perm32(int rho) { const int n = rho >> 4, i = rho & 15; return 8 * (i >> 2) + 4 * n + (i & 3); }

struct Unit { int pm, pn; };
struct Gemm { const bf16_t* A; const bf16_t* Bt; int M, N, K; };

struct StaticOrder {
    int nM, nN, nwg, G, c;
    __host__ __device__ void init(int M, int N, int G_, int c_) { nM = M / BM; nN = N / BM; nwg = nM * nN; G = G_; c = c_; }
    __host__ __device__ bool next(int i, Unit& u) const {
        const long L = (long)i * G + c; if (L >= nwg) return false;
        int wgid = (int)L; { const int q = nwg / NXCD, r = nwg % NXCD, xcd = wgid % NXCD, off = wgid / NXCD; wgid = (xcd < r ? xcd * (q + 1) : r * (q + 1) + (xcd - r) * q) + off; }
        const int nig = WGM * nN, gid = wgid / nig, fm = gid * WGM, gsz = (nM - fm) < WGM ? (nM - fm) : WGM;
        u.pm = fm + ((wgid % nig) % gsz); u.pn = (wgid % nig) / gsz; return true;
    }
    __device__ __forceinline__ void a_ready(const Unit&) const {}
    __device__ __forceinline__ void done(const Unit&) const {}
};

__device__ __forceinline__ unsigned cvt_pk_bf16(float lo, float hi) { unsigned r; asm volatile("v_cvt_pk_bf16_f32 %0, %1, %2" : "=v"(r) : "v"(lo), "v"(hi)); return r; }
struct EpiStoreBf16 {
    static constexpr bool PERM = true, AFTER_DRAIN = false;
    bf16_t* O; int ldc;
    __device__ __forceinline__ void operator()(const f32x4 (&acc)[2][2][4][2], const Unit& u, int wr, int wc, int fr, int fq) const {
        const int row0 = u.pm * BM + wr * 64 + fr; const int col0 = u.pn * BM + wc * 32 + 8 * fq;
#pragma unroll
        for (int ai = 0; ai < 2; ++ai)
#pragma unroll
            for (int m = 0; m < 4; ++m) { bf16_t* rowp = O + (size_t)(row0 + ai * HALF + m * 16) * ldc + col0;
#pragma unroll
                for (int bj = 0; bj < 2; ++bj) { const f32x4 v0 = acc[ai][bj][m][0], v1 = acc[ai][bj][m][1];
                    u32x4 w; w.x = cvt_pk_bf16(v0[0], v0[1]); w.y = cvt_pk_bf16(v0[2], v0[3]); w.z = cvt_pk_bf16(v1[0], v1[1]); w.w = cvt_pk_bf16(v1[2], v1[3]);
                    *(u32x4*)(rowp + bj * HALF) = w; } }
    }
};
struct EpiResid {
    static constexpr bool PERM = false, AFTER_DRAIN = false;
    const float* base; float* out; const float* gate;
    __device__ __forceinline__ void operator()(const f32x4 (&acc)[2][2][4][2], const Unit& u, int wr, int wc, int fr, int fq) const {
        const int col0 = u.pn * BM + wc * 32 + 4 * fq;
        const float* gp = gate + (size_t)((u.pm * BM) >> 11) * 6144 + col0;
        f32x4 gv[2][2];
#pragma unroll
        for (int bj = 0; bj < 2; ++bj)
#pragma unroll
            for (int n = 0; n < 2; ++n) gv[bj][n] = *(const f32x4*)(gp + bj * HALF + n * 16);
#pragma unroll
        for (int ai = 0; ai < 2; ++ai)
#pragma unroll
            for (int m = 0; m < 4; ++m) { const size_t off = (size_t)(u.pm * BM + ai * HALF + wr * 64 + m * 16 + fr) * 1024 + col0;
#pragma unroll
                for (int bj = 0; bj < 2; ++bj)
#pragma unroll
                    for (int n = 0; n < 2; ++n) { const f32x4 bs = *(const f32x4*)(base + off + bj * HALF + n * 16);
                        *(f32x4*)(out + off + bj * HALF + n * 16) = bs + gv[bj][n] * acc[ai][bj][m][n]; }
                if (m & 1) asm volatile("" ::: "memory"); }
    }
};
__device__ __forceinline__ float silu_f(float v) { return v * __builtin_amdgcn_rcpf(1.0f + __expf(-v)); }
struct EpiSwiglu {
    static constexpr bool PERM = true, AFTER_DRAIN = false;
    bf16_t* O; int ldc;
    __device__ __forceinline__ void operator()(const f32x4 (&acc)[2][2][4][2], const Unit& u, int wr, int wc, int fr, int fq) const {
        const int row0 = u.pm * BM + wr * 64 + fr; const int col0 = u.pn * HALF + wc * 32 + 8 * fq;
#pragma unroll
        for (int ai = 0; ai < 2; ++ai)
#pragma unroll
            for (int m = 0; m < 4; ++m) { bf16_t* rowp = O + (size_t)(row0 + ai * HALF + m * 16) * ldc + col0;
                const f32x4 g0 = acc[ai][0][m][0], g1 = acc[ai][0][m][1], u0 = acc[ai][1][m][0], u1 = acc[ai][1][m][1];
                u32x4 w;
                w.x = cvt_pk_bf16(silu_f(g0[0]) * u0[0], silu_f(g0[1]) * u0[1]); w.y = cvt_pk_bf16(silu_f(g0[2]) * u0[2], silu_f(g0[3]) * u0[3]);
                w.z = cvt_pk_bf16(silu_f(g1[0]) * u1[0], silu_f(g1[1]) * u1[1]); w.w = cvt_pk_bf16(silu_f(g1[2]) * u1[2], silu_f(g1[3]) * u1[3]);
                *(u32x4*)rowp = w; }
    }
};

template <class Epi, class Sched, bool ALIGN_EPI = false, bool SP2 = false>
__device__ __forceinline__ void gemm_phase(PG8_LAS unsigned char* lds, const Gemm g, const Sched& S, const Epi& E) {
    int tid_ = threadIdx.x; asm volatile("" : "+v"(tid_));
    const int tid = tid_, wid = __builtin_amdgcn_readfirstlane(tid >> 6), lane = tid & 63, wr = wid >> 2, wc = wid & 3, fr = lane & 15, fq = lane >> 4;
    const int K = g.K, nt = K / BK;
    unsigned voffA[2], voffB[2];
#pragma unroll
    for (int i = 0; i < 2; ++i) { int R, C; stage_rc(tid * 16 + i * 8192, R, C); const int Rb = Epi::PERM ? ((R & ~31) + perm32(R & 31)) : R;
        voffA[i] = (unsigned)(R * K + C) * 2u; voffB[i] = (unsigned)(Rb * K + C) * 2u; }
    const size_t kstep = (size_t)(BK * 2);
    const size_t hstep = (size_t)HALF * K * 2;
    const size_t tstep = 2 * hstep;
    const unsigned ldsw = (unsigned)wid * 1024u;
    const int aoff = lds_byte(wr * 64 + fr, fq * 8), boff = lds_byte(wc * 32 + fr, fq * 8);
#define PG8_SA(b, h) (((b) * 2 + (h)) * HTB)
#define PG8_SB(b, h) ((4 + (b) * 2 + (h)) * HTB)
#define PG8_STAGE(bufoff, gbase, voff) do { _Pragma("unroll") for (int _i = 0; _i < 2; ++_i) \
        __builtin_amdgcn_global_load_lds((const unsigned*)((const char*)(gbase) + (voff)[_i]), (PG8_LAS unsigned*)(lds + (bufoff) + ldsw + _i * 8192), 16, 0, 0); } while (0)
#define PG8_LDA(dst, b, h) do { _Pragma("unroll") for (int m = 0; m < 4; ++m) _Pragma("unroll") for (int k = 0; k < 2; ++k) dst[m][k] = *(const PG8_LAS bf16x8*)(lds + PG8_SA(b, h) + aoff + m * 2048 + k * 1024); } while (0)
#define PG8_LDB(dst, b, h) do { _Pragma("unroll") for (int n = 0; n < 2; ++n) _Pragma("unroll") for (int k = 0; k < 2; ++k) dst[n][k] = *(const PG8_LAS bf16x8*)(lds + PG8_SB(b, h) + boff + n * 2048 + k * 1024); } while (0)
#define PG8_MMA(ai, bj, At, Bt) do { __builtin_amdgcn_s_setprio(1); _Pragma("unroll") for (int m = 0; m < 4; ++m) _Pragma("unroll") for (int n = 0; n < 2; ++n) _Pragma("unroll") for (int k = 0; k < 2; ++k) \
        acc[ai][bj][m][n] = __builtin_amdgcn_mfma_f32_16x16x32_bf16(Bt[n][k], At[m][k], acc[ai][bj][m][n], 0, 0, 0); __builtin_amdgcn_s_setprio(0); } while (0)
#define PG8_WAIT_V(n) asm volatile("s_waitcnt vmcnt(" #n ")" ::: "memory")
#define PG8_WAIT_L(n) asm volatile("s_waitcnt lgkmcnt(" #n ")" ::: "memory")
#define PG8_BAR __builtin_amdgcn_s_barrier()
#define PG8_SCHED __builtin_amdgcn_sched_barrier(0)
    Unit cur, nxt; int ui = 0;
    if (!S.next(0, cur)) return;
    f32x4 acc[2][2][4][2];
#pragma unroll
    for (int a = 0; a < 2; ++a)
#pragma unroll
        for (int b = 0; b < 2; ++b)
#pragma unroll
            for (int m = 0; m < 4; ++m)
#pragma unroll
                for (int n = 0; n < 2; ++n) acc[a][b][m][n] = (f32x4){0.f, 0.f, 0.f, 0.f};
    bf16x8 At[4][2], B0[2][2], B1[2][2];
    const char* cA = (const char*)g.A + (size_t)cur.pm * tstep; const char* cB = (const char*)g.Bt + (size_t)cur.pn * tstep;
    S.a_ready(cur);
    if constexpr (SP2) {
        PG8_STAGE(PG8_SB(0, 0), cB, voffB); PG8_STAGE(PG8_SB(0, 1), cB + hstep, voffB); PG8_STAGE(PG8_SA(0, 0), cA, voffA); PG8_STAGE(PG8_SA(0, 1), cA + hstep, voffA);
        if (wr == 1) PG8_BAR;
        PG8_WAIT_V(2); PG8_BAR;
        PG8_STAGE(PG8_SB(1, 0), cB + kstep, voffB); PG8_STAGE(PG8_SA(1, 0), cA + kstep, voffA); PG8_STAGE(PG8_SB(1, 1), cB + hstep + kstep, voffB);
        PG8_WAIT_V(6); PG8_BAR;
    } else {
        PG8_STAGE(PG8_SB(0, 0), cB, voffB); PG8_STAGE(PG8_SA(0, 0), cA, voffA); PG8_STAGE(PG8_SB(0, 1), cB + hstep, voffB); PG8_STAGE(PG8_SA(0, 1), cA + hstep, voffA);
        if (wr == 1) PG8_BAR;
        PG8_WAIT_V(4); PG8_BAR;
        PG8_STAGE(PG8_SB(1, 0), cB + kstep, voffB); PG8_STAGE(PG8_SA(1, 0), cA + kstep, voffA); PG8_STAGE(PG8_SB(1, 1), cB + hstep + kstep, voffB);
        PG8_WAIT_V(6); PG8_BAR;
    }
    for (;;) {
        const bool has_next = S.next(ui + 1, nxt);
        const char* nA = has_next ? (const char*)g.A + (size_t)nxt.pm * tstep : cA; const char* nB = has_next ? (const char*)g.Bt + (size_t)nxt.pn * tstep : cB;
        for (int t = 0; t < nt; t += 2) {
            const bool last = (t == nt - 2);
            const char* a1 = cA + (size_t)(t + 1) * kstep;
            const char* a2 = last ? nA : cA + (size_t)(t + 2) * kstep; const char* b2 = last ? nB : cB + (size_t)(t + 2) * kstep;
            const char* a3 = a2 + kstep; const char* b3 = b2 + kstep;
            if (last && has_next) S.a_ready(nxt);
            if constexpr (SP2) {
            PG8_LDB(B0, 0, 0); PG8_LDB(B1, 0, 1); PG8_SCHED; PG8_LDA(At, 0, 0); PG8_STAGE(PG8_SA(1, 1), a1 + hstep, voffA);
            PG8_WAIT_V(8); PG8_WAIT_L(0); PG8_BAR; PG8_MMA(0, 0, At, B0); PG8_MMA(0, 1, At, B1); PG8_BAR; PG8_SCHED;
            PG8_LDA(At, 0, 1); PG8_STAGE(PG8_SB(0, 0), b2, voffB); PG8_STAGE(PG8_SB(0, 1), b2 + hstep, voffB); PG8_STAGE(PG8_SA(0, 0), a2, voffA);
            PG8_WAIT_V(8); PG8_WAIT_L(0); PG8_BAR; PG8_MMA(1, 0, At, B0); PG8_MMA(1, 1, At, B1); PG8_BAR; PG8_SCHED;
            PG8_LDB(B0, 1, 0); PG8_LDB(B1, 1, 1); PG8_SCHED; PG8_LDA(At, 1, 0); PG8_STAGE(PG8_SA(0, 1), a2 + hstep, voffA);
            PG8_WAIT_V(8); PG8_WAIT_L(0); PG8_BAR; PG8_MMA(0, 0, At, B0); PG8_MMA(0, 1, At, B1); PG8_BAR; PG8_SCHED;
            PG8_LDA(At, 1, 1); PG8_STAGE(PG8_SB(1, 0), b3, voffB); PG8_STAGE(PG8_SB(1, 1), b3 + hstep, voffB); PG8_STAGE(PG8_SA(1, 0), a3, voffA);
            PG8_WAIT_V(8); PG8_WAIT_L(0); PG8_BAR; PG8_MMA(1, 0, At, B0); PG8_MMA(1, 1, At, B1); PG8_BAR; PG8_SCHED;
            } else {
            PG8_LDB(B0, 0, 0); PG8_SCHED; PG8_LDA(At, 0, 0); PG8_STAGE(PG8_SA(1, 1), a1 + hstep, voffA);
            PG8_WAIT_L(8); PG8_BAR; PG8_WAIT_L(0); PG8_MMA(0, 0, At, B0); PG8_BAR; PG8_SCHED;
            PG8_LDB(B1, 0, 1); PG8_STAGE(PG8_SB(0, 0), b2, voffB);
            PG8_BAR; PG8_WAIT_L(0); PG8_MMA(0, 1, At, B1); PG8_BAR;
            PG8_LDA(At, 0, 1); PG8_STAGE(PG8_SA(0, 0), a2, voffA);
            PG8_BAR; PG8_WAIT_L(0); PG8_MMA(1, 0, At, B0); PG8_BAR; PG8_SCHED;
            PG8_STAGE(PG8_SB(0, 1), b2 + hstep, voffB);
            PG8_WAIT_V(6); PG8_BAR; PG8_MMA(1, 1, At, B1); PG8_BAR;
            PG8_LDB(B0, 1, 0); PG8_SCHED; PG8_LDA(At, 1, 0); PG8_STAGE(PG8_SA(0, 1), a2 + hstep, voffA);
            PG8_WAIT_L(8); PG8_BAR; PG8_WAIT_L(0); PG8_MMA(0, 0, At, B0); PG8_BAR; PG8_SCHED;
            PG8_LDB(B1, 1, 1); PG8_STAGE(PG8_SB(1, 0), b3, voffB);
            PG8_BAR; PG8_WAIT_L(0); PG8_MMA(0, 1, At, B1); PG8_BAR;
            PG8_LDA(At, 1, 1); PG8_STAGE(PG8_SA(1, 0), a3, voffA);
            PG8_BAR; PG8_WAIT_L(0); PG8_MMA(1, 0, At, B0); PG8_BAR; PG8_SCHED;
            PG8_STAGE(PG8_SB(1, 1), b3 + hstep, voffB);
            PG8_WAIT_V(6); PG8_BAR; PG8_MMA(1, 1, At, B1); PG8_BAR;
            }
        }
        if constexpr (ALIGN_EPI) { if (wr == 0) PG8_BAR; }
        if constexpr (!Epi::AFTER_DRAIN) { E(acc, cur, wr, wc, fr, fq); S.done(cur); }
        if (!has_next) break;
#pragma unroll
        for (int a = 0; a < 2; ++a)
#pragma unroll
            for (int b = 0; b < 2; ++b)
#pragma unroll
                for (int m = 0; m < 4; ++m)
#pragma unroll
                    for (int n = 0; n < 2; ++n) acc[a][b][m][n] = (f32x4){0.f, 0.f, 0.f, 0.f};
        cur = nxt; cA = nA; cB = nB; ++ui;
        if constexpr (ALIGN_EPI) { if (wr == 1) PG8_BAR; }
    }
    PG8_WAIT_V(0);
    if constexpr (!ALIGN_EPI) { if (wr == 0) PG8_BAR; }
    PG8_BAR;
    if constexpr (Epi::AFTER_DRAIN) { E.fused(acc, cur, wr, wc, fr, fq, lds, wid, lane); S.done(cur); }
#undef PG8_SA
#undef PG8_SB
#undef PG8_STAGE
#undef PG8_LDA
#undef PG8_LDB
#undef PG8_MMA
#undef PG8_WAIT_V
#undef PG8_WAIT_L
#undef PG8_BAR
#undef PG8_SCHED
}
}

constexpr int NB = 16, SEQ = 2048, DM = 1024, MTOK = NB * SEQ, DEPTH = 2;
constexpr int P_IN = 3608, FFH = 2816, UL = 3072;
constexpr int C_SZ = 0, C_SX = 256, C_SB = 512, C_SC = 768, C_NQ = 1024, C_NK = 1280, C_NV = 1536, C_MQ = 1792, C_MK = 2048, C_MV = 2304, C_MO = 2560, C_G = 2816;
constexpr float EPS = 1e-6f;
constexpr int NWAVES = 8, NTHR = 512;
constexpr size_t MiB = 1u << 20;
constexpr size_t WS_CTL = 0, CTL_ZERO_BYTES = 64 * 1024;
constexpr size_t WS_MOD = 1 * MiB, WS_HID2 = 2 * MiB, WS_DT = 3 * MiB, WS_FILT = 4 * MiB, WS_W = 12 * MiB;
constexpr size_t W_IN_OFF = 0, W_HY_OFF = 6 * MiB, W_OUT_OFF = 7 * MiB + MiB / 2, W_GU_OFF = 9 * MiB + MiB / 2, W_DN_OFF = 20 * MiB + MiB / 2, W_LAYER = 26 * MiB;
constexpr size_t WS_XN = 64 * MiB, WS_U = 128 * MiB, WS_UHT = 320 * MiB, WS_YS = 368 * MiB, WS_NAO = 400 * MiB, WS_MLH = 416 * MiB, WS_HYO = 448 * MiB, WS_END = 464 * MiB;
constexpr int LDS_BYTES = 147456, MISC_OFF = 131072 + 320;

#define GAS __attribute__((address_space(1)))
#define LAS __attribute__((address_space(3)))
typedef unsigned short bf16;
typedef unsigned v4u __attribute__((ext_vector_type(4)));
typedef float f32x4 __attribute__((ext_vector_type(4)));
__device__ __forceinline__ unsigned f2bf(float f) { unsigned u = __builtin_bit_cast(unsigned, f); return (u + 0x7fffu + ((u >> 16) & 1u)) >> 16; }
__device__ __forceinline__ unsigned pk2(float lo, float hi) { return f2bf(lo) | (f2bf(hi) << 16); }
__device__ __forceinline__ float bf2f(unsigned h) { return __builtin_bit_cast(float, h << 16); }
__device__ __forceinline__ float bflo(unsigned w) { return __builtin_bit_cast(float, w << 16); }
__device__ __forceinline__ float bfhi(unsigned w) { return __builtin_bit_cast(float, w & 0xffff0000u); }
__device__ __forceinline__ float wave_sum(float v) {
#pragma unroll
    for (int o = 1; o < 64; o <<= 1) v += __shfl_xor(v, o);
    return v;
}
__device__ __forceinline__ float wave_max(float v) {
#pragma unroll
    for (int o = 1; o < 64; o <<= 1) v = fmaxf(v, __shfl_xor(v, o));
    return v;
}
__device__ __forceinline__ float sigmoid_f(float v) { return 1.0f / (1.0f + __expf(-v)); }
__device__ __forceinline__ float silu_ff(float v) { return v / (1.0f + __expf(-v)); }
__device__ __forceinline__ float softplus_f(float v) { return v > 20.f ? v : log1pf(__expf(v)); }

__device__ __forceinline__ int fresh_tid() { int t = threadIdx.x; asm volatile("" : "+v"(t)); return t; }
struct Args { const float* in[31]; float* out; unsigned char* ws; int ph_lo, ph_hi; };

struct Ctx {
    LAS unsigned char* lds;
    int tid, lane, wave, bid, G;
    const Args* A; float* out; unsigned char* ws;
};
#define INP(i) (F.A->in[i])

__device__ __forceinline__ const float* wsrc(const Ctx& F, int which, int l, int j, int* ld) {
    if (which == 0) { *ld = P_IN; const float* w = INP(4) + (size_t)l * DM * P_IN;
        int o; if (j < 1024) o = j; else if (j < 1792) o = 1032 + (j - 1024); else if (j < 2816) o = 1800 + (j - 1792); else if (j < 2824) o = 1024 + (j - 2816); else if (j < 2840) o = j; else return nullptr;
        return w + o; }
    if (which == 1) { *ld = P_IN; return INP(4) + (size_t)l * DM * P_IN + 2840 + j; }
    if (which == 2) { *ld = DM; return INP(26) + (size_t)l * DM * DM + j; }
    if (which == 3) { *ld = FFH; const int t = j >> 8, w = j & 255; return (w < 128 ? INP(27) : INP(28)) + (size_t)l * DM * FFH + t * 128 + (w & 127); }
    *ld = DM; return INP(29) + (size_t)l * FFH * DM + j;
}
__device__ __forceinline__ void transpose_item(const Ctx& F, int which, int l, int K, bf16* WT, LAS float* scr, int item, int nblk) {
    const int lane = F.lane, kb = item / nblk, nb = item % nblk, k0 = 64 * kb, n0 = 32 * nb;
    int ld = 0; const float* cp = wsrc(F, which, l, n0 + (lane & 31), &ld);
#pragma unroll 8
    for (int i = 0; i < 32; ++i) { const int kk = 2 * i + (lane >> 5); scr[kk * 33 + (lane & 31)] = cp ? cp[(size_t)(k0 + kk) * ld] : 0.f; }
    asm volatile("s_waitcnt lgkmcnt(0)" ::: "memory");
    const int c = lane & 7;
#pragma unroll
    for (int j = 0; j < 4; ++j) { const int n = (lane >> 3) + 8 * j; const LAS float* s = scr + (8 * c) * 33 + n;
        v4u o; o.x = pk2(s[0 * 33], s[1 * 33]); o.y = pk2(s[2 * 33], s[3 * 33]); o.z = pk2(s[4 * 33], s[5 * 33]); o.w = pk2(s[6 * 33], s[7 * 33]);
        *(v4u*)(WT + (size_t)(n0 + n) * K + k0 + 8 * c) = o; }
    asm volatile("s_waitcnt lgkmcnt(0)" ::: "memory");
}
__device__ __forceinline__ void ph_prologue(Ctx& F) {
    const int gw = F.bid * NWAVES + F.wave, NGW = F.G * NWAVES, lane = F.lane;
    LAS float* scr = (LAS float*)(F.lds + F.wave * 16384);
    constexpr int I_IN = 16 * 96, I_HY = 16 * 24, I_OUT = 16 * 32, I_GU = 16 * 176, I_DN = 44 * 32, I_L = I_IN + I_HY + I_OUT + I_GU + I_DN;
    for (int it = gw; it < DEPTH * I_L; it += NGW) {
        const int l = it / I_L; int r = it % I_L; unsigned char* wb = F.ws + WS_W + (size_t)l * W_LAYER;
        if (r < I_IN) { transpose_item(F, 0, l, DM, (bf16*)(wb + W_IN_OFF), scr, r, 96); continue; } r -= I_IN;
        if (r < I_HY) { transpose_item(F, 1, l, DM, (bf16*)(wb + W_HY_OFF), scr, r, 24); continue; } r -= I_HY;
        if (r < I_OUT) { transpose_item(F, 2, l, DM, (bf16*)(wb + W_OUT_OFF), scr, r, 32); continue; } r -= I_OUT;
        if (r < I_GU) { transpose_item(F, 3, l, DM, (bf16*)(wb + W_GU_OFF), scr, r, 176); continue; } r -= I_GU;
        transpose_item(F, 4, l, FFH, (bf16*)(wb + W_DN_OFF), scr, r, 32);
    }
    for (int it = gw; it < DEPTH * SEQ; it += NGW) {
        const int l = it / SEQ, pos = it % SEQ;
        const float* w1 = INP(18) + l * 33 * 64; const float* b1 = INP(19) + l * 64; const float* w2 = INP(20) + l * 64 * 64; const float* b2 = INP(21) + l * 64; const float* fq = INP(23) + l * 128;
        const float t = (float)pos / 2047.0f;
        float z = b1[lane] + t * w1[lane];
        const float a = 6.283185307179586f * ((float)pos / 2048.0f);
#pragma unroll
        for (int i = 0; i < 16; ++i) { const float f = 1e-4f + (float)i * ((15.0f - 1e-4f) / 15.0f); const float ang = a * f;
            z += cosf(ang) * w1[(1 + i) * 64 + lane]; z -= sinf(ang) * w1[(17 + i) * 64 + lane]; }
        const float h1 = sinf(fq[lane] * z);
        float z2 = b2[lane];
        for (int i = 0; i < 64; ++i) z2 += __shfl(h1, i) * w2[i * 64 + lane];
        const float h2 = sinf(fq[64 + lane] * z2);
        ((float*)(F.ws + WS_HID2))[(size_t)it * 64 + lane] = h2;
    }
    __syncthreads();
    LAS float* cond = (LAS float*)F.lds; LAS float* part = (LAS float*)(F.lds + 65536);
    if (F.bid < 192) {
        for (int i = F.tid; i < NB * DM; i += NTHR) cond[i] = silu_ff(INP(1)[i]);
        __syncthreads();
        for (int it = F.bid; it < 192; it += F.G) {
            const int l = it / 96, n0 = (it % 96) * 64;
            const float* W = INP(2) + (size_t)l * DM * 6144 + n0 + lane;
            float acc[16];
#pragma unroll
            for (int b = 0; b < 16; ++b) acc[b] = 0.f;
            const int kb = F.wave * 128;
            for (int k = 0; k < 128; ++k) { const float wv = W[(size_t)(kb + k) * 6144];
#pragma unroll
                for (int b = 0; b < 16; ++b) acc[b] += cond[b * DM + kb + k] * wv; }
#pragma unroll
            for (int b = 0; b < 16; ++b) part[(F.wave * 16 + b) * 64 + lane] = acc[b];
            __syncthreads();
            for (int o = F.tid; o < 1024; o += NTHR) { const int b = o >> 6, cidx = o & 63; float s = INP(3)[l * 6144 + n0 + cidx];
#pragma unroll
                for (int w = 0; w < 8; ++w) s += part[(w * 16 + b) * 64 + cidx];
                ((float*)(F.ws + WS_MOD))[(size_t)(l * NB + b) * 6144 + n0 + cidx] = s; }
            __syncthreads();
        }
    }
}

__device__ __forceinline__ void ph_xn(Ctx& F, const float* xsrc, const float* mod_l, int sh_off, int sc_off) {
    const int gw = F.bid * NWAVES + F.wave, NGW = F.G * NWAVES;
    bf16* XN = (bf16*)(F.ws + WS_XN);
    for (int m = gw; m < MTOK; m += NGW) {
        const f32x4* xr = (const f32x4*)(xsrc + (size_t)m * DM) + F.lane;
        const float* mb = mod_l + (size_t)(m >> 11) * 6144;
        f32x4 v[4]; float s = 0.f;
#pragma unroll
        for (int j = 0; j < 4; ++j) { v[j] = xr[64 * j]; s += (v[j].x * v[j].x + v[j].y * v[j].y) + (v[j].z * v[j].z + v[j].w * v[j].w); }
        const float rstd = 1.0f / sqrtf(wave_sum(s) * (1.f / DM) + EPS);
        unsigned long long* o8 = (unsigned long long*)(XN + (size_t)m * DM) + F.lane;
#pragma unroll
        for (int j = 0; j < 4; ++j) { const f32x4 sc = *((const f32x4*)(mb + sc_off) + F.lane + 64 * j), sh = *((const f32x4*)(mb + sh_off) + F.lane + 64 * j);
            const float a = v[j].x * rstd * (1.f + sc.x) + sh.x, b = v[j].y * rstd * (1.f + sc.y) + sh.y, c = v[j].z * rstd * (1.f + sc.z) + sh.z, d = v[j].w * rstd * (1.f + sc.w) + sh.w;
            o8[64 * j] = (unsigned long long)pk2(a, b) | ((unsigned long long)pk2(c, d) << 32); }
    }
}
__device__ __forceinline__ void ph_final(Ctx& F) {
    const int gw = F.bid * NWAVES + F.wave, NGW = F.G * NWAVES;
    const float* g = INP(30);
    for (int m = gw; m < MTOK; m += NGW) {
        f32x4* xr = (f32x4*)(F.out + (size_t)m * DM) + F.lane;
        f32x4 v[4]; float s = 0.f;
#pragma unroll
        for (int j = 0; j < 4; ++j) { v[j] = xr[64 * j]; s += (v[j].x * v[j].x + v[j].y * v[j].y) + (v[j].z * v[j].z + v[j].w * v[j].w); }
        const float rstd = 1.0f / sqrtf(wave_sum(s) * (1.f / DM) + EPS);
#pragma unroll
        for (int j = 0; j < 4; ++j) { const f32x4 gg = *((const f32x4*)g + F.lane + 64 * j); xr[64 * j] = v[j] * rstd * gg; }
    }
}

__device__ __forceinline__ void ph_filters(Ctx& F) {
    LAS float* red = (LAS float*)F.lds;
    for (int it = F.bid; it < DEPTH * 2 * 32; it += F.G) {
        const int l = it >> 6, o = (it >> 5) & 1, co = it & 31;
        const int cc = F.tid & 15, dir = cc >> 3, ch = co * 8 + (cc & 7), pl = F.tid >> 4;
        const float* w3 = INP(22) + (size_t)l * 64 * 1024 + o * 512 + dir * 256 + ch;
        float wc[64];
#pragma unroll
        for (int k = 0; k < 64; ++k) wc[k] = w3[k * 1024];
        const float delta = 3.0701134573253945f + (float)ch * ((15.350567286626972f - 3.0701134573253945f) / 255.0f);
        const float* hid = (const float*)(F.ws + WS_HID2) + (size_t)l * SEQ * 64;
        float ss = 0.f;
        for (int i = 0; i < 64; ++i) { const int p = pl + 32 * i; const f32x4* hr = (const f32x4*)(hid + (size_t)p * 64); float d = 0.f;
#pragma unroll
            for (int k = 0; k < 16; ++k) { const f32x4 hv = hr[k]; d += hv.x * wc[4 * k] + hv.y * wc[4 * k + 1] + hv.z * wc[4 * k + 2] + hv.w * wc[4 * k + 3]; }
            const float val = d * __expf(-((float)p / 2047.0f) * delta); ss += val * val; }
        ss += __shfl_xor(ss, 8); ss += __shfl_xor(ss, 16); ss += __shfl_xor(ss, 32);
        if (F.lane < 8) red[F.wave * 8 + F.lane] = ss;
        __syncthreads();
        float tot = 0.f;
#pragma unroll
        for (int w = 0; w < 8; ++w) tot += red[w * 8 + (cc & 7)];
        const float scale = 1.0f / sqrtf(tot + EPS);
        __syncthreads();
        bf16* fo = (bf16*)(F.ws + WS_FILT) + ((size_t)((l * 2 + o) * 256 + ch)) * 4096;
        for (int i = 0; i < 64; ++i) { const int p = pl + 32 * i; const f32x4* hr = (const f32x4*)(hid + (size_t)p * 64); float d = 0.f;
#pragma unroll
            for (int k = 0; k < 16; ++k) { const f32x4 hv = hr[k]; d += hv.x * wc[4 * k] + hv.y * wc[4 * k + 1] + hv.z * wc[4 * k + 2] + hv.w * wc[4 * k + 3]; }
            const float val = d * __expf(-((float)p / 2047.0f) * delta) * scale;
            if (dir == 0) fo[2048 - p] = (bf16)f2bf(val);
            else { if (p == 0) fo[0] = 0; else fo[2048 + p] = (bf16)f2bf(val); } }
    }
}

__device__ __forceinline__ void ph_prepass(Ctx& F, int l) {
    const bf16* U = (const bf16*)(F.ws + WS_U); bf16* XBC = (bf16*)(F.ws + WS_XN); float* DT = (float*)(F.ws + WS_DT);
    const float* cw = INP(5) + l * 3 * 768; const float* cb = INP(6) + l * 768; const float* dtb = INP(7) + l * 8;
    const int gt = F.bid * NTHR + F.tid, NT = F.G * NTHR;
    for (int it = gt; it < MTOK * 96; it += NT) {
        const int tok = it / 96, cg = it % 96, t = tok & (SEQ - 1), c0 = cg * 8;
        const bf16* up = U + (size_t)tok * UL + C_SX + c0;
        const v4u z4 = {0u, 0u, 0u, 0u};
        const v4u um = t > 0 ? *(const v4u*)(up - UL) : z4, u0 = *(const v4u*)up, upn = t < SEQ - 1 ? *(const v4u*)(up + UL) : z4;
        float r[8];
#pragma unroll
        for (int q = 0; q < 4; ++q) {
            const int c = c0 + 2 * q;
            const float a0 = cw[c] * bflo(um[q]) + cw[768 + c] * bflo(u0[q]) + cw[1536 + c] * bflo(upn[q]) + cb[c];
            const float a1 = cw[c + 1] * bfhi(um[q]) + cw[768 + c + 1] * bfhi(u0[q]) + cw[1536 + c + 1] * bfhi(upn[q]) + cb[c + 1];
            r[2 * q] = silu_ff(a0); r[2 * q + 1] = silu_ff(a1); }
        v4u o; o.x = pk2(r[0], r[1]); o.y = pk2(r[2], r[3]); o.z = pk2(r[4], r[5]); o.w = pk2(r[6], r[7]);
        *(v4u*)(XBC + (size_t)tok * 768 + c0) = o;
    }
    for (int it = gt; it < MTOK * 8; it += NT) { const int tok = it >> 3, j = it & 7;
        DT[it] = softplus_f(bf2f(U[(size_t)tok * UL + C_G + j]) + dtb[j]); }
}

__device__ __forceinline__ void ssd_seq_item(Ctx& F, int l, int it) {
    const int b = it >> 3, dir = (it >> 2) & 1, h = it & 3, g = h >> 1, lane = F.lane;
    const bf16* XBC = (const bf16*)(F.ws + WS_XN); const float* DT = (const float*)(F.ws + WS_DT);
    bf16* YS = (bf16*)(F.ws + WS_YS) + (size_t)dir * MTOK * 256;
    const float A = -__expf(INP(8)[l * 8 + dir * 4 + h]); const float Dk = INP(9)[l * 4 + h];
    float st[128];
#pragma unroll
    for (int n = 0; n < 128; ++n) st[n] = 0.f;
    for (int step = 0; step < SEQ; ++step) {
        const int t = dir ? SEQ - 1 - step : step; const size_t row = (size_t)b * SEQ + t;
        const float dt = DT[row * 8 + dir * 4 + h]; const float a = __expf(dt * A);
        const float x = bf2f(XBC[row * 768 + h * 64 + lane]); const float xdt = x * dt;
        const v4u* Bp = (const v4u*)(XBC + row * 768 + 256 + g * 128); const v4u* Cp = (const v4u*)(XBC + row * 768 + 512 + g * 128);
        float y = 0.f;
#pragma unroll
        for (int q = 0; q < 16; ++q) { const v4u bv = Bp[q], cv = Cp[q];
#pragma unroll
            for (int e = 0; e < 4; ++e) {
                float s0 = st[q * 8 + 2 * e] * a + xdt * bflo(bv[e]); float s1 = st[q * 8 + 2 * e + 1] * a + xdt * bfhi(bv[e]);
                st[q * 8 + 2 * e] = s0; st[q * 8 + 2 * e + 1] = s1; y += bflo(cv[e]) * s0 + bfhi(cv[e]) * s1; } }
        if (dir == 0) y += Dk * x;
        YS[row * 256 + h * 64 + lane] = (bf16)f2bf(y);
    }
}
__device__ __forceinline__ void ml_seq_item(Ctx& F, int l, int it) {
    const int b = it >> 3, dir = (it >> 2) & 1, h = it & 3, lane = F.lane;
    const bf16* U = (const bf16*)(F.ws + WS_U);
    bf16* MLH = (bf16*)(F.ws + WS_MLH) + (size_t)dir * MTOK * 256;
    const float ib = INP(13)[l * 8 + dir * 4 + h], fb = INP(14)[l * 8 + dir * 4 + h];
    float C[64];
#pragma unroll
    for (int d = 0; d < 64; ++d) C[d] = 0.f;
    float nl = 0.f, m = 0.f;
    for (int step = 0; step < SEQ; ++step) {
        const int t = dir ? SEQ - 1 - step : step; const size_t row = (size_t)b * SEQ + t; const bf16* ur = U + row * UL;
        const float li = bf2f(ur[C_G + 8 + dir * 4 + h]) + ib; const float gf = bf2f(ur[C_G + 16 + dir * 4 + h]) + fb;
        const float lf = -softplus_f(-gf);
        const float mn = fmaxf(lf + m, li); const float fs = __expf(lf + m - mn), is = __expf(li - mn); m = mn;
        const float v = bf2f(ur[C_MV + h * 64 + lane]);
        const float kl = bf2f(ur[C_MK + h * 64 + lane]) * 0.125f, ql = bf2f(ur[C_MQ + h * 64 + lane]);
        nl = fs * nl + is * kl;
        const float den = wave_sum(ql * nl);
        const v4u* Qp = (const v4u*)(ur + C_MQ + h * 64); const v4u* Kp = (const v4u*)(ur + C_MK + h * 64);
        const float iv = is * v * 0.125f;
        float num = 0.f;
#pragma unroll
        for (int q = 0; q < 8; ++q) { const v4u qv = Qp[q], kv = Kp[q];
#pragma unroll
            for (int e = 0; e < 4; ++e) {
                float c0 = fs * C[q * 8 + 2 * e] + iv * bflo(kv[e]); float c1 = fs * C[q * 8 + 2 * e + 1] + iv * bfhi(kv[e]);
                C[q * 8 + 2 * e] = c0; C[q * 8 + 2 * e + 1] = c1; num += bflo(qv[e]) * c0 + bfhi(qv[e]) * c1; } }
        const float hh = num / fmaxf(fabsf(den), __expf(-m));
        MLH[row * 256 + h * 64 + lane] = (bf16)f2bf(hh);
    }
}
__device__ __forceinline__ void na_item(Ctx& F, int l, int it) {
    const int b = it >> 5, r = it & 31, lane = F.lane;
    const bf16* U = (const bf16*)(F.ws + WS_U); bf16* NAO = (bf16*)(F.ws + WS_NAO);
    const int rs = min(max(r - 4, 0), 24);
    for (int i = 0; i < 32; ++i) {
        const int wq = F.wave * 32 + i, j = wq >> 2, h = wq & 3;
        const int cs = min(max(j - 8, 0), 48);
        const size_t qtok = (size_t)b * SEQ + r * 64 + j;
        const float* rpb = INP(11) + (size_t)(l * 4 + h) * 15 * 31;
        const v4u* qp = (const v4u*)(U + qtok * UL + C_NQ + h * 64);
        v4u qv[8];
#pragma unroll
        for (int q = 0; q < 8; ++q) qv[q] = qp[q];
        float s[2];
#pragma unroll
        for (int kk = 0; kk < 2; ++kk) { const int key = lane + 64 * kk, krow = rs + (key >> 4), kcol = cs + (key & 15);
            const v4u* kp = (const v4u*)(U + ((size_t)b * SEQ + krow * 64 + kcol) * UL + C_NK + h * 64); float d = 0.f;
#pragma unroll
            for (int q = 0; q < 8; ++q) { const v4u kv = kp[q];
#pragma unroll
                for (int e = 0; e < 4; ++e) d += bflo(qv[q][e]) * bflo(kv[e]) + bfhi(qv[q][e]) * bfhi(kv[e]); }
            s[kk] = d * 0.125f + rpb[(krow - r + 7) * 31 + (kcol - j + 15)]; }
        const float mx = wave_max(fmaxf(s[0], s[1]));
        float p0 = __expf(s[0] - mx), p1 = __expf(s[1] - mx);
        const float inv = 1.0f / wave_sum(p0 + p1); p0 *= inv; p1 *= inv;
        float acc = 0.f;
        for (int key = 0; key < 128; ++key) { const float p = __shfl(key < 64 ? p0 : p1, key & 63);
            const int krow = rs + (key >> 4), kcol = cs + (key & 15);
            acc += p * bf2f(U[((size_t)b * SEQ + krow * 64 + kcol) * UL + C_NV + h * 64 + lane]); }
        NAO[qtok * 256 + h * 64 + lane] = (bf16)f2bf(acc);
    }
}
__device__ __forceinline__ float hy_conv3(const bf16* row, int tok, int t, float w0, float w1, float w2, float bias) {
    const float vm = t > 0 ? bf2f(row[tok - 1]) : 0.f, v0 = bf2f(row[tok]), vp = t < SEQ - 1 ? bf2f(row[tok + 1]) : 0.f;
    return w0 * vm + w1 * v0 + w2 * vp + bias;
}
__device__ __forceinline__ void hy_item(Ctx& F, int l, int c) {
    LAS bf16* zbuf = (LAS bf16*)F.lds; LAS float* rev = (LAS float*)(F.lds + 65536);
    const bf16* UHT = (const bf16*)(F.ws + WS_UHT); bf16* HYO = (bf16*)(F.ws + WS_HYO);
    const float* cw = INP(16) + l * 3 * 768; const float* cb = INP(17) + l * 768; const float* skip = INP(24) + l * 512;
    const int tid = F.tid;
    for (int i = tid; i < 8192; i += NTHR) rev[i] = bf2f(((const bf16*)(F.ws + WS_FILT))[((size_t)((l * 2 + (i >> 12)) * 256 + c)) * 4096 + (i & 4095)]);
    { const float w0 = cw[c], w1 = cw[768 + c], w2 = cw[1536 + c], bias = cb[c]; const bf16* row = UHT + (size_t)c * MTOK;
      for (int i = tid; i < MTOK; i += NTHR) { const int b = i >> 11, t = i & (SEQ - 1); zbuf[t * 16 + b] = (bf16)f2bf(hy_conv3(row, i, t, w0, w1, w2, bias)); } }
    __syncthreads();
    for (int o = 0; o < 2; ++o) {
        float acc[4][16];
#pragma unroll
        for (int j = 0; j < 4; ++j)
#pragma unroll
            for (int b = 0; b < 16; ++b) acc[j][b] = 0.f;
        const LAS float* rv = rev + o * 4096 + 2048 - tid;
        for (int s = 0; s < SEQ; ++s) {
            const v4u za = *(const LAS v4u*)(zbuf + s * 16), zb = *(const LAS v4u*)(zbuf + s * 16 + 8);
            float zf[16];
#pragma unroll
            for (int e = 0; e < 4; ++e) { zf[2 * e] = bflo(za[e]); zf[2 * e + 1] = bfhi(za[e]); zf[8 + 2 * e] = bflo(zb[e]); zf[8 + 2 * e + 1] = bfhi(zb[e]); }
#pragma unroll
            for (int j = 0; j < 4; ++j) { const float rr = rv[s - 512 * j];
#pragma unroll
                for (int b = 0; b < 16; ++b) acc[j][b] += rr * zf[b]; }
        }
        __syncthreads();
        const int gc = 256 * (o + 1) + c; const float w0 = cw[gc], w1 = cw[768 + gc], w2 = cw[1536 + gc], bias = cb[gc]; const bf16* grow = UHT + (size_t)gc * MTOK;
        const float sk = skip[o * 256 + c];
        LAS float* ysc = (LAS float*)(F.lds + 98304);
#pragma unroll
        for (int j = 0; j < 4; ++j) { const int t = tid + 512 * j;
#pragma unroll
            for (int b = 0; b < 16; ++b) ysc[b * 512 + tid] = acc[j][b];
            asm volatile("s_waitcnt lgkmcnt(0)" ::: "memory");
#pragma unroll 1
            for (int b = 0; b < 16; ++b) { const int tok = b * SEQ + t; const float xg = hy_conv3(grow, tok, t, w0, w1, w2, bias);
                const float zp = bf2f(zbuf[t * 16 + b]); const float zn = xg * (ysc[b * 512 + tid] + sk * zp);
                if (o == 0) zbuf[t * 16 + b] = (bf16)f2bf(zn); else HYO[(size_t)c * MTOK + tok] = (bf16)f2bf(zn); }
            asm volatile("s_waitcnt lgkmcnt(0)" ::: "memory"); }
        __syncthreads();
    }
}
__device__ __forceinline__ void ph_mixers(Ctx& F, int l) {
    if (F.bid < 64 && F.wave < 4) { const int it = F.bid * 4 + F.wave; if (it < 128) ssd_seq_item(F, l, it); else ml_seq_item(F, l, it - 128); }
    volatile LAS int* slot = (volatile LAS int*)(F.lds + MISC_OFF);
    unsigned* ctr = (unsigned*)(F.ws + WS_CTL) + 64 * (1 + l);
    for (;;) {
        __syncthreads();
        if (F.tid == 0) slot[0] = (int)atomicAdd(ctr, 1u);
        __syncthreads();
        const int it = slot[0];
        if (it >= 256 + 512) break;
        if (it < 256) hy_item(F, l, it); else na_item(F, l, it - 256);
    }
}

__device__ __forceinline__ void ph_finalize(Ctx& F, int l) {
    const int gw = F.bid * NWAVES + F.wave, NGW = F.G * NWAVES, lane = F.lane, c0 = lane * 4;
    const bf16* U = (const bf16*)(F.ws + WS_U); const bf16* YS = (const bf16*)(F.ws + WS_YS); const bf16* NAO = (const bf16*)(F.ws + WS_NAO);
    const bf16* MLH = (const bf16*)(F.ws + WS_MLH); const bf16* HYO = (const bf16*)(F.ws + WS_HYO); bf16* YM = (bf16*)(F.ws + WS_XN);
    const f32x4 gs = *(const f32x4*)(INP(10) + l * 256 + c0), gn = *(const f32x4*)(INP(12) + l * 256 + c0), gm = *(const f32x4*)(INP(15) + l * 256 + c0), gh = *(const f32x4*)(INP(25) + l * 256 + c0);
    for (int tok = gw; tok < MTOK; tok += NGW) {
        typedef unsigned u2 __attribute__((ext_vector_type(2)));
        { const u2 a = *(const u2*)(YS + (size_t)tok * 256 + c0), b2 = *(const u2*)(YS + (size_t)(MTOK + tok) * 256 + c0), z = *(const u2*)(U + (size_t)tok * UL + C_SZ + c0);
          float v0 = (bflo(a.x) + bflo(b2.x)) * silu_ff(bflo(z.x)), v1 = (bfhi(a.x) + bfhi(b2.x)) * silu_ff(bfhi(z.x)), v2 = (bflo(a.y) + bflo(b2.y)) * silu_ff(bflo(z.y)), v3 = (bfhi(a.y) + bfhi(b2.y)) * silu_ff(bfhi(z.y));
          const float rs = 1.0f / sqrtf(wave_sum(v0 * v0 + v1 * v1 + v2 * v2 + v3 * v3) * (1.f / 256.f) + EPS);
          u2 o; o.x = pk2(v0 * rs * gs.x, v1 * rs * gs.y); o.y = pk2(v2 * rs * gs.z, v3 * rs * gs.w); *(u2*)(YM + (size_t)tok * DM + c0) = o; }
        { const u2 a = *(const u2*)(NAO + (size_t)tok * 256 + c0);
          const float v0 = bflo(a.x), v1 = bfhi(a.x), v2 = bflo(a.y), v3 = bfhi(a.y);
          const float rs = 1.0f / sqrtf(wave_sum(v0 * v0 + v1 * v1 + v2 * v2 + v3 * v3) * (1.f / 256.f) + EPS);
          u2 o; o.x = pk2(v0 * rs * gn.x, v1 * rs * gn.y); o.y = pk2(v2 * rs * gn.z, v3 * rs * gn.w); *(u2*)(YM + (size_t)tok * DM + 256 + c0) = o; }
        { const u2 a = *(const u2*)(MLH + (size_t)tok * 256 + c0), b2 = *(const u2*)(MLH + (size_t)(MTOK + tok) * 256 + c0), og = *(const u2*)(U + (size_t)tok * UL + C_MO + c0);
          const float v0 = bflo(a.x) + bflo(b2.x), v1 = bfhi(a.x) + bfhi(b2.x), v2 = bflo(a.y) + bflo(b2.y), v3 = bfhi(a.y) + bfhi(b2.y);
          float ss = v0 * v0 + v1 * v1 + v2 * v2 + v3 * v3;
          ss += __shfl_xor(ss, 1); ss += __shfl_xor(ss, 2); ss += __shfl_xor(ss, 4); ss += __shfl_xor(ss, 8);
          const float rs = 1.0f / sqrtf(ss * (1.f / 64.f) + EPS);
          u2 o; o.x = pk2(v0 * rs * gm.x * sigmoid_f(bflo(og.x)), v1 * rs * gm.y * sigmoid_f(bfhi(og.x))); o.y = pk2(v2 * rs * gm.z * sigmoid_f(bflo(og.y)), v3 * rs * gm.w * sigmoid_f(bfhi(og.y)));
          *(u2*)(YM + (size_t)tok * DM + 512 + c0) = o; }
        { const float v0 = bf2f(HYO[(size_t)(c0 + 0) * MTOK + tok]), v1 = bf2f(HYO[(size_t)(c0 + 1) * MTOK + tok]), v2 = bf2f(HYO[(size_t)(c0 + 2) * MTOK + tok]), v3 = bf2f(HYO[(size_t)(c0 + 3) * MTOK + tok]);
          const float rs = 1.0f / sqrtf(wave_sum(v0 * v0 + v1 * v1 + v2 * v2 + v3 * v3) * (1.f / 256.f) + EPS);
          u2 o; o.x = pk2(v0 * rs * gh.x, v1 * rs * gh.y); o.y = pk2(v2 * rs * gh.z, v3 * rs * gh.w); *(u2*)(YM + (size_t)tok * DM + 768 + c0) = o; }
    }
}

constexpr int N_PHASES = 2 + 9 * DEPTH;
#ifndef MK_MULTI
#define MK_MULTI 1
#endif
__global__ void __launch_bounds__(NTHR, 2) hybrid_fwd(Args args) {
    extern __shared__ __attribute__((aligned(16))) unsigned char lds_raw[];
    Ctx F;
    F.lds = (LAS unsigned char*)lds_raw; F.tid = threadIdx.x; F.lane = F.tid & 63; F.wave = __builtin_amdgcn_readfirstlane(F.tid >> 6);
    F.bid = blockIdx.x; F.G = gridDim.x; F.out = args.out; F.ws = args.ws; F.A = &args;
    const int lo = args.ph_lo, hi = args.ph_hi;
#if MK_MULTI
#define SEAM(k) do { } while (0)
#else
    cg::grid_group grid = cg::this_grid();
#define SEAM(k) do { if ((k) + 1 < hi) grid.sync(); } while (0)
#endif
#ifndef PHMASK
#define PHMASK 0xFFFFF
#endif
#define FRESH() do { F.tid = fresh_tid(); F.lane = F.tid & 63; F.wave = __builtin_amdgcn_readfirstlane(F.tid >> 6); } while (0)
#define IN(k) (((PHMASK >> (k)) & 1) && lo <= (k) && (k) < hi)
#define INL(j) (((PHMASK >> (2 + (j))) & 1) && lo <= (pb + (j)) && (pb + (j)) < hi)
    const float* MOD = (const float*)(F.ws + WS_MOD);
    if (IN(0)) { FRESH(); ph_prologue(F); SEAM(0); }
    if (IN(1)) { FRESH(); ph_filters(F); FRESH(); ph_xn(F, INP(0), MOD, 0, 1024); SEAM(1); }
    for (int l = 0; l < DEPTH; ++l) {
        const int pb = 2 + 9 * l; unsigned char* wb = F.ws + WS_W + (size_t)l * W_LAYER; const float* mod_l = MOD + (size_t)l * NB * 6144;
        if (INL(0)) {
            { pg8::Gemm g{(const pg8::bf16_t*)(F.ws + WS_XN), (const pg8::bf16_t*)(wb + W_IN_OFF), MTOK, UL, DM}; pg8::StaticOrder S; S.init(MTOK, UL, F.G, F.bid);
              pg8::EpiStoreBf16 E{(pg8::bf16_t*)(F.ws + WS_U), UL}; pg8::gemm_phase<pg8::EpiStoreBf16, pg8::StaticOrder, true, true>(F.lds, g, S, E); }
            __syncthreads();
            { pg8::Gemm g{(const pg8::bf16_t*)(wb + W_HY_OFF), (const pg8::bf16_t*)(F.ws + WS_XN), 768, MTOK, DM}; pg8::StaticOrder S; S.init(768, MTOK, F.G, F.bid);
              pg8::EpiStoreBf16 E{(pg8::bf16_t*)(F.ws + WS_UHT), MTOK}; pg8::gemm_phase<pg8::EpiStoreBf16, pg8::StaticOrder, true, true>(F.lds, g, S, E); }
            SEAM(pb + 0);
        }
        if (INL(1)) { FRESH(); ph_prepass(F, l); SEAM(pb + 1); }
        if (INL(2)) { FRESH(); ph_mixers(F, l); SEAM(pb + 2); }
        if (INL(3)) { FRESH(); ph_finalize(F, l); SEAM(pb + 3); }
        if (INL(4)) {
            pg8::Gemm g{(const pg8::bf16_t*)(F.ws + WS_XN), (const pg8::bf16_t*)(wb + W_OUT_OFF), MTOK, DM, DM}; pg8::StaticOrder S; S.init(MTOK, DM, F.G, F.bid);
            pg8::EpiResid E{l == 0 ? INP(0) : (const float*)F.out, F.out, mod_l + 2048}; pg8::gemm_phase<pg8::EpiResid, pg8::StaticOrder, true, true>(F.lds, g, S, E);
            SEAM(pb + 4);
        }
        if (INL(5)) { FRESH(); ph_xn(F, F.out, mod_l, 3072, 4096); SEAM(pb + 5); }
        if (INL(6)) {
            pg8::Gemm g{(const pg8::bf16_t*)(F.ws + WS_XN), (const pg8::bf16_t*)(wb + W_GU_OFF), MTOK, 2 * FFH, DM}; pg8::StaticOrder S; S.init(MTOK, 2 * FFH, F.G, F.bid);
            pg8::EpiSwiglu E{(pg8::bf16_t*)(F.ws + WS_U), FFH}; pg8::gemm_phase<pg8::EpiSwiglu, pg8::StaticOrder, true, true>(F.lds, g, S, E);
            SEAM(pb + 6);
        }
        if (INL(7)) {
            pg8::Gemm g{(const pg8::bf16_t*)(F.ws + WS_U), (const pg8::bf16_t*)(wb + W_DN_OFF), MTOK, DM, FFH}; pg8::StaticOrder S; S.init(MTOK, DM, F.G, F.bid);
            pg8::EpiResid E{(const float*)F.out, F.out, mod_l + 5120}; pg8::gemm_phase<pg8::EpiResid, pg8::StaticOrder, true, true>(F.lds, g, S, E);
            SEAM(pb + 7);
        }
        if (INL(8)) { FRESH(); if (l + 1 < DEPTH) ph_xn(F, F.out, mod_l + (size_t)NB * 6144, 0, 1024); else ph_final(F); SEAM(pb + 8); }
    }
#undef IN
#undef INL
#undef SEAM
}

extern "C" void kernel_launch(void* const* d_in, const int* in_sizes, int n_in, void* d_out, int out_size, void* d_ws, size_t ws_size, hipStream_t stream) {
    static int grid = 0;
    if (grid == 0) {
        if (n_in != 31 || out_size != MTOK * DM || ws_size < WS_END) { fprintf(stderr, "kernel_launch: unexpected problem shape (n_in %d out %d ws %zu)\n", n_in, out_size, ws_size); grid = -1; return; }
        int dev = 0, cus = 0, per_cu = 0;
        hipGetDevice(&dev); hipDeviceGetAttribute(&cus, hipDeviceAttributeMultiprocessorCount, dev);
        if (hipFuncSetAttribute((const void*)hybrid_fwd, hipFuncAttributeMaxDynamicSharedMemorySize, LDS_BYTES) != hipSuccess) { fprintf(stderr, "kernel_launch: hipFuncSetAttribute failed\n"); grid = -1; return; }
        if (hipOccupancyMaxActiveBlocksPerMultiprocessor(&per_cu, (const void*)hybrid_fwd, NTHR, LDS_BYTES) != hipSuccess || per_cu < 1) { fprintf(stderr, "kernel_launch: occupancy query says %d blocks per CU\n", per_cu); grid = -1; (void)hipGetLastError(); return; }
        grid = cus;
    }
    if (grid < 0) return;
    hipMemsetAsync((char*)d_ws + WS_CTL, 0, CTL_ZERO_BYTES, stream);
    Args a{};
    for (int i = 0; i < 31; ++i) a.in[i] = (const float*)d_in[i];
    a.out = (float*)d_out; a.ws = (unsigned char*)d_ws;
#if MK_MULTI
    for (int p = 0; p < N_PHASES; ++p) { a.ph_lo = p; a.ph_hi = p + 1; hipLaunchKernelGGL(hybrid_fwd, dim3(grid), dim3(NTHR), LDS_BYTES, stream, a); }
#else
    a.ph_lo = 0; a.ph_hi = N_PHASES;
    void* kargs[] = {&a};
    hipError_t e = hipLaunchCooperativeKernel((const void*)hybrid_fwd, dim3(grid), dim3(NTHR), kargs, LDS_BYTES, stream);
    if (e != hipSuccess) fprintf(stderr, "cooperative launch failed: %s (grid %d)\n", hipGetErrorString(e), grid);
#endif
}
```

```cpp
#include <hip/hip_runtime.h>
#include <hip/hip_cooperative_groups.h>
#include <cstdio>
#include <cstdint>
namespace cg = cooperative_groups;
#define MK_MULTI 0
namespace pg8 {
#define PG8_LAS __attribute__((address_space(3)))
typedef unsigned short bf16_t;
typedef short bf16x8 __attribute__((ext_vector_type(8)));
typedef float f32x4 __attribute__((ext_vector_type(4)));
typedef unsigned u32x4 __attribute__((ext_vector_type(4)));
constexpr int BM = 256, BK = 64, HALF = 128, HTB = HALF * BK * 2  , STAGE_BYTES = 8 * HTB, NXCD = 8, WGM = 8;

__host__ __device__ __forceinline__ int lds_byte(int r, int c) { const int st = (r >> 4) * 2 + (c >> 5), rr = r & 15, cc = c & 31, ob = rr * 64 + cc * 2; return st * 1024 + (ob ^ (((ob >> 9) & 1) << 5)); }
__host__ __device__ __forceinline__ void stage_rc(int b, int& R, int& C) { const int st = b / 1024, sb = b % 1024, swz = sb ^ (((sb >> 9) & 1) << 5); R = (st >> 1) * 16 + swz / 64; C = (st & 1) * 32 + (swz % 64) / 2; }
__host__ __device__ __forceinline__ int perm32(int rho) { const int n = rho >> 4, i = rho & 15; return 8 * (i >> 2) + 4 * n + (i & 3); }

struct Unit { int pm, pn, kind; };
struct Gemm { const bf16_t* A; const bf16_t* Bt; int M, N, K; };

struct StaticOrder {
    int nM, nN, nwg, G, c;
    __host__ __device__ void init(int M, int N, int G_, int c_) { nM = M / BM; nN = N / BM; nwg = nM * nN; G = G_; c = c_; }
    __host__ __device__ bool next(int i, Unit& u) const {
        const long L = (long)i * G + c; if (L >= nwg) return false;
        int wgid = (int)L; { const int q = nwg / NXCD, r = nwg % NXCD, xcd = wgid % NXCD, off = wgid / NXCD; wgid = (xcd < r ? xcd * (q + 1) : r * (q + 1) + (xcd - r) * q) + off; }
        const int nig = WGM * nN, gid = wgid / nig, fm = gid * WGM, gsz = (nM - fm) < WGM ? (nM - fm) : WGM;
        u.pm = fm + ((wgid % nig) % gsz); u.pn = (wgid % nig) / gsz; u.kind = 0; return true;
    }
    template <class G_> __device__ __forceinline__ const char* pa(const G_& g, const Unit& u, size_t tstep) const { return (const char*)g.A + (size_t)u.pm * tstep; }
    template <class G_> __device__ __forceinline__ const char* pb(const G_& g, const Unit& u, size_t tstep) const { return (const char*)g.Bt + (size_t)u.pn * tstep; }
    __device__ __forceinline__ void a_ready(const Unit&) const {}
    __device__ __forceinline__ void done(const Unit&) const {}
};

__device__ __forceinline__ unsigned cvt_pk_bf16(float lo, float hi) { unsigned r; asm volatile("v_cvt_pk_bf16_f32 %0, %1, %2" : "=v"(r) : "v"(lo), "v"(hi)); return r; }
constexpr float PG8_EPS = 1e-6f;
constexpr int CVP = 9472;
struct EpiStoreBf16N {
    static constexpr bool PERM = true, AFTER_DRAIN = false;
    bf16_t* O; int ldc; const float* ss; const float* cv;
    __device__ __forceinline__ void operator()(const f32x4 (&acc)[2][2][4][2], const Unit& u, int wr, int wc, int fr, int fq) const {
        const int row0 = u.pm * BM + wr * 64 + fr; const int col0 = u.pn * BM + wc * 32 + 8 * fq;
        const float* cvp = cv + (size_t)((u.pm * BM) >> 11) * CVP + col0;
        f32x4 cvv[2][2];
#pragma unroll
        for (int bj = 0; bj < 2; ++bj)
#pragma unroll
            for (int n = 0; n < 2; ++n) cvv[bj][n] = *(const f32x4*)(cvp + bj * HALF + 4 * n);
#pragma unroll
        for (int ai = 0; ai < 2; ++ai)
#pragma unroll
            for (int m = 0; m < 4; ++m) { const int r = row0 + ai * HALF + m * 16; bf16_t* rowp = O + (size_t)r * ldc + col0;
                const float rs = 1.0f / sqrtf(ss[r] * (1.0f / 1024.0f) + PG8_EPS);
#pragma unroll
                for (int bj = 0; bj < 2; ++bj) { const f32x4 v0 = acc[ai][bj][m][0] * rs + cvv[bj][0], v1 = acc[ai][bj][m][1] * rs + cvv[bj][1];
                    u32x4 w; w.x = cvt_pk_bf16(v0[0], v0[1]); w.y = cvt_pk_bf16(v0[2], v0[3]); w.z = cvt_pk_bf16(v1[0], v1[1]); w.w = cvt_pk_bf16(v1[2], v1[3]);
                    *(u32x4*)(rowp + bj * HALF) = w; } }
    }
};
struct EpiStoreBf16T {
    static constexpr bool PERM = true, AFTER_DRAIN = false;
    bf16_t* O; int ldc; const float* ss; const float* cv;
    __device__ __forceinline__ void operator()(const f32x4 (&acc)[2][2][4][2], const Unit& u, int wr, int wc, int fr, int fq) const {
        const int row0 = u.pm * BM + wr * 64 + fr; const int col0 = u.pn * BM + wc * 32 + 8 * fq;
        const float* cvp = cv + (size_t)((u.pn * BM) >> 11) * CVP;
        f32x4 rsv[2][2];
#pragma unroll
        for (int bj = 0; bj < 2; ++bj)
#pragma unroll
            for (int n = 0; n < 2; ++n) { const f32x4 s4 = *(const f32x4*)(ss + col0 + bj * HALF + 4 * n);
#pragma unroll
                for (int j = 0; j < 4; ++j) rsv[bj][n][j] = 1.0f / sqrtf(s4[j] * (1.0f / 1024.0f) + PG8_EPS); }
#pragma unroll
        for (int ai = 0; ai < 2; ++ai)
#pragma unroll
            for (int m = 0; m < 4; ++m) { const int r = row0 + ai * HALF + m * 16; bf16_t* rowp = O + (size_t)r * ldc + col0; const float c = cvp[r];
#pragma unroll
                for (int bj = 0; bj < 2; ++bj) { const f32x4 v0 = acc[ai][bj][m][0] * rsv[bj][0] + c, v1 = acc[ai][bj][m][1] * rsv[bj][1] + c;
                    u32x4 w; w.x = cvt_pk_bf16(v0[0], v0[1]); w.y = cvt_pk_bf16(v0[2], v0[3]); w.z = cvt_pk_bf16(v1[0], v1[1]); w.w = cvt_pk_bf16(v1[2], v1[3]);
                    *(u32x4*)(rowp + bj * HALF) = w; } }
    }
};
struct EpiResidN {
    static constexpr bool PERM = false, AFTER_DRAIN = false;
    const float* base; float* out; const float* gate; const float* scn; bf16_t* an; float* ss;
    __device__ __forceinline__ void operator()(const f32x4 (&acc)[2][2][4][2], const Unit& u, int wr, int wc, int fr, int fq) const {
        const int col0 = u.pn * BM + wc * 32 + 4 * fq; const size_t bo = (size_t)((u.pm * BM) >> 11) * 6144 + col0;
        f32x4 gv[2][2], sv[2][2];
#pragma unroll
        for (int bj = 0; bj < 2; ++bj)
#pragma unroll
            for (int n = 0; n < 2; ++n) { gv[bj][n] = *(const f32x4*)(gate + bo + bj * HALF + n * 16); sv[bj][n] = an ? *(const f32x4*)(scn + bo + bj * HALF + n * 16) + 1.0f : (f32x4){0.f, 0.f, 0.f, 0.f}; }
#pragma unroll
        for (int ai = 0; ai < 2; ++ai)
#pragma unroll
            for (int m = 0; m < 4; ++m) { const int r = u.pm * BM + ai * HALF + wr * 64 + m * 16 + fr; const size_t off = (size_t)r * 1024 + col0; float q = 0.f;
#pragma unroll
                for (int bj = 0; bj < 2; ++bj)
#pragma unroll
                    for (int n = 0; n < 2; ++n) { const f32x4 bs = *(const f32x4*)(base + off + bj * HALF + n * 16); const f32x4 o = bs + gv[bj][n] * acc[ai][bj][m][n];
                        *(f32x4*)(out + off + bj * HALF + n * 16) = o; q += (o[0] * o[0] + o[1] * o[1]) + (o[2] * o[2] + o[3] * o[3]);
                        if (an) { const f32x4 a = o * sv[bj][n]; typedef unsigned u32x2 __attribute__((ext_vector_type(2))); u32x2 w; w.x = cvt_pk_bf16(a[0], a[1]); w.y = cvt_pk_bf16(a[2], a[3]); *(u32x2*)(an + off + bj * HALF + n * 16) = w; } }
                q += __shfl_xor(q, 16); q += __shfl_xor(q, 32);
                if (fq == 0) atomicAdd(ss + r, q);
                if (m == 3) asm volatile("" ::: "memory"); }
    }
};
__device__ __forceinline__ float silu_f(float v) { return v * __builtin_amdgcn_rcpf(1.0f + __expf(-v)); }
struct EpiSwigluN {
    static constexpr bool PERM = true, AFTER_DRAIN = false;
    bf16_t* O; int ldc; const float* ss; const float* cv;
    __device__ __forceinline__ void operator()(const f32x4 (&acc)[2][2][4][2], const Unit& u, int wr, int wc, int fr, int fq) const {
        const int row0 = u.pm * BM + wr * 64 + fr; const int col0 = u.pn * HALF + wc * 32 + 8 * fq;
        const float* cvp = cv + (size_t)((u.pm * BM) >> 11) * CVP + u.pn * BM + wc * 32 + 8 * fq;
        f32x4 cg[2], cu[2];
#pragma unroll
        for (int n = 0; n < 2; ++n) { cg[n] = *(const f32x4*)(cvp + 4 * n); cu[n] = *(const f32x4*)(cvp + HALF + 4 * n); }
#pragma unroll
        for (int ai = 0; ai < 2; ++ai)
#pragma unroll
            for (int m = 0; m < 4; ++m) { const int r = row0 + ai * HALF + m * 16; bf16_t* rowp = O + (size_t)r * ldc + col0;
                const float rs = 1.0f / sqrtf(ss[r] * (1.0f / 1024.0f) + PG8_EPS);
                const f32x4 g0 = acc[ai][0][m][0] * rs + cg[0], g1 = acc[ai][0][m][1] * rs + cg[1], u0 = acc[ai][1][m][0] * rs + cu[0], u1 = acc[ai][1][m][1] * rs + cu[1];
                u32x4 w;
                w.x = cvt_pk_bf16(silu_f(g0[0]) * u0[0], silu_f(g0[1]) * u0[1]); w.y = cvt_pk_bf16(silu_f(g0[2]) * u0[2], silu_f(g0[3]) * u0[3]);
                w.z = cvt_pk_bf16(silu_f(g1[0]) * u1[0], silu_f(g1[1]) * u1[1]); w.w = cvt_pk_bf16(silu_f(g1[2]) * u1[2], silu_f(g1[3]) * u1[3]);
                *(u32x4*)rowp = w; }
    }
};


struct DualOrder {
    StaticOrder s1, s2; const bf16_t* A2; const bf16_t* Bt2;
    __host__ __device__ void init(int M1, int N1, int M2, int N2, int G_, int c_, const bf16_t* a2, const bf16_t* b2) { s1.init(M1, N1, G_, c_); s2.init(M2, N2, G_, c_); A2 = a2; Bt2 = b2; }
    __device__ __forceinline__ bool next(int i, Unit& u) const {
        const long L = (long)i * s1.G + s1.c;
        if (L < s1.nwg) return s1.next(i, u);
        const long L2 = L - s1.nwg; if (L2 >= s2.nwg) return false;
        StaticOrder t = s2; t.c = (int)(L2 % s2.G); const bool ok = t.next((int)(L2 / s2.G), u); u.kind = 1; return ok;
    }
    template <class G_> __device__ __forceinline__ const char* pa(const G_& g, const Unit& u, size_t tstep) const { return (const char*)(u.kind ? A2 : g.A) + (size_t)u.pm * tstep; }
    template <class G_> __device__ __forceinline__ const char* pb(const G_& g, const Unit& u, size_t tstep) const { return (const char*)(u.kind ? Bt2 : g.Bt) + (size_t)u.pn * tstep; }
    __device__ __forceinline__ void a_ready(const Unit&) const {}
    __device__ __forceinline__ void done(const Unit&) const {}
};
struct EpiDualIn {
    static constexpr bool PERM = true, AFTER_DRAIN = false;
    EpiStoreBf16N a; EpiStoreBf16T b;
    __device__ __forceinline__ void operator()(const f32x4 (&acc)[2][2][4][2], const Unit& u, int wr, int wc, int fr, int fq) const { if (u.kind) b(acc, u, wr, wc, fr, fq); else a(acc, u, wr, wc, fr, fq); }
};
template <class Epi, class Sched, bool ALIGN_EPI = false, bool SP2 = false>
__device__ __forceinline__ void gemm_phase(PG8_LAS unsigned char* lds, const Gemm g, const Sched& S, const Epi& E) {
    int tid_ = threadIdx.x; asm volatile("" : "+v"(tid_));
    const int tid = tid_, wid = __builtin_amdgcn_readfirstlane(tid >> 6), lane = tid & 63, wr = wid >> 2, wc = wid & 3, fr = lane & 15, fq = lane >> 4;
    const int K = g.K, nt = K / BK;
    unsigned voffA[2], voffB[2];
#pragma unroll
    for (int i = 0; i < 2; ++i) { int R, C; stage_rc(tid * 16 + i * 8192, R, C); const int Rb = Epi::PERM ? ((R & ~31) + perm32(R & 31)) : R;
        voffA[i] = (unsigned)(R * K + C) * 2u; voffB[i] = (unsigned)(Rb * K + C) * 2u; }
    const size_t kstep = (size_t)(BK * 2);
    const size_t hstep = (size_t)HALF * K * 2;
    const size_t tstep = 2 * hstep;
    const unsigned ldsw = (unsigned)wid * 1024u;
    const int aoff = lds_byte(wr * 64 + fr, fq * 8), boff = lds_byte(wc * 32 + fr, fq * 8);
#define PG8_SA(b, h) (((b) * 2 + (h)) * HTB)
#define PG8_SB(b, h) ((4 + (b) * 2 + (h)) * HTB)
#define PG8_STAGE(bufoff, gbase, voff) do { _Pragma("unroll") for (int _i = 0; _i < 2; ++_i) \
        __builtin_amdgcn_global_load_lds((const unsigned*)((const char*)(gbase) + (voff)[_i]), (PG8_LAS unsigned*)(lds + (bufoff) + ldsw + _i * 8192), 16, 0, 0); } while (0)
#define PG8_LDA(dst, b, h) do { _Pragma("unroll") for (int m = 0; m < 4; ++m) _Pragma("unroll") for (int k = 0; k < 2; ++k) dst[m][k] = *(const PG8_LAS bf16x8*)(lds + PG8_SA(b, h) + aoff + m * 2048 + k * 1024); } while (0)
#define PG8_LDB(dst, b, h) do { _Pragma("unroll") for (int n = 0; n < 2; ++n) _Pragma("unroll") for (int k = 0; k < 2; ++k) dst[n][k] = *(const PG8_LAS bf16x8*)(lds + PG8_SB(b, h) + boff + n * 2048 + k * 1024); } while (0)
#define PG8_MMA(ai, bj, At, Bt) do { __builtin_amdgcn_s_setprio(1); _Pragma("unroll") for (int m = 0; m < 4; ++m) _Pragma("unroll") for (int n = 0; n < 2; ++n) _Pragma("unroll") for (int k = 0; k < 2; ++k) \
        acc[ai][bj][m][n] = __builtin_amdgcn_mfma_f32_16x16x32_bf16(Bt[n][k], At[m][k], acc[ai][bj][m][n], 0, 0, 0); __builtin_amdgcn_s_setprio(0); } while (0)
#define PG8_WAIT_V(n) asm volatile("s_waitcnt vmcnt(" #n ")" ::: "memory")
#define PG8_WAIT_L(n) asm volatile("s_waitcnt lgkmcnt(" #n ")" ::: "memory")
#define PG8_BAR __builtin_amdgcn_s_barrier()
#define PG8_SCHED __builtin_amdgcn_sched_barrier(0)
    Unit cur, nxt; int ui = 0;
    if (!S.next(0, cur)) return;
    f32x4 acc[2][2][4][2];
#pragma unroll
    for (int a = 0; a < 2; ++a)
#pragma unroll
        for (int b = 0; b < 2; ++b)
#pragma unroll
            for (int m = 0; m < 4; ++m)
#pragma unroll
                for (int n = 0; n < 2; ++n) acc[a][b][m][n] = (f32x4){0.f, 0.f, 0.f, 0.f};
    bf16x8 At[4][2], B0[2][2], B1[2][2];
    const char* cA = S.pa(g, cur, tstep); const char* cB = S.pb(g, cur, tstep);
    S.a_ready(cur);
    if constexpr (SP2) {
        PG8_STAGE(PG8_SB(0, 0), cB, voffB); PG8_STAGE(PG8_SB(0, 1), cB + hstep, voffB); PG8_STAGE(PG8_SA(0, 0), cA, voffA); PG8_STAGE(PG8_SA(0, 1), cA + hstep, voffA);
        if (wr == 1) PG8_BAR;
        PG8_WAIT_V(2); PG8_BAR;
        PG8_STAGE(PG8_SB(1, 0), cB + kstep, voffB); PG8_STAGE(PG8_SA(1, 0), cA + kstep, voffA); PG8_STAGE(PG8_SB(1, 1), cB + hstep + kstep, voffB);
        PG8_WAIT_V(6); PG8_BAR;
    } else {
        PG8_STAGE(PG8_SB(0, 0), cB, voffB); PG8_STAGE(PG8_SA(0, 0), cA, voffA); PG8_STAGE(PG8_SB(0, 1), cB + hstep, voffB); PG8_STAGE(PG8_SA(0, 1), cA + hstep, voffA);
        if (wr == 1) PG8_BAR;
        PG8_WAIT_V(4); PG8_BAR;
        PG8_STAGE(PG8_SB(1, 0), cB + kstep, voffB); PG8_STAGE(PG8_SA(1, 0), cA + kstep, voffA); PG8_STAGE(PG8_SB(1, 1), cB + hstep + kstep, voffB);
        PG8_WAIT_V(6); PG8_BAR;
    }
    for (;;) {
        const bool has_next = S.next(ui + 1, nxt);
        const char* nA = has_next ? S.pa(g, nxt, tstep) : cA; const char* nB = has_next ? S.pb(g, nxt, tstep) : cB;
        for (int t = 0; t < nt; t += 2) {
            const bool last = (t == nt - 2);
            const char* a1 = cA + (size_t)(t + 1) * kstep;
            const char* a2 = last ? nA : cA + (size_t)(t + 2) * kstep; const char* b2 = last ? nB : cB + (size_t)(t + 2) * kstep;
            const char* a3 = a2 + kstep; const char* b3 = b2 + kstep;
            if (last && has_next) S.a_ready(nxt);
            if constexpr (SP2) {
            PG8_LDB(B0, 0, 0); PG8_LDB(B1, 0, 1); PG8_SCHED; PG8_LDA(At, 0, 0); PG8_STAGE(PG8_SA(1, 1), a1 + hstep, voffA);
            PG8_WAIT_V(8); PG8_WAIT_L(0); PG8_BAR; PG8_MMA(0, 0, At, B0); PG8_MMA(0, 1, At, B1); PG8_BAR; PG8_SCHED;
            PG8_LDA(At, 0, 1); PG8_STAGE(PG8_SB(0, 0), b2, voffB); PG8_STAGE(PG8_SB(0, 1), b2 + hstep, voffB); PG8_STAGE(PG8_SA(0, 0), a2, voffA);
            PG8_WAIT_V(8); PG8_WAIT_L(0); PG8_BAR; PG8_MMA(1, 0, At, B0); PG8_MMA(1, 1, At, B1); PG8_BAR; PG8_SCHED;
            PG8_LDB(B0, 1, 0); PG8_LDB(B1, 1, 1); PG8_SCHED; PG8_LDA(At, 1, 0); PG8_STAGE(PG8_SA(0, 1), a2 + hstep, voffA);
            PG8_WAIT_V(8); PG8_WAIT_L(0); PG8_BAR; PG8_MMA(0, 0, At, B0); PG8_MMA(0, 1, At, B1); PG8_BAR; PG8_SCHED;
            PG8_LDA(At, 1, 1); PG8_STAGE(PG8_SB(1, 0), b3, voffB); PG8_STAGE(PG8_SB(1, 1), b3 + hstep, voffB); PG8_STAGE(PG8_SA(1, 0), a3, voffA);
            PG8_WAIT_V(8); PG8_WAIT_L(0); PG8_BAR; PG8_MMA(1, 0, At, B0); PG8_MMA(1, 1, At, B1); PG8_BAR; PG8_SCHED;
            } else {
            PG8_LDB(B0, 0, 0); PG8_SCHED; PG8_LDA(At, 0, 0); PG8_STAGE(PG8_SA(1, 1), a1 + hstep, voffA);
            PG8_WAIT_L(8); PG8_BAR; PG8_WAIT_L(0); PG8_MMA(0, 0, At, B0); PG8_BAR; PG8_SCHED;
            PG8_LDB(B1, 0, 1); PG8_STAGE(PG8_SB(0, 0), b2, voffB);
            PG8_BAR; PG8_WAIT_L(0); PG8_MMA(0, 1, At, B1); PG8_BAR;
            PG8_LDA(At, 0, 1); PG8_STAGE(PG8_SA(0, 0), a2, voffA);
            PG8_BAR; PG8_WAIT_L(0); PG8_MMA(1, 0, At, B0); PG8_BAR; PG8_SCHED;
            PG8_STAGE(PG8_SB(0, 1), b2 + hstep, voffB);
            PG8_WAIT_V(6); PG8_BAR; PG8_MMA(1, 1, At, B1); PG8_BAR;
            PG8_LDB(B0, 1, 0); PG8_SCHED; PG8_LDA(At, 1, 0); PG8_STAGE(PG8_SA(0, 1), a2 + hstep, voffA);
            PG8_WAIT_L(8); PG8_BAR; PG8_WAIT_L(0); PG8_MMA(0, 0, At, B0); PG8_BAR; PG8_SCHED;
            PG8_LDB(B1, 1, 1); PG8_STAGE(PG8_SB(1, 0), b3, voffB);
            PG8_BAR; PG8_WAIT_L(0); PG8_MMA(0, 1, At, B1); PG8_BAR;
            PG8_LDA(At, 1, 1); PG8_STAGE(PG8_SA(1, 0), a3, voffA);
            PG8_BAR; PG8_WAIT_L(0); PG8_MMA(1, 0, At, B0); PG8_BAR; PG8_SCHED;
            PG8_STAGE(PG8_SB(1, 1), b3 + hstep, voffB);
            PG8_WAIT_V(6); PG8_BAR; PG8_MMA(1, 1, At, B1); PG8_BAR;
            }
        }
        if constexpr (ALIGN_EPI) { if (wr == 0) PG8_BAR; }
        if constexpr (!Epi::AFTER_DRAIN) { E(acc, cur, wr, wc, fr, fq); S.done(cur); }
        if (!has_next) break;
#pragma unroll
        for (int a = 0; a < 2; ++a)
#pragma unroll
            for (int b = 0; b < 2; ++b)
#pragma unroll
                for (int m = 0; m < 4; ++m)
#pragma unroll
                    for (int n = 0; n < 2; ++n) acc[a][b][m][n] = (f32x4){0.f, 0.f, 0.f, 0.f};
        cur = nxt; cA = nA; cB = nB; ++ui;
        if constexpr (ALIGN_EPI) { if (wr == 1) PG8_BAR; }
    }
    PG8_WAIT_V(0);
    if constexpr (!ALIGN_EPI) { if (wr == 0) PG8_BAR; }
    PG8_BAR;
    if constexpr (Epi::AFTER_DRAIN) { E.fused(acc, cur, wr, wc, fr, fq, lds, wid, lane); S.done(cur); }
#undef PG8_SA
#undef PG8_SB
#undef PG8_STAGE
#undef PG8_LDA
#undef PG8_LDB
#undef PG8_MMA
#undef PG8_WAIT_V
#undef PG8_WAIT_L
#undef PG8_BAR
#undef PG8_SCHED
}
}

constexpr int NB = 16, SEQ = 2048, DM = 1024, MTOK = NB * SEQ, DEPTH = 2;
constexpr int P_IN = 3608, FFH = 2816, UL = 2816, NTR = 1024;
constexpr int C_SZ = 0, C_SX = 256, C_SB = 512, C_SC = 768, C_NQ = 1024, C_NK = 1280, C_MQ = 1536, C_MK = 1792, C_MV = 2048, C_MO = 2304, C_G = 2560;
constexpr int TP = MTOK + 128;
constexpr int R_HY = 0, R_NV = 768;
constexpr float EPS = 1e-6f;
constexpr int NWAVES = 8, NTHR = 512;
constexpr size_t MiB = 1u << 20;
constexpr size_t WS_CTL = 0, WS_SS = 64 * 1024, CTL_ZERO_BYTES = 64 * 1024 + 5 * 131072;
constexpr size_t WS_MOD = 1 * MiB, WS_HID2 = 2 * MiB, WS_DT = 3 * MiB, WS_FILT = 4 * MiB, WS_W = 12 * MiB;
constexpr size_t W_IN_OFF = 0, W_HY_OFF = 5 * MiB + MiB / 2, W_OUT_OFF = 7 * MiB + MiB / 2, W_GU_OFF = 9 * MiB + MiB / 2, W_DN_OFF = 20 * MiB + MiB / 2, W_LAYER = 26 * MiB;
constexpr size_t WS_XN = 64 * MiB, WS_U = 128 * MiB, WS_UHT = 320 * MiB, WS_YS = 386 * MiB, WS_NAO = 418 * MiB, WS_MLH = 434 * MiB, WS_HYO = 466 * MiB, WS_CV = 484 * MiB, WS_END = 486 * MiB;
constexpr size_t WS_XN2 = WS_UHT;
constexpr int CVP = 9472;
constexpr int LDS_BYTES = 147456, MISC_OFF = 147456 - 128;

#define GAS __attribute__((address_space(1)))
#define LAS __attribute__((address_space(3)))
typedef unsigned short bf16;
typedef unsigned v4u __attribute__((ext_vector_type(4)));
typedef float f32x4 __attribute__((ext_vector_type(4)));
typedef __bf16 bf16v2 __attribute__((ext_vector_type(2)));
typedef float f32v2 __attribute__((ext_vector_type(2)));
__device__ __forceinline__ unsigned pk2(float lo, float hi) { const f32v2 v = {lo, hi}; return __builtin_bit_cast(unsigned, __builtin_convertvector(v, bf16v2)); }
__device__ __forceinline__ unsigned f2bf(float f) { return (unsigned)__builtin_bit_cast(unsigned short, (__bf16)f); }
__device__ __forceinline__ float bf2f(unsigned h) { return __builtin_bit_cast(float, h << 16); }
__device__ __forceinline__ float bflo(unsigned w) { return __builtin_bit_cast(float, w << 16); }
__device__ __forceinline__ float bfhi(unsigned w) { return __builtin_bit_cast(float, w & 0xffff0000u); }
__device__ __forceinline__ float wave_sum(float v) {
#pragma unroll
    for (int o = 1; o < 64; o <<= 1) v += __shfl_xor(v, o);
    return v;
}
__device__ __forceinline__ float wave_max(float v) {
#pragma unroll
    for (int o = 1; o < 64; o <<= 1) v = fmaxf(v, __shfl_xor(v, o));
    return v;
}
__device__ __forceinline__ float sigmoid_f(float v) { return 1.0f / (1.0f + __expf(-v)); }
__device__ __forceinline__ float silu_ff(float v) { return v / (1.0f + __expf(-v)); }
__device__ __forceinline__ float softplus_f(float v) { return v > 20.f ? v : log1pf(__expf(v)); }

__device__ __forceinline__ int fresh_tid() { int t = threadIdx.x; asm volatile("" : "+v"(t)); return t; }
typedef short bf16x8 __attribute__((ext_vector_type(8)));
#define MFMA16(a, b, c) __builtin_amdgcn_mfma_f32_16x16x32_bf16((a), (b), (c), 0, 0, 0)
struct Args { const float* in[31]; float* out; unsigned char* ws; int ph_lo, ph_hi; };

struct Ctx {
    LAS unsigned char* lds;
    int tid, lane, wave, bid, G;
    const Args* A; float* out; unsigned char* ws;
};
#define INP(i) (F.A->in[i])

__device__ __forceinline__ const float* wsrc(const Ctx& F, int which, int l, int j, int* ld) {
    if (which == 0) { *ld = P_IN; const float* w = INP(4) + (size_t)l * DM * P_IN;
        int o; if (j < 1024) o = j; else if (j < 1536) o = 1032 + (j - 1024); else if (j < 2560) o = 1800 + (j - 1536); else if (j < 2568) o = 1024 + (j - 2560); else if (j < 2584) o = 2824 + (j - 2568); else return nullptr;
        return w + o; }
    if (which == 1) { *ld = P_IN; return INP(4) + (size_t)l * DM * P_IN + (j < 768 ? 2840 + j : 1544 + (j - 768)); }
    if (which == 2) { *ld = DM; return INP(26) + (size_t)l * DM * DM + j; }
    if (which == 3) { *ld = FFH; const int t = j >> 8, w = j & 255; return (w < 128 ? INP(27) : INP(28)) + (size_t)l * DM * FFH + t * 128 + (w & 127); }
    *ld = DM; return INP(29) + (size_t)l * FFH * DM + j;
}
__device__ __forceinline__ void transpose_item(const Ctx& F, int which, int l, int K, bf16* WT, LAS float* scr, int item, int nblk) {
    const int lane = F.lane, kb = item / nblk, nb = item % nblk, k0 = 64 * kb, n0 = 32 * nb;
    int ld = 0; const float* cp = wsrc(F, which, l, n0 + (lane & 31), &ld);
    float tv[32];
#pragma unroll
    for (int i = 0; i < 32; ++i) { const int kk = 2 * i + (lane >> 5); tv[i] = cp ? cp[(size_t)(k0 + kk) * ld] : 0.f; }
#pragma unroll
    for (int i = 0; i < 32; ++i) { const int kk = 2 * i + (lane >> 5); scr[kk * 33 + (lane & 31)] = tv[i]; }
    asm volatile("s_waitcnt lgkmcnt(0)" ::: "memory");
    const int c = lane & 7;
#pragma unroll
    for (int j = 0; j < 4; ++j) { const int n = (lane >> 3) + 8 * j; const LAS float* s = scr + (8 * c) * 33 + n;
        v4u o; o.x = pk2(s[0 * 33], s[1 * 33]); o.y = pk2(s[2 * 33], s[3 * 33]); o.z = pk2(s[4 * 33], s[5 * 33]); o.w = pk2(s[6 * 33], s[7 * 33]);
        *(v4u*)(WT + (size_t)(n0 + n) * K + k0 + 8 * c) = o; }
    asm volatile("s_waitcnt lgkmcnt(0)" ::: "memory");
}
__device__ __forceinline__ void ph_prologue(Ctx& F) {
    const int gw = F.bid * NWAVES + F.wave, NGW = F.G * NWAVES, lane = F.lane;
    LAS float* scr = (LAS float*)(F.lds + F.wave * 16384);
    constexpr int I_IN = 16 * 88, I_HY = 16 * 32, I_OUT = 16 * 32, I_GU = 16 * 176, I_DN = 44 * 32, I_L = I_IN + I_HY + I_OUT + I_GU + I_DN;
    for (int it = gw; it < DEPTH * I_L; it += NGW) {
        const int l = it / I_L; int r = it % I_L; unsigned char* wb = F.ws + WS_W + (size_t)l * W_LAYER;
        if (r < I_IN) { transpose_item(F, 0, l, DM, (bf16*)(wb + W_IN_OFF), scr, r, 88); continue; } r -= I_IN;
        if (r < I_HY) { transpose_item(F, 1, l, DM, (bf16*)(wb + W_HY_OFF), scr, r, 32); continue; } r -= I_HY;
        if (r < I_OUT) { transpose_item(F, 2, l, DM, (bf16*)(wb + W_OUT_OFF), scr, r, 32); continue; } r -= I_OUT;
        if (r < I_GU) { transpose_item(F, 3, l, DM, (bf16*)(wb + W_GU_OFF), scr, r, 176); continue; } r -= I_GU;
        transpose_item(F, 4, l, FFH, (bf16*)(wb + W_DN_OFF), scr, r, 32);
    }
    for (int it = gw; it < DEPTH * SEQ; it += NGW) {
        const int l = it / SEQ, pos = it % SEQ;
        const float* w1 = INP(18) + l * 33 * 64; const float* b1 = INP(19) + l * 64; const float* w2 = INP(20) + l * 64 * 64; const float* b2 = INP(21) + l * 64; const float* fq = INP(23) + l * 128;
        const float t = (float)pos / 2047.0f;
        float z = b1[lane] + t * w1[lane];
        const float a = 6.283185307179586f * ((float)pos / 2048.0f);
#pragma unroll
        for (int i = 0; i < 16; ++i) { const float f = 1e-4f + (float)i * ((15.0f - 1e-4f) / 15.0f); const float ang = a * f;
            z += cosf(ang) * w1[(1 + i) * 64 + lane]; z -= sinf(ang) * w1[(17 + i) * 64 + lane]; }
        const float h1 = sinf(fq[lane] * z);
        float z2 = b2[lane];
        for (int i = 0; i < 64; ++i) z2 += __shfl(h1, i) * w2[i * 64 + lane];
        const float h2 = sinf(fq[64 + lane] * z2);
        ((float*)(F.ws + WS_HID2))[(size_t)it * 64 + lane] = h2;
    }
    __syncthreads();
    LAS float* cond = (LAS float*)F.lds; LAS float* part = (LAS float*)(F.lds + 65536);
    if (F.bid < 192) {
        for (int i = F.tid; i < NB * DM; i += NTHR) cond[i] = silu_ff(INP(1)[i]);
        __syncthreads();
        for (int it = F.bid; it < 192; it += F.G) {
            const int l = it / 96, n0 = (it % 96) * 64;
            const float* W = INP(2) + (size_t)l * DM * 6144 + n0 + lane;
            float acc[16];
#pragma unroll
            for (int b = 0; b < 16; ++b) acc[b] = 0.f;
            const int kb = F.wave * 128;
            for (int k8 = 0; k8 < 128; k8 += 16) { float wv[16];
#pragma unroll
                for (int j = 0; j < 16; ++j) wv[j] = W[(size_t)(kb + k8 + j) * 6144];
#pragma unroll
                for (int j = 0; j < 16; ++j)
#pragma unroll
                    for (int b = 0; b < 16; ++b) acc[b] += cond[b * DM + kb + k8 + j] * wv[j]; }
#pragma unroll
            for (int b = 0; b < 16; ++b) part[(F.wave * 16 + b) * 64 + lane] = acc[b];
            __syncthreads();
            for (int o = F.tid; o < 1024; o += NTHR) { const int b = o >> 6, cidx = o & 63; float s = INP(3)[l * 6144 + n0 + cidx];
#pragma unroll
                for (int w = 0; w < 8; ++w) s += part[(w * 16 + b) * 64 + cidx];
                ((float*)(F.ws + WS_MOD))[(size_t)(l * NB + b) * 6144 + n0 + cidx] = s; }
            __syncthreads();
        }
    }
}

__device__ __forceinline__ void ph_xn0(Ctx& F, const float* mod_l) {
    const int gw = F.bid * NWAVES + F.wave, NGW = F.G * NWAVES;
    bf16* XN = (bf16*)(F.ws + WS_XN); float* ss = (float*)(F.ws + WS_SS);
    for (int m0 = gw * 4; m0 < MTOK; m0 += NGW * 4) {
        f32x4 v[4][4], sc[4][4];
#pragma unroll
        for (int u = 0; u < 4; ++u) { const int m = m0 + u; const f32x4* xr = (const f32x4*)(INP(0) + (size_t)m * DM) + F.lane; const float* mb = mod_l + (size_t)(m >> 11) * 6144 + 1024;
#pragma unroll
            for (int j = 0; j < 4; ++j) { v[u][j] = xr[64 * j]; sc[u][j] = *((const f32x4*)mb + F.lane + 64 * j); } }
#pragma unroll
        for (int u = 0; u < 4; ++u) { const int m = m0 + u; float s = 0.f;
#pragma unroll
            for (int j = 0; j < 4; ++j) s += (v[u][j].x * v[u][j].x + v[u][j].y * v[u][j].y) + (v[u][j].z * v[u][j].z + v[u][j].w * v[u][j].w);
            s = wave_sum(s); if (F.lane == 0) ss[m] = s;
            unsigned long long* o8 = (unsigned long long*)(XN + (size_t)m * DM) + F.lane;
#pragma unroll
            for (int j = 0; j < 4; ++j) o8[64 * j] = (unsigned long long)pk2(v[u][j].x * (1.f + sc[u][j].x), v[u][j].y * (1.f + sc[u][j].y)) | ((unsigned long long)pk2(v[u][j].z * (1.f + sc[u][j].z), v[u][j].w * (1.f + sc[u][j].w)) << 32); }
    }
}
__device__ __forceinline__ void ph_final(Ctx& F) {
    const float* g = INP(30); const float* ss = (const float*)(F.ws + WS_SS) + 4 * MTOK;
    const int gt = F.bid * NTHR + F.tid, NT = F.G * NTHR;
    for (int i0 = gt; i0 < MTOK * (DM / 4); i0 += 8 * NT) { f32x4 xv[8]; float sv[8];
#pragma unroll
        for (int u = 0; u < 8; ++u) { const int i = i0 + u * NT; xv[u] = ((const f32x4*)F.out)[i]; sv[u] = ss[i >> 8]; }
#pragma unroll
        for (int u = 0; u < 8; ++u) { const int i = i0 + u * NT; ((f32x4*)F.out)[i] = xv[u] * (1.0f / sqrtf(sv[u] * (1.f / DM) + EPS)) * *((const f32x4*)g + (i & 255)); } }
}
__device__ __forceinline__ void ph_cvec(Ctx& F) {
    const int gw = F.bid * NWAVES + F.wave, NGW = F.G * NWAVES, lane = F.lane, fr = lane & 15, fg = lane >> 4;
    for (int it = gw; it < DEPTH * (CVP / 16); it += NGW) {
        const int l = it / (CVP / 16), n0 = (it % (CVP / 16)) * 16; unsigned char* wb = F.ws + WS_W + (size_t)l * W_LAYER;
        const bf16* wt = n0 < 2816 ? (const bf16*)(wb + W_IN_OFF) + (size_t)n0 * DM : n0 < 3840 ? (const bf16*)(wb + W_HY_OFF) + (size_t)(n0 - 2816) * DM : (const bf16*)(wb + W_GU_OFF) + (size_t)(n0 - 3840) * DM;
        const float* sh = (const float*)(F.ws + WS_MOD) + (size_t)(l * NB + fr) * 6144 + (n0 < 3840 ? 0 : 3072) + 8 * fg;
        const bf16* wp = wt + (size_t)fr * DM + 8 * fg;
        f32x4 acc = (f32x4){0.f, 0.f, 0.f, 0.f};
#pragma unroll 8
        for (int ks = 0; ks < 32; ++ks) { const f32x4 a0 = *(const f32x4*)(sh + 32 * ks), a1 = *(const f32x4*)(sh + 32 * ks + 4);
            v4u aw; aw[0] = pk2(a0[0], a0[1]); aw[1] = pk2(a0[2], a0[3]); aw[2] = pk2(a1[0], a1[1]); aw[3] = pk2(a1[2], a1[3]);
            acc = MFMA16(__builtin_bit_cast(bf16x8, aw), *(const bf16x8*)(wp + 32 * ks), acc); }
        float* cvo = (float*)(F.ws + WS_CV) + (size_t)l * NB * CVP + n0 + fr;
#pragma unroll
        for (int r = 0; r < 4; ++r) cvo[(size_t)(4 * fg + r) * CVP] = acc[r];
    }
}

__device__ __forceinline__ void ph_filters(Ctx& F) {
    const int lane = F.lane, fr = lane & 15, fg = lane >> 4, w = F.wave;
    for (int it = F.bid; it < DEPTH * 2 * 32; it += F.G) {
        const int l = it >> 6, o = (it >> 5) & 1, co = it & 31;
        const int dir = fr >> 3, ch = co * 8 + (fr & 7);
        const float* w3 = INP(22) + (size_t)l * 64 * 1024 + o * 512 + dir * 256 + ch;
        bf16x8 bw[2], bwl[2];
#pragma unroll
        for (int ks = 0; ks < 2; ++ks) { v4u pw, pl;
#pragma unroll
            for (int e = 0; e < 4; ++e) { const float x0 = w3[(size_t)(32 * ks + 8 * fg + 2 * e) * 1024], x1 = w3[(size_t)(32 * ks + 8 * fg + 2 * e + 1) * 1024];
                pw[e] = pk2(x0, x1); pl[e] = pk2(x0 - bflo(pw[e]), x1 - bfhi(pw[e])); }
            bw[ks] = __builtin_bit_cast(bf16x8, pw); bwl[ks] = __builtin_bit_cast(bf16x8, pl); }
        const float delta = 3.0701134573253945f + (float)ch * ((15.350567286626972f - 3.0701134573253945f) / 255.0f);
        const float* hid = (const float*)(F.ws + WS_HID2) + (size_t)l * SEQ * 64 + (size_t)(256 * w + fr) * 64 + 8 * fg;
        float ss = 0.f;
        LAS f32x4* vals = (LAS f32x4*)F.lds + (size_t)w * 16 * 64 + lane;
#pragma unroll 2
        for (int ii = 0; ii < 16; ++ii) { const float* hp = hid + (size_t)(16 * ii) * 64;
            const f32x4 h0 = *(const f32x4*)hp, h1 = *(const f32x4*)(hp + 4), h2 = *(const f32x4*)(hp + 32), h3 = *(const f32x4*)(hp + 36);
            v4u pa, pb, qa, qb;
#pragma unroll
            for (int e = 0; e < 2; ++e) { pa[e] = pk2(h0[2 * e], h0[2 * e + 1]); pa[2 + e] = pk2(h1[2 * e], h1[2 * e + 1]); pb[e] = pk2(h2[2 * e], h2[2 * e + 1]); pb[2 + e] = pk2(h3[2 * e], h3[2 * e + 1]);
                qa[e] = pk2(h0[2 * e] - bflo(pa[e]), h0[2 * e + 1] - bfhi(pa[e])); qa[2 + e] = pk2(h1[2 * e] - bflo(pa[2 + e]), h1[2 * e + 1] - bfhi(pa[2 + e]));
                qb[e] = pk2(h2[2 * e] - bflo(pb[e]), h2[2 * e + 1] - bfhi(pb[e])); qb[2 + e] = pk2(h3[2 * e] - bflo(pb[2 + e]), h3[2 * e + 1] - bfhi(pb[2 + e])); }
            f32x4 a = (f32x4){0.f, 0.f, 0.f, 0.f};
            a = MFMA16(__builtin_bit_cast(bf16x8, qa), bw[0], a); a = MFMA16(__builtin_bit_cast(bf16x8, qb), bw[1], a);
            a = MFMA16(__builtin_bit_cast(bf16x8, pa), bwl[0], a); a = MFMA16(__builtin_bit_cast(bf16x8, pb), bwl[1], a);
            a = MFMA16(__builtin_bit_cast(bf16x8, pa), bw[0], a); a = MFMA16(__builtin_bit_cast(bf16x8, pb), bw[1], a);
#pragma unroll
            for (int r = 0; r < 4; ++r) { const int p = 256 * w + 16 * ii + 4 * fg + r; a[r] *= __expf(-((float)p / 2047.0f) * delta); ss += a[r] * a[r]; }
            vals[ii * 64] = a; }
        ss += __shfl_xor(ss, 8); ss += __shfl_xor(ss, 16); ss += __shfl_xor(ss, 32);
        LAS float* red = (LAS float*)(F.lds + 131072);
        __syncthreads();
        if (lane < 8) red[w * 8 + lane] = ss;
        __syncthreads();
        float tot = 0.f;
#pragma unroll
        for (int q = 0; q < 8; ++q) tot += red[q * 8 + (fr & 7)];
        const float scale = 1.0f / sqrtf(tot + EPS);
        bf16* fo = (bf16*)(F.ws + WS_FILT) + ((size_t)((l * 2 + o) * 256 + ch)) * 4096 + 2048;
#pragma unroll 2
        for (int ii = 0; ii < 16; ++ii) { const f32x4 a = vals[ii * 64];
#pragma unroll
            for (int r = 0; r < 4; ++r) { const int p = 256 * w + 16 * ii + 4 * fg + r; const unsigned short v = (unsigned short)f2bf(a[r] * scale);
                const bool unused = dir == 1 && p == 0;
                fo[unused ? -2048 : (dir == 0 ? -p : p)] = unused ? (unsigned short)0 : v; } }
    }
}

__device__ __forceinline__ void ph_prepass(Ctx& F, int l) {
    const bf16* U = (const bf16*)(F.ws + WS_U); bf16* XBC = (bf16*)(F.ws + WS_XN); float* DT = (float*)(F.ws + WS_DT);
    const float* cw = INP(5) + l * 3 * 768; const float* cb = INP(6) + l * 768; const float* dtb = INP(7) + l * 8;
    const int gt = F.bid * NTHR + F.tid, NT = F.G * NTHR;
    for (int it0 = gt; it0 < MTOK * 96; it0 += 4 * NT) {
        v4u um[4], u0[4], upn[4];
#pragma unroll
        for (int u = 0; u < 4; ++u) { const int it = it0 + u * NT, tok = it / 96, cg = it % 96; const bf16* up = U + (size_t)tok * UL + C_SX + cg * 8;
            um[u] = *(const v4u*)(up - UL); u0[u] = *(const v4u*)up; upn[u] = *(const v4u*)(up + UL); }
#pragma unroll
        for (int u = 0; u < 4; ++u) { const int it = it0 + u * NT, tok = it / 96, cg = it % 96, t = tok & (SEQ - 1), c0 = cg * 8;
            const v4u z4 = {0u, 0u, 0u, 0u}; const v4u a = t > 0 ? um[u] : z4, b = u0[u], cc = t < SEQ - 1 ? upn[u] : z4;
            float r[8];
#pragma unroll
            for (int q = 0; q < 4; ++q) {
                const int c = c0 + 2 * q;
                const float a0 = cw[c] * bflo(a[q]) + cw[768 + c] * bflo(b[q]) + cw[1536 + c] * bflo(cc[q]) + cb[c];
                const float a1 = cw[c + 1] * bfhi(a[q]) + cw[768 + c + 1] * bfhi(b[q]) + cw[1536 + c + 1] * bfhi(cc[q]) + cb[c + 1];
                r[2 * q] = silu_ff(a0); r[2 * q + 1] = silu_ff(a1); }
            v4u o; o.x = pk2(r[0], r[1]); o.y = pk2(r[2], r[3]); o.z = pk2(r[4], r[5]); o.w = pk2(r[6], r[7]);
            *(v4u*)(XBC + (size_t)tok * 768 + c0) = o; }
    }
    for (int it = gt; it < MTOK * 8; it += NT) { const int tok = it >> 3, j = it & 7;
        DT[it] = softplus_f(bf2f(U[(size_t)tok * UL + C_G + j]) + dtb[j]); }
}

typedef short s16x4 __attribute__((ext_vector_type(4)));
typedef unsigned u2v __attribute__((ext_vector_type(2)));
__device__ __forceinline__ bf16x8 lds_b128(LAS unsigned char* p) { return *(LAS bf16x8*)p; }
__device__ __forceinline__ bf16x8 lds_tr8(LAS unsigned char* base, int pitch, int lane) {
    const int fg = lane >> 4, q = (lane & 15) >> 2, p = lane & 3;
    LAS unsigned char* a = base + (8 * fg + q) * pitch + 8 * p;
    const s16x4 lo = __builtin_amdgcn_ds_read_tr16_b64_v4i16((LAS s16x4*)a);
    const s16x4 hi = __builtin_amdgcn_ds_read_tr16_b64_v4i16((LAS s16x4*)(a + 4 * pitch));
    bf16x8 r; r[0] = lo[0]; r[1] = lo[1]; r[2] = lo[2]; r[3] = lo[3]; r[4] = hi[0]; r[5] = hi[1]; r[6] = hi[2]; r[7] = hi[3]; return r;
}
__device__ __forceinline__ float wave_incl_sum(float a, int lane) {
#pragma unroll
    for (int o = 1; o < 64; o <<= 1) { const float t = __shfl_up(a, o); if (lane >= o) a += t; }
    return a;
}
__device__ __forceinline__ float wave_incl_max(float a, int lane) {
#pragma unroll
    for (int o = 1; o < 64; o <<= 1) { const float t = __shfl_up(a, o); if (lane >= o) a = fmaxf(a, t); }
    return a;
}
constexpr int SP_C = 272, SP_X = 144;
constexpr int SB_CS = 0, SB_BS = 17408, SB_XD = 34816, SB_XW = 44032, SB_SIZE = 53248, S_SC = 106496, S_SBF = 115712;
__device__ __forceinline__ void ssd_item(Ctx& F, int l, int it) {
    const int b = it >> 3, dir = (it >> 2) & 1, h = it & 3, grp = h >> 1;
    const int tid = F.tid, lane = F.lane, w = F.wave, fr = lane & 15, fg = lane >> 4, tb = w >> 1, half = w & 1;
    const bf16* XBC = (const bf16*)(F.ws + WS_XN); const float* DT = (const float*)(F.ws + WS_DT);
    bf16* YS = (bf16*)(F.ws + WS_YS) + (size_t)dir * MTOK * 256;
    const float A = -__expf(INP(8)[l * 8 + dir * 4 + h]); const float Dk = dir == 0 ? INP(9)[l * 4 + h] : 0.f;
    LAS unsigned char* L = F.lds;
#define SSD_TOK(c, tau) ((size_t)b * SEQ + (dir ? SEQ - 1 - ((c) * 64 + (tau)) : (c) * 64 + (tau)))
    f32x4 sacc[4];
#pragma unroll
    for (int i = 0; i < 4; ++i) sacc[i] = (f32x4){0.f, 0.f, 0.f, 0.f};
    for (int i = tid; i < 17408 / 16; i += NTHR) *(LAS v4u*)(L + S_SBF + 16 * i) = (v4u){0u, 0u, 0u, 0u};
    v4u pc0[2], pbv0[2], px0, pc1[2], pbv1[2], px1; float pdt0, pdt1;
#define SSD_LOAD(c, S) do { \
        _Pragma("unroll") for (int k = 0; k < 2; ++k) { const int idx = tid + 512 * k, tau = idx >> 4, ch = idx & 15; const bf16* rp = XBC + SSD_TOK(c, tau) * 768 + grp * 128 + 8 * ch; \
            pbv##S[k] = *(const v4u*)(rp + 256); pc##S[k] = *(const v4u*)(rp + 512); } \
        { const int tau = tid >> 3, ch = tid & 7; px##S = *(const v4u*)(XBC + SSD_TOK(c, tau) * 768 + h * 64 + 8 * ch); } \
        pdt##S = DT[SSD_TOK(c, lane) * 8 + dir * 4 + h]; } while (0)
#define SSD_STAGE(bo, dtv, acum, alast, S) do { \
        _Pragma("unroll") for (int k = 0; k < 2; ++k) { const int idx = tid + 512 * k, tau = idx >> 4, ch = idx & 15; \
            *(LAS v4u*)(L + (bo) + SB_BS + tau * SP_C + ch * 16) = pbv##S[k]; *(LAS v4u*)(L + (bo) + SB_CS + tau * SP_C + ch * 16) = pc##S[k]; } \
        { const int tau = tid >> 3, ch = tid & 7; const float dts = __shfl(dtv, tau), es = __expf((alast) - __shfl(acum, tau)) * dts; v4u od, ow; \
          _Pragma("unroll") for (int e = 0; e < 4; ++e) { const float x0 = bflo(px##S[e]), x1 = bfhi(px##S[e]); od[e] = pk2(x0 * dts, x1 * dts); ow[e] = pk2(x0 * es, x1 * es); } \
          *(LAS v4u*)(L + (bo) + SB_XD + tau * SP_X + ch * 16) = od; *(LAS v4u*)(L + (bo) + SB_XW + tau * SP_X + ch * 16) = ow; } } while (0)
#define SSD_CHUNK(c, CS, NS) do { \
        const int bo = ((c) & 1) * SB_SIZE; \
        __syncthreads();                                                       \
        if ((c) + 2 < 32) SSD_LOAD((c) + 2, CS); \
        bf16x8 ca[4]; \
        _Pragma("unroll") for (int ks = 0; ks < 4; ++ks) ca[ks] = lds_b128(L + bo + SB_CS + (16 * tb + fr) * SP_C + (32 * ks + 8 * fg) * 2); \
        f32x4 yoff[2];                                                         \
        _Pragma("unroll") for (int pbi = 0; pbi < 2; ++pbi) { yoff[pbi] = (f32x4){0.f, 0.f, 0.f, 0.f}; \
            _Pragma("unroll") for (int ks = 0; ks < 4; ++ks) yoff[pbi] = MFMA16(lds_b128(L + S_SBF + (16 * (2 * half + pbi) + fr) * SP_C + (32 * ks + 8 * fg) * 2), ca[ks], yoff[pbi]); } \
        const int tlc = 16 * tb + fr; const float atc = __shfl(acum, tlc), dtc = __shfl(dtv, tlc); \
        _Pragma("unroll") for (int sbi = 0; sbi < 2; ++sbi) { const int sb = 2 * half + sbi; f32x4 g = (f32x4){0.f, 0.f, 0.f, 0.f};     \
            if (sb <= tb) { \
                _Pragma("unroll") for (int ks = 0; ks < 4; ++ks) g = MFMA16(lds_b128(L + bo + SB_BS + (16 * sb + fr) * SP_C + (32 * ks + 8 * fg) * 2), ca[ks], g); } \
            float sv[4]; \
            _Pragma("unroll") for (int r = 0; r < 4; ++r) { const int sl = 16 * sb + 4 * fg + r; const float as_ = __shfl(acum, sl); \
                float v = sl <= tlc ? g[r] * __expf(atc - as_) : 0.f; if (sl == tlc) v += Dk / dtc; sv[r] = v; } \
            u2v so; so.x = pk2(sv[0], sv[1]); so.y = pk2(sv[2], sv[3]); *(LAS u2v*)(L + S_SC + tlc * SP_X + (16 * sb + 4 * fg) * 2) = so; } \
        { const float dec = __expf(alast); \
          _Pragma("unroll") for (int i = 0; i < 4; ++i) sacc[i] *= dec; \
          _Pragma("unroll") for (int ks = 0; ks < 2; ++ks) { const bf16x8 af = lds_tr8(L + bo + SB_BS + (32 * ks) * SP_C + (16 * w) * 2, SP_C, lane); \
              _Pragma("unroll") for (int pb = 0; pb < 4; ++pb) sacc[pb] = MFMA16(af, lds_tr8(L + bo + SB_XW + (32 * ks) * SP_X + (16 * pb) * 2, SP_X, lane), sacc[pb]); } } \
        __syncthreads();                                                       \
        { const float eat = __expf(atc); \
        _Pragma("unroll") for (int pbi = 0; pbi < 2; ++pbi) { const int pb = 2 * half + pbi; f32x4 yd = (f32x4){0.f, 0.f, 0.f, 0.f}; \
            _Pragma("unroll") for (int ks = 0; ks < 2; ++ks) yd = MFMA16(lds_tr8(L + bo + SB_XD + (32 * ks) * SP_X + (16 * pb) * 2, SP_X, lane), lds_b128(L + S_SC + (16 * tb + fr) * SP_X + (32 * ks + 8 * fg) * 2), yd); \
            u2v yo; yo.x = pk2(yd[0] + eat * yoff[pbi][0], yd[1] + eat * yoff[pbi][1]); yo.y = pk2(yd[2] + eat * yoff[pbi][2], yd[3] + eat * yoff[pbi][3]); \
            *(u2v*)(YS + SSD_TOK(c, tlc) * 256 + h * 64 + 16 * pb + 4 * fg) = yo; } } \
        _Pragma("unroll") for (int pb = 0; pb < 4; ++pb) { u2v o; o.x = pk2(sacc[pb][0], sacc[pb][1]); o.y = pk2(sacc[pb][2], sacc[pb][3]); \
            *(LAS u2v*)(L + S_SBF + (16 * pb + fr) * SP_C + (16 * w + 4 * fg) * 2) = o; } \
        if ((c) + 1 < 32) { dtv = pdt##NS; acum = wave_incl_sum(pdt##NS * A, lane); alast = __shfl(acum, 63); SSD_STAGE((((c) + 1) & 1) * SB_SIZE, dtv, acum, alast, NS); } } while (0)
    SSD_LOAD(0, 0);
    float dtv = pdt0, acum = wave_incl_sum(pdt0 * A, lane), alast = __shfl(acum, 63);
    SSD_STAGE(0, dtv, acum, alast, 0);
    SSD_LOAD(1, 1);
    for (int c2 = 0; c2 < 32; c2 += 2) { SSD_CHUNK(c2, 0, 1); SSD_CHUNK(c2 + 1, 1, 0); }
    __syncthreads();
#undef SSD_CHUNK
#undef SSD_LOAD
#undef SSD_STAGE
#undef SSD_TOK
}
constexpr int MB_QS = 0, MB_KS = 9216, MB_KW = 18432, MB_VS = 27648, MB_SIZE = 36864, M_SC = 73728, M_CBF = 82944, M_NBF = 92160;
__device__ __forceinline__ void ml_item(Ctx& F, int l, int it) {
    const int b = it >> 3, dir = (it >> 2) & 1, h = it & 3;
    const int tid = F.tid, lane = F.lane, w = F.wave, fr = lane & 15, fg = lane >> 4, tb = w >> 1, half = w & 1;
    const bf16* U = (const bf16*)(F.ws + WS_U);
    bf16* MLH = (bf16*)(F.ws + WS_MLH) + (size_t)dir * MTOK * 256;
    const float ib = INP(13)[l * 8 + dir * 4 + h], fb = INP(14)[l * 8 + dir * 4 + h];
    LAS unsigned char* L = F.lds;
#define ML_TOK(c, tau) ((size_t)b * SEQ + (dir ? SEQ - 1 - ((c) * 64 + (tau)) : (c) * 64 + (tau)))
    f32x4 cacc[2], nacc = (f32x4){0.f, 0.f, 0.f, 0.f};
    cacc[0] = (f32x4){0.f, 0.f, 0.f, 0.f}; cacc[1] = (f32x4){0.f, 0.f, 0.f, 0.f};
    for (int i = tid; i < (M_NBF + 256 - M_CBF) / 16; i += NTHR) *(LAS v4u*)(L + M_CBF + 16 * i) = (v4u){0u, 0u, 0u, 0u};
    bf16x8 ones;
#pragma unroll
    for (int j = 0; j < 8; ++j) ones[j] = (short)0x3F80;
    v4u pq0, pk0, pv0, pq1, pk1, pv1; float pli0, plf0, pli1, plf1;
#define ML_LOAD(c, S) do { \
        { const int tau = tid >> 3, ch = tid & 7; const bf16* rp = U + ML_TOK(c, tau) * UL + h * 64 + 8 * ch; pq##S = *(const v4u*)(rp + C_MQ); pk##S = *(const v4u*)(rp + C_MK); pv##S = *(const v4u*)(rp + C_MV); } \
        { const bf16* gp = U + ML_TOK(c, lane) * UL + C_G + dir * 4 + h; pli##S = bf2f(gp[8]) + ib; plf##S = -softplus_f(-(bf2f(gp[16]) + fb)); } } while (0)
#define ML_STAGE(bo, av, Mlast, S) do { const int tau = tid >> 3, ch = tid & 7; const float ks = 0.125f * __expf(__shfl(av, tau) - (Mlast)); v4u ow; \
        _Pragma("unroll") for (int e = 0; e < 4; ++e) ow[e] = pk2(bflo(pk##S[e]) * ks, bfhi(pk##S[e]) * ks); \
        *(LAS v4u*)(L + (bo) + MB_QS + tau * SP_X + ch * 16) = pq##S; *(LAS v4u*)(L + (bo) + MB_KS + tau * SP_X + ch * 16) = pk##S; \
        *(LAS v4u*)(L + (bo) + MB_KW + tau * SP_X + ch * 16) = ow; *(LAS v4u*)(L + (bo) + MB_VS + tau * SP_X + ch * 16) = pv##S; } while (0)
#define ML_CHUNK(c, CS, NS) do { \
        const int bo = ((c) & 1) * MB_SIZE; \
        __syncthreads();                                                       \
        if ((c) + 2 < 32) ML_LOAD((c) + 2, CS); \
        bf16x8 qa[2]; \
        _Pragma("unroll") for (int ks = 0; ks < 2; ++ks) qa[ks] = lds_b128(L + bo + MB_QS + (16 * tb + fr) * SP_X + (32 * ks + 8 * fg) * 2); \
        f32x4 yint[2], dint = (f32x4){0.f, 0.f, 0.f, 0.f};                     \
        _Pragma("unroll") for (int ebi = 0; ebi < 2; ++ebi) { yint[ebi] = (f32x4){0.f, 0.f, 0.f, 0.f}; \
            _Pragma("unroll") for (int ks = 0; ks < 2; ++ks) yint[ebi] = MFMA16(lds_b128(L + M_CBF + (16 * (2 * half + ebi) + fr) * SP_X + (32 * ks + 8 * fg) * 2), qa[ks], yint[ebi]); } \
        _Pragma("unroll") for (int ks = 0; ks < 2; ++ks) dint = MFMA16(lds_b128(L + M_NBF + (32 * ks + 8 * fg) * 2), qa[ks], dint); \
        const int tlc = 16 * tb + fr; const float Mtc = __shfl(Mv, tlc), btc = __shfl(bcum, tlc); \
        _Pragma("unroll") for (int sbi = 0; sbi < 2; ++sbi) { const int sb = 2 * half + sbi; f32x4 g = (f32x4){0.f, 0.f, 0.f, 0.f}; \
            if (sb <= tb) { \
                _Pragma("unroll") for (int ks = 0; ks < 2; ++ks) g = MFMA16(lds_b128(L + bo + MB_KS + (16 * sb + fr) * SP_X + (32 * ks + 8 * fg) * 2), qa[ks], g); } \
            float sv[4]; \
            _Pragma("unroll") for (int r = 0; r < 4; ++r) { const int sl = 16 * sb + 4 * fg + r; const float as_ = __shfl(av, sl); \
                sv[r] = sl <= tlc ? g[r] * 0.125f * __expf(as_ - Mtc) : 0.f; } \
            u2v so; so.x = pk2(sv[0], sv[1]); so.y = pk2(sv[2], sv[3]); *(LAS u2v*)(L + M_SC + tlc * SP_X + (16 * sb + 4 * fg) * 2) = so; } \
        { const float dec = __expf(mprev - Mlast); \
          cacc[0] *= dec; cacc[1] *= dec; nacc *= dec; \
          _Pragma("unroll") for (int ks = 0; ks < 2; ++ks) { const bf16x8 af = lds_tr8(L + bo + MB_KW + (32 * ks) * SP_X + (16 * tb) * 2, SP_X, lane); \
              nacc = MFMA16(af, ones, nacc); \
              _Pragma("unroll") for (int ebi = 0; ebi < 2; ++ebi) cacc[ebi] = MFMA16(af, lds_tr8(L + bo + MB_VS + (32 * ks) * SP_X + (16 * (2 * half + ebi)) * 2, SP_X, lane), cacc[ebi]); } } \
        __syncthreads();                                                       \
        { f32x4 dintra = (f32x4){0.f, 0.f, 0.f, 0.f}; bf16x8 sa[2]; \
          _Pragma("unroll") for (int ks = 0; ks < 2; ++ks) { sa[ks] = lds_b128(L + M_SC + (16 * tb + fr) * SP_X + (32 * ks + 8 * fg) * 2); dintra = MFMA16(ones, sa[ks], dintra); } \
          const float wi = __expf(mprev - Mtc), den = wi * dint[0] + dintra[0], dn = 1.0f / fmaxf(fabsf(den), __expf(-(btc + Mtc))); \
          _Pragma("unroll") for (int ebi = 0; ebi < 2; ++ebi) { const int eb = 2 * half + ebi; f32x4 yd = (f32x4){0.f, 0.f, 0.f, 0.f}; \
              _Pragma("unroll") for (int ks = 0; ks < 2; ++ks) yd = MFMA16(lds_tr8(L + bo + MB_VS + (32 * ks) * SP_X + (16 * eb) * 2, SP_X, lane), sa[ks], yd); \
              u2v ho; ho.x = pk2((wi * yint[ebi][0] + yd[0]) * dn, (wi * yint[ebi][1] + yd[1]) * dn); ho.y = pk2((wi * yint[ebi][2] + yd[2]) * dn, (wi * yint[ebi][3] + yd[3]) * dn); \
              *(u2v*)(MLH + ML_TOK(c, tlc) * 256 + h * 64 + 16 * eb + 4 * fg) = ho; } } \
        _Pragma("unroll") for (int ebi = 0; ebi < 2; ++ebi) { u2v o; o.x = pk2(cacc[ebi][0], cacc[ebi][1]); o.y = pk2(cacc[ebi][2], cacc[ebi][3]); \
            *(LAS u2v*)(L + M_CBF + (16 * (2 * half + ebi) + fr) * SP_X + (16 * tb + 4 * fg) * 2) = o; } \
        if (half == 0 && fr == 0) { u2v o; o.x = pk2(nacc[0], nacc[1]); o.y = pk2(nacc[2], nacc[3]); *(LAS u2v*)(L + M_NBF + (16 * tb + 4 * fg) * 2) = o; } \
        mprev = blast + Mlast; \
        if ((c) + 1 < 32) { bcum = wave_incl_sum(plf##NS, lane); av = pli##NS - bcum; Mv = fmaxf(mprev, wave_incl_max(av, lane)); Mlast = __shfl(Mv, 63); blast = __shfl(bcum, 63); \
            ML_STAGE((((c) + 1) & 1) * MB_SIZE, av, Mlast, NS); } } while (0)
    float mprev = 0.f;
    ML_LOAD(0, 0);
    float bcum = wave_incl_sum(plf0, lane), av = pli0 - bcum, Mv = fmaxf(mprev, wave_incl_max(av, lane)), Mlast = __shfl(Mv, 63), blast = __shfl(bcum, 63);
    ML_STAGE(0, av, Mlast, 0);
    ML_LOAD(1, 1);
    for (int c2 = 0; c2 < 32; c2 += 2) { ML_CHUNK(c2, 0, 1); ML_CHUNK(c2 + 1, 1, 0); }
    __syncthreads();
#undef ML_CHUNK
#undef ML_LOAD
#undef ML_STAGE
#undef ML_TOK
}
constexpr int NA_RPB_OFF = 135168;
__device__ __forceinline__ void na_wave_item(Ctx& F, int l, int wi) {
    const int jb = wi & 3, r = (wi >> 2) & 31, h = (wi >> 7) & 3, b = wi >> 9, lane = F.lane, fr = lane & 15, fg = lane >> 4;
    const bf16* U = (const bf16*)(F.ws + WS_U); const bf16* VT = (const bf16*)(F.ws + WS_UHT) + (size_t)(R_NV + h * 64) * TP; bf16* NAO = (bf16*)(F.ws + WS_NAO);
    const LAS float* rpb = (const LAS float*)(F.lds + NA_RPB_OFF) + h * 15 * 31;
    const int rs = min(max(r - 4, 0), 24), ks0 = min(max(16 * jb - 8, 0), 32);
    const int jq = 16 * jb + fr, cs = min(max(jq - 8, 0), 48);
    const size_t tb0 = (size_t)b * SEQ;
    bf16x8 qb[2];
    { const bf16* qp = U + (tb0 + r * 64 + jq) * UL + C_NQ + h * 64 + 8 * fg; qb[0] = *(const bf16x8*)qp; qb[1] = *(const bf16x8*)(qp + 32); }
    const int kcl = ks0 + 8 * (fr >> 2) + (fr & 3);
    const bf16* kbase = U + (tb0 + rs * 64 + kcl) * UL + C_NK + h * 64 + 8 * fg;
    const bf16* vbase = VT + (size_t)fr * TP + tb0 + rs * 64 + ks0 + 8 * fg;
    float sc[16][4];
#pragma unroll
    for (int hb = 0; hb < 2; ++hb) {
        bf16x8 kf[16];
#pragma unroll
        for (int t = 0; t < 8; ++t) { const int T = 8 * hb + t; const bf16* kp = kbase + (size_t)((T >> 1) * 64 + 4 * (T & 1)) * UL; kf[2 * t] = *(const bf16x8*)kp; kf[2 * t + 1] = *(const bf16x8*)(kp + 32); }
#pragma unroll
        for (int t = 0; t < 8; ++t) { const int T = 8 * hb + t, krow = rs + (T >> 1);
            f32x4 s = (f32x4){0.f, 0.f, 0.f, 0.f}; s = MFMA16(kf[2 * t], qb[0], s); s = MFMA16(kf[2 * t + 1], qb[1], s);
#pragma unroll
            for (int e = 0; e < 4; ++e) { const int kc = ks0 + 8 * fg + 4 * (T & 1) + e; const bool valid = kc >= cs && kc < cs + 16;
                const int dc = min(max(kc - jq + 15, 0), 30);
                sc[T][e] = valid ? s[e] * 0.125f + rpb[(krow - r + 7) * 31 + dc] : -1e30f; } }
        asm volatile("" ::: "memory"); }
    bf16x8 vf[16];
#pragma unroll
    for (int ks = 0; ks < 4; ++ks)
#pragma unroll
        for (int d = 0; d < 4; ++d) vf[4 * ks + d] = *(const bf16x8*)(vbase + (size_t)(16 * d) * TP + ks * 64);
    float mx = -1e30f;
#pragma unroll
    for (int T = 0; T < 16; ++T)
#pragma unroll
        for (int e = 0; e < 4; ++e) mx = fmaxf(mx, sc[T][e]);
    mx = fmaxf(mx, __shfl_xor(mx, 16)); mx = fmaxf(mx, __shfl_xor(mx, 32));
    float sum = 0.f;
#pragma unroll
    for (int T = 0; T < 16; ++T)
#pragma unroll
        for (int e = 0; e < 4; ++e) { sc[T][e] = __expf(sc[T][e] - mx); sum += sc[T][e]; }
    sum += __shfl_xor(sum, 16); sum += __shfl_xor(sum, 32);
    f32x4 oacc[4];
#pragma unroll
    for (int d = 0; d < 4; ++d) oacc[d] = (f32x4){0.f, 0.f, 0.f, 0.f};
#pragma unroll
    for (int hb = 0; hb < 2; ++hb) {
        if (hb == 1) {
#pragma unroll
            for (int ks = 0; ks < 4; ++ks)
#pragma unroll
                for (int d = 0; d < 4; ++d) vf[4 * ks + d] = *(const bf16x8*)(vbase + (size_t)(16 * d) * TP + (4 + ks) * 64); }
#pragma unroll
        for (int k4 = 0; k4 < 4; ++k4) { const int ks = 4 * hb + k4;
            bf16x8 pa; { v4u pw; pw[0] = pk2(sc[2 * ks][0], sc[2 * ks][1]); pw[1] = pk2(sc[2 * ks][2], sc[2 * ks][3]); pw[2] = pk2(sc[2 * ks + 1][0], sc[2 * ks + 1][1]); pw[3] = pk2(sc[2 * ks + 1][2], sc[2 * ks + 1][3]); pa = __builtin_bit_cast(bf16x8, pw); }
#pragma unroll
            for (int d = 0; d < 4; ++d) oacc[d] = MFMA16(pa, vf[4 * k4 + d], oacc[d]); } }
#pragma unroll
    for (int e = 0; e < 4; ++e) { const int q = 4 * fg + e; const float inv = 1.0f / __shfl(sum, q);
        bf16* op = NAO + (tb0 + r * 64 + 16 * jb + q) * 256 + h * 64 + fr;
#pragma unroll
        for (int d = 0; d < 4; ++d) op[16 * d] = (bf16)f2bf(oacc[d][e] * inv); }
}
constexpr int HY_CP = 8224, HY_ZP = 4112, HY_ZB = 8 * HY_CP;
__device__ __forceinline__ void hy_build_copies(LAS unsigned char* L, const bf16* R, int tid) {
    const v4u cur = *(const v4u*)(R + 8 * tid); const v4u prev = tid > 0 ? *(const v4u*)(R + 8 * tid - 8) : (v4u){0u, 0u, 0u, 0u};
    unsigned wd[9] = {prev[0], prev[1], prev[2], prev[3], cur[0], cur[1], cur[2], cur[3], 0u};
#pragma unroll
    for (int rho = 0; rho < 8; ++rho) { const int wo = (8 - rho) >> 1; v4u o;
        if ((rho & 1) == 0) { o[0] = wd[wo]; o[1] = wd[wo + 1]; o[2] = wd[wo + 2]; o[3] = wd[wo + 3]; }
        else {
#pragma unroll
            for (int j = 0; j < 4; ++j) o[j] = (wd[wo + j] >> 16) | (wd[wo + j + 1] << 16); }
        *(LAS v4u*)(L + rho * HY_CP + 16 * tid) = o; }
}
__device__ __forceinline__ float hy_gate4(const bf16* grow, int tok, int t, float w0, float w1, float w2, float bias, float* out4) {
    const u2v c4 = *(const u2v*)(grow + tok); const float lf = t > 0 ? bf2f(grow[tok - 1]) : 0.f, rt = t + 4 < SEQ ? bf2f(grow[tok + 4]) : 0.f;
    const float v0 = bflo(c4.x), v1 = bfhi(c4.x), v2 = bflo(c4.y), v3 = bfhi(c4.y);
    out4[0] = w0 * lf + w1 * v0 + w2 * v1 + bias; out4[1] = w0 * v0 + w1 * v1 + w2 * v2 + bias; out4[2] = w0 * v1 + w1 * v2 + w2 * v3 + bias; out4[3] = w0 * v2 + w1 * v3 + w2 * rt + bias;
    return 0.f;
}
__device__ __forceinline__ void hy_item(Ctx& F, int l, int c) {
    LAS unsigned char* L = F.lds;
    const bf16* UHT = (const bf16*)(F.ws + WS_UHT); bf16* HYO = (bf16*)(F.ws + WS_HYO);
    const float* cw = INP(16) + l * 3 * 768; const float* cb = INP(17) + l * 768; const float* skip = INP(24) + l * 512;
    const int tid = F.tid, lane = F.lane, w = F.wave, fr = lane & 15, fg = lane >> 4;
    const bf16* FR = (const bf16*)(F.ws + WS_FILT) + (size_t)(l * 2 * 256 + c) * 4096;
    hy_build_copies(L, FR, tid);
    { const float w0 = cw[c], w1 = cw[768 + c], w2 = cw[1536 + c], bias = cb[c]; const bf16* row = UHT + (size_t)c * TP;
#pragma unroll
      for (int k = 0; k < 8; ++k) { const int u = tid + 512 * k, b = u >> 8, t0 = (u & 255) * 8, tok = b * SEQ + t0;
          const v4u cv = *(const v4u*)(row + tok); const unsigned short lraw = row[tok - 1], rraw = row[tok + 8]; const float lf = t0 > 0 ? bf2f(lraw) : 0.f, rt = t0 + 8 < SEQ ? bf2f(rraw) : 0.f;
          float x[10]; x[0] = lf; x[9] = rt;
#pragma unroll
          for (int e = 0; e < 4; ++e) { x[1 + 2 * e] = bflo(cv[e]); x[2 + 2 * e] = bfhi(cv[e]); }
          v4u o;
#pragma unroll
          for (int e = 0; e < 4; ++e) o[e] = pk2(w0 * x[2 * e] + w1 * x[2 * e + 1] + w2 * x[2 * e + 2] + bias, w0 * x[2 * e + 1] + w1 * x[2 * e + 2] + w2 * x[2 * e + 3] + bias);
          *(LAS v4u*)(L + HY_ZB + b * HY_ZP + t0 * 2) = o; } }
    __syncthreads();
    const int abase = (fr & 7) * HY_CP + 4096 + 16 * (fg - (fr >> 3)) - 32 * 16 * w;
    const int bbase = HY_ZB + fr * HY_ZP + 16 * fg;
    for (int o = 0; o < 2; ++o) {
        f32x4 acc[16];
#pragma unroll
        for (int i = 0; i < 16; ++i) acc[i] = (f32x4){0.f, 0.f, 0.f, 0.f};
        bf16x8 af[16];
#pragma unroll
        for (int m = 2; m <= 15; ++m) af[(16 - m) & 15] = lds_b128(L + abase - 32 * m);
        for (int j0 = 0; j0 < 64; j0 += 8) {
#pragma unroll
            for (int jj = 0; jj < 8; ++jj) { const int j = j0 + jj;
                af[(2 * jj) & 15] = lds_b128(L + abase + 64 * j); af[(2 * jj + 15) & 15] = lds_b128(L + abase + 64 * j - 32);
                const bf16x8 bfr = lds_b128(L + bbase + 64 * j);
#pragma unroll
                for (int ii = 0; ii < 16; ++ii) acc[ii] = MFMA16(af[(2 * jj - ii + 16) & 15], bfr, acc[ii]); }
        }
        __syncthreads();
        if (o == 0) hy_build_copies(L, FR + (size_t)256 * 4096, tid);
        const int gc = 256 * (o + 1) + c; const float w0 = cw[gc], w1 = cw[768 + gc], w2 = cw[1536 + gc], bias = cb[gc]; const bf16* grow = UHT + (size_t)gc * TP;
        const float sk = skip[o * 256 + c];
        u2v gcv[16]; unsigned short glf[16], grt[16];
#pragma unroll
        for (int ii = 0; ii < 16; ++ii) { const int t = 16 * (16 * w + ii) + 4 * fg, tok = fr * SEQ + t;
            gcv[ii] = *(const u2v*)(grow + tok); glf[ii] = grow[tok - 1]; grt[ii] = grow[tok + 4]; }
#pragma unroll
        for (int ii = 0; ii < 16; ++ii) { const int t = 16 * (16 * w + ii) + 4 * fg, tok = fr * SEQ + t;
            const float lf = t > 0 ? bf2f(glf[ii]) : 0.f, rt = t + 4 < SEQ ? bf2f(grt[ii]) : 0.f, v0 = bflo(gcv[ii].x), v1 = bfhi(gcv[ii].x), v2 = bflo(gcv[ii].y), v3 = bfhi(gcv[ii].y);
            const float xg0 = w0 * lf + w1 * v0 + w2 * v1 + bias, xg1 = w0 * v0 + w1 * v1 + w2 * v2 + bias, xg2 = w0 * v1 + w1 * v2 + w2 * v3 + bias, xg3 = w0 * v2 + w1 * v3 + w2 * rt + bias;
            LAS u2v* zp = (LAS u2v*)(L + HY_ZB + fr * HY_ZP + t * 2); const u2v zo = *zp;
            const float z0 = xg0 * (acc[ii][0] + sk * bflo(zo.x)), z1 = xg1 * (acc[ii][1] + sk * bfhi(zo.x)), z2 = xg2 * (acc[ii][2] + sk * bflo(zo.y)), z3 = xg3 * (acc[ii][3] + sk * bfhi(zo.y));
            u2v zn; zn.x = pk2(z0, z1); zn.y = pk2(z2, z3);
            if (o == 0) *zp = zn; else *(u2v*)(HYO + (size_t)c * TP + tok) = zn; }
        __syncthreads();
    }
}
#ifndef MIXREP
#define MIXREP 0
#endif
__device__ __forceinline__ void ph_mixers(Ctx& F, int l, int rep) {
    for (int q_ = 0; q_ < ((MIXREP & 1) ? 2 : 1); ++q_)
    for (int it = F.bid; it < 256; it += F.G) { if (it < 128) ssd_item(F, l, it); else ml_item(F, l, it - 128); }
    F.tid = fresh_tid(); F.lane = F.tid & 63; F.wave = __builtin_amdgcn_readfirstlane(F.tid >> 6);
    for (int i = F.tid; i < 4 * 15 * 31; i += NTHR) ((LAS float*)(F.lds + NA_RPB_OFF))[i] = INP(11)[(size_t)l * 4 * 15 * 31 + i];
    volatile LAS int* slot = (volatile LAS int*)(F.lds + MISC_OFF);
    unsigned* ctr = (unsigned*)(F.ws + WS_CTL) + 64 * (1 + l + 2 * rep);
    for (;;) {
        __syncthreads();
        if (F.tid == 0) slot[0] = (int)atomicAdd(ctr, 1u);
        __syncthreads();
        const int it = slot[0];
        if (it >= 256 + 256) break;
        if (it < 256) { hy_item(F, l, it); if (MIXREP & 2) hy_item(F, l, it); }
        else {
#pragma unroll 1
            for (int q = 0; q < 4; ++q) na_wave_item(F, l, ((it - 256) * 4 + q) * 8 + F.wave); }
    }
}

__device__ __forceinline__ void ph_finalize(Ctx& F, int l) {
    const int lane = F.lane, c0 = lane * 4, tid = F.tid;
    const bf16* U = (const bf16*)(F.ws + WS_U); const bf16* YS = (const bf16*)(F.ws + WS_YS); const bf16* NAO = (const bf16*)(F.ws + WS_NAO);
    const bf16* MLH = (const bf16*)(F.ws + WS_MLH); const bf16* HYO = (const bf16*)(F.ws + WS_HYO); bf16* YM = (bf16*)(F.ws + WS_XN);
    const f32x4 gs = *(const f32x4*)(INP(10) + l * 256 + c0), gn = *(const f32x4*)(INP(12) + l * 256 + c0), gm = *(const f32x4*)(INP(15) + l * 256 + c0), gh = *(const f32x4*)(INP(25) + l * 256 + c0);
    constexpr int HP = 144;
    for (int it = F.bid; it < MTOK / 64; it += F.G) {
        const int tok0 = it * 64;
        __syncthreads();
#pragma unroll
        for (int k = 0; k < 4; ++k) { const int u = tid + 512 * k, c = u >> 3, ch = u & 7; *(LAS v4u*)(F.lds + c * HP + ch * 16) = *(const v4u*)(HYO + (size_t)c * TP + tok0 + ch * 8); }
        __syncthreads();
        typedef unsigned u2 __attribute__((ext_vector_type(2)));
#pragma unroll 1
        for (int q0 = 0; q0 < 8; q0 += 8) {
            u2 ys0[8], ys1[8], zz[8], na[8], m0[8], m1[8], og[8]; float hv[8][4];
#pragma unroll
            for (int j = 0; j < 8; ++j) { const int tl = F.wave * 8 + q0 + j; const size_t tok = (size_t)(tok0 + tl);
                ys0[j] = *(const u2*)(YS + tok * 256 + c0); ys1[j] = *(const u2*)(YS + (MTOK + tok) * 256 + c0); zz[j] = *(const u2*)(U + tok * UL + C_SZ + c0);
                na[j] = *(const u2*)(NAO + tok * 256 + c0); m0[j] = *(const u2*)(MLH + tok * 256 + c0); m1[j] = *(const u2*)(MLH + (MTOK + tok) * 256 + c0); og[j] = *(const u2*)(U + tok * UL + C_MO + c0);
                const LAS bf16* hp = (const LAS bf16*)(F.lds + c0 * HP + tl * 2); hv[j][0] = bf2f(hp[0]); hv[j][1] = bf2f(hp[HP / 2]); hv[j][2] = bf2f(hp[HP]); hv[j][3] = bf2f(hp[3 * HP / 2]); }
#pragma unroll
            for (int j = 0; j < 8; ++j) { const size_t tok = (size_t)(tok0 + F.wave * 8 + q0 + j); bf16* yo = YM + tok * DM + c0;
                { const float v0 = (bflo(ys0[j].x) + bflo(ys1[j].x)) * silu_ff(bflo(zz[j].x)), v1 = (bfhi(ys0[j].x) + bfhi(ys1[j].x)) * silu_ff(bfhi(zz[j].x)), v2 = (bflo(ys0[j].y) + bflo(ys1[j].y)) * silu_ff(bflo(zz[j].y)), v3 = (bfhi(ys0[j].y) + bfhi(ys1[j].y)) * silu_ff(bfhi(zz[j].y));
                  const float rs = 1.0f / sqrtf(wave_sum(v0 * v0 + v1 * v1 + v2 * v2 + v3 * v3) * (1.f / 256.f) + EPS);
                  u2 o; o.x = pk2(v0 * rs * gs.x, v1 * rs * gs.y); o.y = pk2(v2 * rs * gs.z, v3 * rs * gs.w); *(u2*)yo = o; }
                { const float v0 = bflo(na[j].x), v1 = bfhi(na[j].x), v2 = bflo(na[j].y), v3 = bfhi(na[j].y);
                  const float rs = 1.0f / sqrtf(wave_sum(v0 * v0 + v1 * v1 + v2 * v2 + v3 * v3) * (1.f / 256.f) + EPS);
                  u2 o; o.x = pk2(v0 * rs * gn.x, v1 * rs * gn.y); o.y = pk2(v2 * rs * gn.z, v3 * rs * gn.w); *(u2*)(yo + 256) = o; }
                { const float v0 = bflo(m0[j].x) + bflo(m1[j].x), v1 = bfhi(m0[j].x) + bfhi(m1[j].x), v2 = bflo(m0[j].y) + bflo(m1[j].y), v3 = bfhi(m0[j].y) + bfhi(m1[j].y);
                  float ss = v0 * v0 + v1 * v1 + v2 * v2 + v3 * v3;
                  ss += __shfl_xor(ss, 1); ss += __shfl_xor(ss, 2); ss += __shfl_xor(ss, 4); ss += __shfl_xor(ss, 8);
                  const float rs = 1.0f / sqrtf(ss * (1.f / 64.f) + EPS);
                  u2 o; o.x = pk2(v0 * rs * gm.x * sigmoid_f(bflo(og[j].x)), v1 * rs * gm.y * sigmoid_f(bfhi(og[j].x))); o.y = pk2(v2 * rs * gm.z * sigmoid_f(bflo(og[j].y)), v3 * rs * gm.w * sigmoid_f(bfhi(og[j].y)));
                  *(u2*)(yo + 512) = o; }
                { const float v0 = hv[j][0], v1 = hv[j][1], v2 = hv[j][2], v3 = hv[j][3];
                  const float rs = 1.0f / sqrtf(wave_sum(v0 * v0 + v1 * v1 + v2 * v2 + v3 * v3) * (1.f / 256.f) + EPS);
                  u2 o; o.x = pk2(v0 * rs * gh.x, v1 * rs * gh.y); o.y = pk2(v2 * rs * gh.z, v3 * rs * gh.w); *(u2*)(yo + 768) = o; }
            }
        }
    }
}

#define XB_TMO      128
#define XB_XCNT(j)  (256  + 64 * (j))
#define XB_XSUB(j)  (1280 + 64 * (j))
#define XB_XGEN(j)  (2304 + 64 * (j))
#define XB_TOP      3328
#define XB_TOPGEN   3392
#define XCD_BAR_WORDS 3456
#define XB_SPIN_CAP (1u << 18)

__device__ __forceinline__ unsigned xb_ld(unsigned* p)              { return __hip_atomic_load(p, __ATOMIC_RELAXED, __HIP_MEMORY_SCOPE_AGENT); }
__device__ __forceinline__ unsigned xb_add(unsigned* p, unsigned v) { return __hip_atomic_fetch_add(p, v, __ATOMIC_RELAXED, __HIP_MEMORY_SCOPE_AGENT); }
__device__ __forceinline__ unsigned xb_xcc_id() { return (unsigned)__builtin_amdgcn_s_getreg((3 << 11) | 20) & 0xFu; }
#define XB_SPIN(cond, bar) do { unsigned _sp = 0; while (cond) { __builtin_amdgcn_s_sleep(1); \
    if ((++_sp & 255u) == 0u) { if (xb_ld(&(bar)[XB_TMO])) break; if (_sp > XB_SPIN_CAP) { atomicAdd(&(bar)[XB_TMO], 1u); break; } } } } while (0)

struct XcdBarrier {
    unsigned* bar; unsigned x;
    volatile LAS unsigned* st;
};

__device__ __forceinline__ XcdBarrier xcd_barrier_post(unsigned* bar, volatile LAS unsigned* st) {
    XcdBarrier b; b.bar = bar; b.x = xb_xcc_id(); b.st = st;
    if (threadIdx.x == 0) (void)xb_add(&bar[XB_XCNT(b.x)], 1u);
    return b;
}
__device__ __forceinline__ void xcd_barrier_complete(unsigned* bar, unsigned x, unsigned& nloc, unsigned& nx) {
    const unsigned G = gridDim.x * gridDim.y * gridDim.z;
    unsigned sum, cnt, mine, sp = 0u;
    for (;;) {
        sum = 0u; cnt = 0u; mine = 0u;
#pragma unroll
        for (unsigned j = 0; j < 16; ++j) { const unsigned c = xb_ld(&bar[XB_XCNT(j)]); sum += c; cnt += (c > 0u) ? 1u : 0u; mine = (j == x) ? c : mine; }
        if (sum == G) break;
        __builtin_amdgcn_s_sleep(1);
        if ((++sp & 255u) == 0u) { if (xb_ld(&bar[XB_TMO])) break; if (sp > XB_SPIN_CAP) { atomicAdd(&bar[XB_TMO], 1u); break; } }
    }
    nloc = mine > 0u ? mine : 1u; nx = cnt > 0u ? cnt : 1u;
}

__device__ __forceinline__ void xcd_barrier(const XcdBarrier& b) {
    asm volatile("s_waitcnt vmcnt(0)" ::: "memory");
    __syncthreads();
    if (threadIdx.x == 0) {
        unsigned* bar = b.bar;
        __builtin_amdgcn_s_waitcnt(0);
        unsigned nloc = b.st[0], nx = b.st[1];
        if (nloc == 0u) { xcd_barrier_complete(bar, b.x, nloc, nx); b.st[0] = nloc; b.st[1] = nx; }
        const unsigned old = xb_add(&bar[XB_XSUB(b.x)], 1u);
        const unsigned gen = old / nloc;
        if (old + 1u == (gen + 1u) * nloc) {
            __builtin_amdgcn_fence(__ATOMIC_RELEASE, "agent");
            asm volatile("s_waitcnt vmcnt(0)" ::: "memory");
            const unsigned og = xb_add(&bar[XB_TOP], 1u);
            const unsigned tg = og / nx;
            if (og + 1u == (tg + 1u) * nx) xb_add(&bar[XB_TOPGEN], 1u);
            else XB_SPIN(xb_ld(&bar[XB_TOPGEN]) == tg, bar);
            __builtin_amdgcn_fence(__ATOMIC_ACQUIRE, "agent");
            xb_add(&bar[XB_XGEN(b.x)], 1u);
            asm volatile("s_waitcnt vmcnt(0)" ::: "memory");
        } else {
            XB_SPIN(xb_ld(&bar[XB_XGEN(b.x)]) == gen, bar);
            __builtin_amdgcn_fence(__ATOMIC_ACQUIRE, "agent");
            asm volatile("s_waitcnt vmcnt(0)" ::: "memory");
        }
    }
    __syncthreads();
}

constexpr int N_PHASES = 2 + 9 * DEPTH;
#ifndef MK_MULTI
#define MK_MULTI 1
#endif
__global__ void __launch_bounds__(NTHR, 2) hybrid_fwd(Args args) {
    extern __shared__ __attribute__((aligned(16))) unsigned char lds_raw[];
    Ctx F;
    F.lds = (LAS unsigned char*)lds_raw; F.tid = threadIdx.x; F.lane = F.tid & 63; F.wave = __builtin_amdgcn_readfirstlane(F.tid >> 6);
    F.bid = blockIdx.x; F.G = gridDim.x; F.out = args.out; F.ws = args.ws; F.A = &args;
    const int lo = args.ph_lo, hi = args.ph_hi;
#if MK_MULTI
#define SEAM(k) do { } while (0)
#else
    for (int u = F.tid; u < 32; u += NTHR) ((LAS unsigned*)(F.lds + MISC_OFF))[u] = 0u;
    __syncthreads();
    XcdBarrier bar = xcd_barrier_post((unsigned*)(F.ws + WS_CTL) + 4096, (volatile LAS unsigned*)(F.lds + MISC_OFF) + 8);
#define SEAM(k) do { if ((k) + 1 < hi) xcd_barrier(bar); } while (0)
#endif
#ifndef PHMASK
#define PHMASK 0xFFFFF
#endif
#define FRESH() do { F.tid = fresh_tid(); F.lane = F.tid & 63; F.wave = __builtin_amdgcn_readfirstlane(F.tid >> 6); } while (0)
#define IN(k) (((PHMASK >> (k)) & 1) && lo <= (k) && (k) < hi)
#define INL(j) (((PHMASK >> (2 + (j))) & 1) && lo <= (pb + (j)) && (pb + (j)) < hi)
#ifndef REPMASK
#define REPMASK 0
#endif
#define REPS(k) for (int rep_ = 0; rep_ < ((((REPMASK) >> (k)) & 1) ? 2 : 1); ++rep_)
    const float* MOD = (const float*)(F.ws + WS_MOD); float* SS = (float*)(F.ws + WS_SS); const float* CV = (const float*)(F.ws + WS_CV);
    if (IN(0)) { REPS(0) { FRESH(); ph_prologue(F); __syncthreads(); } SEAM(0); }
    if (IN(1)) { REPS(1) { FRESH(); ph_filters(F); FRESH(); ph_cvec(F); FRESH(); ph_xn0(F, MOD); __syncthreads(); } SEAM(1); }
    for (int l = 0; l < DEPTH; ++l) {
        const int pb = 2 + 9 * l; unsigned char* wb = F.ws + WS_W + (size_t)l * W_LAYER; const float* mod_l = MOD + (size_t)l * NB * 6144; const float* cv_l = CV + (size_t)l * NB * CVP;
        float* ss_in = SS + (size_t)(2 * l) * MTOK; float* ss_ff = SS + (size_t)(2 * l + 1) * MTOK; float* ss_nx = SS + (size_t)(2 * l + 2) * MTOK;
        if (INL(0)) { REPS(2) {
            pg8::Gemm g{(const pg8::bf16_t*)(F.ws + WS_XN), (const pg8::bf16_t*)(wb + W_IN_OFF), MTOK, UL, DM};
            pg8::DualOrder S; S.init(MTOK, UL, NTR, MTOK, F.G, F.bid, (const pg8::bf16_t*)(wb + W_HY_OFF), (const pg8::bf16_t*)(F.ws + WS_XN));
            pg8::EpiDualIn E{{(pg8::bf16_t*)(F.ws + WS_U), UL, ss_in, cv_l}, {(pg8::bf16_t*)(F.ws + WS_UHT), TP, ss_in, cv_l + 2816}};
            pg8::gemm_phase<pg8::EpiDualIn, pg8::DualOrder, true, true>(F.lds, g, S, E);
            __syncthreads(); }
            SEAM(pb + 0);
        }
        if (INL(1)) { REPS(3) { FRESH(); ph_prepass(F, l); } SEAM(pb + 1); }
        if (INL(2)) { REPS(4) { FRESH(); ph_mixers(F, l, rep_); } SEAM(pb + 2); }
        if (INL(3)) { REPS(5) { FRESH(); ph_finalize(F, l); } SEAM(pb + 3); }
        if (INL(4)) {
            pg8::Gemm g{(const pg8::bf16_t*)(F.ws + WS_XN), (const pg8::bf16_t*)(wb + W_OUT_OFF), MTOK, DM, DM}; pg8::StaticOrder S; S.init(MTOK, DM, F.G, F.bid);
            pg8::EpiResidN E{l == 0 ? INP(0) : (const float*)F.out, F.out, mod_l + 2048, mod_l + 4096, (pg8::bf16_t*)(F.ws + WS_XN2), ss_ff};
            pg8::gemm_phase<pg8::EpiResidN, pg8::StaticOrder, true, true>(F.lds, g, S, E);
            SEAM(pb + 4);
        }
        if (INL(6)) { REPS(8) {
            pg8::Gemm g{(const pg8::bf16_t*)(F.ws + WS_XN2), (const pg8::bf16_t*)(wb + W_GU_OFF), MTOK, 2 * FFH, DM}; pg8::StaticOrder S; S.init(MTOK, 2 * FFH, F.G, F.bid);
            pg8::EpiSwigluN E{(pg8::bf16_t*)(F.ws + WS_U), FFH, ss_ff, cv_l + 3840}; pg8::gemm_phase<pg8::EpiSwigluN, pg8::StaticOrder, true, true>(F.lds, g, S, E); __syncthreads(); }
            SEAM(pb + 6);
        }
        if (INL(7)) {
            pg8::Gemm g{(const pg8::bf16_t*)(F.ws + WS_U), (const pg8::bf16_t*)(wb + W_DN_OFF), MTOK, DM, FFH}; pg8::StaticOrder S; S.init(MTOK, DM, F.G, F.bid);
            pg8::EpiResidN E{(const float*)F.out, F.out, mod_l + 5120, mod_l + (size_t)NB * 6144 + 1024, l + 1 < DEPTH ? (pg8::bf16_t*)(F.ws + WS_XN) : nullptr, ss_nx};
            pg8::gemm_phase<pg8::EpiResidN, pg8::StaticOrder, true, true>(F.lds, g, S, E);
            SEAM(pb + 7);
        }
        if (INL(8)) { if (l + 1 == DEPTH) { FRESH(); ph_final(F); } }
    }
#undef IN
#undef INL
#undef SEAM
}

extern "C" void kernel_launch(void* const* d_in, const int* in_sizes, int n_in, void* d_out, int out_size, void* d_ws, size_t ws_size, hipStream_t stream) {
    static int grid = 0;
    if (grid == 0) {
        if (n_in != 31 || out_size != MTOK * DM || ws_size < WS_END) { fprintf(stderr, "kernel_launch: unexpected problem shape (n_in %d out %d ws %zu)\n", n_in, out_size, ws_size); grid = -1; return; }
        int dev = 0, cus = 0, per_cu = 0;
        hipGetDevice(&dev); hipDeviceGetAttribute(&cus, hipDeviceAttributeMultiprocessorCount, dev);
        if (hipFuncSetAttribute((const void*)hybrid_fwd, hipFuncAttributeMaxDynamicSharedMemorySize, LDS_BYTES) != hipSuccess) { fprintf(stderr, "kernel_launch: hipFuncSetAttribute failed\n"); grid = -1; return; }
        if (hipOccupancyMaxActiveBlocksPerMultiprocessor(&per_cu, (const void*)hybrid_fwd, NTHR, LDS_BYTES) != hipSuccess || per_cu < 1) { fprintf(stderr, "kernel_launch: occupancy query says %d blocks per CU\n", per_cu); grid = -1; (void)hipGetLastError(); return; }
        grid = cus;
    }
    if (grid < 0) return;
    hipMemsetAsync((char*)d_ws + WS_CTL, 0, CTL_ZERO_BYTES, stream);
    Args a{};
    for (int i = 0; i < 31; ++i) a.in[i] = (const float*)d_in[i];
    a.out = (float*)d_out; a.ws = (unsigned char*)d_ws;
#if MK_MULTI
    for (int p = 0; p < N_PHASES; ++p) { a.ph_lo = p; a.ph_hi = p + 1; hipLaunchKernelGGL(hybrid_fwd, dim3(grid), dim3(NTHR), LDS_BYTES, stream, a); }
#else
    a.ph_lo = 0; a.ph_hi = N_PHASES;
    hipLaunchKernelGGL(hybrid_fwd, dim3(grid), dim3(NTHR), LDS_BYTES, stream, a);
#endif
}
```

```cpp
#include <hip/hip_runtime.h>
#include <hip/hip_cooperative_groups.h>
#include <cstdio>
#include <cstdint>
namespace cg = cooperative_groups;
#define MK_MULTI 0
namespace pg8 {
#define PG8_LAS __attribute__((address_space(3)))
typedef unsigned short bf16_t;
typedef short bf16x8 __attribute__((ext_vector_type(8)));
typedef float f32x4 __attribute__((ext_vector_type(4)));
typedef unsigned u32x4 __attribute__((ext_vector_type(4)));
constexpr int BM = 256, BK = 64, HALF = 128, HTB = HALF * BK * 2  , STAGE_BYTES = 8 * HTB, NXCD = 8, WGM = 8;

__host__ __device__ __forceinline__ int lds_byte(int r, int c) { const int st = (r >> 4) * 2 + (c >> 5), rr = r & 15, cc = c & 31, ob = rr * 64 + cc * 2; return st * 1024 + (ob ^ (((ob >> 9) & 1) << 5)); }
__host__ __device__ __forceinline__ void stage_rc(int b, int& R, int& C) { const int st = b / 1024, sb = b % 1024, swz = sb ^ (((sb >> 9) & 1) << 5); R = (st >> 1) * 16 + swz / 64; C = (st & 1) * 32 + (swz % 64) / 2; }
__host__ __device__ __forceinline__ int perm32(int rho) { const int n = rho >> 4, i = rho & 15; return 8 * (i >> 2) + 4 * n + (i & 3); }

struct Unit { int pm, pn, kind; };
struct Gemm { const bf16_t* A; const bf16_t* Bt; int M, N, K; };

struct StaticOrder {
    int nM, nN, nwg, G, c;
    __host__ __device__ void init(int M, int N, int G_, int c_) { nM = M / BM; nN = N / BM; nwg = nM * nN; G = G_; c = c_; }
    __host__ __device__ bool next(int i, Unit& u) const {
        const long L = (long)i * G + c; if (L >= nwg) return false;
        int wgid = (int)L; { const int q = nwg / NXCD, r = nwg % NXCD, xcd = wgid % NXCD, off = wgid / NXCD; wgid = (xcd < r ? xcd * (q + 1) : r * (q + 1) + (xcd - r) * q) + off; }
        const int nig = WGM * nN, gid = wgid / nig, fm = gid * WGM, gsz = (nM - fm) < WGM ? (nM - fm) : WGM;
        u.pm = fm + ((wgid % nig) % gsz); u.pn = (wgid % nig) / gsz; u.kind = 0; return true;
    }
    template <class G_> __device__ __forceinline__ const char* pa(const G_& g, const Unit& u, size_t tstep) const { return (const char*)g.A + (size_t)u.pm * tstep; }
    template <class G_> __device__ __forceinline__ const char* pb(const G_& g, const Unit& u, size_t tstep) const { return (const char*)g.Bt + (size_t)u.pn * tstep; }
    __device__ __forceinline__ void a_ready(const Unit&) const {}
    __device__ __forceinline__ void done(const Unit&) const {}
};

__device__ __forceinline__ unsigned cvt_pk_bf16(float lo, float hi) { unsigned r; asm volatile("v_cvt_pk_bf16_f32 %0, %1, %2" : "=v"(r) : "v"(lo), "v"(hi)); return r; }
constexpr float PG8_EPS = 1e-6f;
constexpr int CVP = 9472;
struct EpiStoreBf16N {
    static constexpr bool PERM = true, AFTER_DRAIN = false;
    bf16_t* O; int ldc; const float* ss; const float* cv;
    __device__ __forceinline__ void operator()(const f32x4 (&acc)[2][2][4][2], const Unit& u, int wr, int wc, int fr, int fq) const {
        const int row0 = u.pm * BM + wr * 64 + fr; const int col0 = u.pn * BM + wc * 32 + 8 * fq;
        const float* cvp = cv + (size_t)((u.pm * BM) >> 11) * CVP + col0;
        f32x4 cvv[2][2];
#pragma unroll
        for (int bj = 0; bj < 2; ++bj)
#pragma unroll
            for (int n = 0; n < 2; ++n) cvv[bj][n] = *(const f32x4*)(cvp + bj * HALF + 4 * n);
#pragma unroll
        for (int ai = 0; ai < 2; ++ai)
#pragma unroll
            for (int m = 0; m < 4; ++m) { const int r = row0 + ai * HALF + m * 16; bf16_t* rowp = O + (size_t)r * ldc + col0;
                const float rs = 1.0f / sqrtf(ss[r] * (1.0f / 1024.0f) + PG8_EPS);
#pragma unroll
                for (int bj = 0; bj < 2; ++bj) { const f32x4 v0 = acc[ai][bj][m][0] * rs + cvv[bj][0], v1 = acc[ai][bj][m][1] * rs + cvv[bj][1];
                    u32x4 w; w.x = cvt_pk_bf16(v0[0], v0[1]); w.y = cvt_pk_bf16(v0[2], v0[3]); w.z = cvt_pk_bf16(v1[0], v1[1]); w.w = cvt_pk_bf16(v1[2], v1[3]);
                    *(u32x4*)(rowp + bj * HALF) = w; } }
    }
};
struct EpiStoreBf16T {
    static constexpr bool PERM = true, AFTER_DRAIN = false;
    bf16_t* O; int ldc; const float* ss; const float* cv;
    __device__ __forceinline__ void operator()(const f32x4 (&acc)[2][2][4][2], const Unit& u, int wr, int wc, int fr, int fq) const {
        const int row0 = u.pm * BM + wr * 64 + fr; const int col0 = u.pn * BM + wc * 32 + 8 * fq;
        const float* cvp = cv + (size_t)((u.pn * BM) >> 11) * CVP;
        f32x4 rsv[2][2];
#pragma unroll
        for (int bj = 0; bj < 2; ++bj)
#pragma unroll
            for (int n = 0; n < 2; ++n) { const f32x4 s4 = *(const f32x4*)(ss + col0 + bj * HALF + 4 * n);
#pragma unroll
                for (int j = 0; j < 4; ++j) rsv[bj][n][j] = 1.0f / sqrtf(s4[j] * (1.0f / 1024.0f) + PG8_EPS); }
#pragma unroll
        for (int ai = 0; ai < 2; ++ai)
#pragma unroll
            for (int m = 0; m < 4; ++m) { const int r = row0 + ai * HALF + m * 16; bf16_t* rowp = O + (size_t)r * ldc + col0; const float c = cvp[r];
#pragma unroll
                for (int bj = 0; bj < 2; ++bj) { const f32x4 v0 = acc[ai][bj][m][0] * rsv[bj][0] + c, v1 = acc[ai][bj][m][1] * rsv[bj][1] + c;
                    u32x4 w; w.x = cvt_pk_bf16(v0[0], v0[1]); w.y = cvt_pk_bf16(v0[2], v0[3]); w.z = cvt_pk_bf16(v1[0], v1[1]); w.w = cvt_pk_bf16(v1[2], v1[3]);
                    *(u32x4*)(rowp + bj * HALF) = w; } }
    }
};
struct EpiResidN {
    static constexpr bool PERM = false, AFTER_DRAIN = false;
    const float* base; float* out; const float* gate; const float* scn; bf16_t* an; float* ss;
    __device__ __forceinline__ void operator()(const f32x4 (&acc)[2][2][4][2], const Unit& u, int wr, int wc, int fr, int fq) const {
        const int col0 = u.pn * BM + wc * 32 + 4 * fq; const size_t bo = (size_t)((u.pm * BM) >> 11) * 6144 + col0;
        f32x4 gv[2][2], sv[2][2];
#pragma unroll
        for (int bj = 0; bj < 2; ++bj)
#pragma unroll
            for (int n = 0; n < 2; ++n) { gv[bj][n] = *(const f32x4*)(gate + bo + bj * HALF + n * 16); sv[bj][n] = an ? *(const f32x4*)(scn + bo + bj * HALF + n * 16) + 1.0f : (f32x4){0.f, 0.f, 0.f, 0.f}; }
#pragma unroll
        for (int ai = 0; ai < 2; ++ai)
#pragma unroll
            for (int m = 0; m < 4; ++m) { const int r = u.pm * BM + ai * HALF + wr * 64 + m * 16 + fr; const size_t off = (size_t)r * 1024 + col0; float q = 0.f;
#pragma unroll
                for (int bj = 0; bj < 2; ++bj)
#pragma unroll
                    for (int n = 0; n < 2; ++n) { const f32x4 bs = *(const f32x4*)(base + off + bj * HALF + n * 16); const f32x4 o = bs + gv[bj][n] * acc[ai][bj][m][n];
                        *(f32x4*)(out + off + bj * HALF + n * 16) = o; q += (o[0] * o[0] + o[1] * o[1]) + (o[2] * o[2] + o[3] * o[3]);
                        if (an) { const f32x4 a = o * sv[bj][n]; typedef unsigned u32x2 __attribute__((ext_vector_type(2))); u32x2 w; w.x = cvt_pk_bf16(a[0], a[1]); w.y = cvt_pk_bf16(a[2], a[3]); *(u32x2*)(an + off + bj * HALF + n * 16) = w; } }
                q += __shfl_xor(q, 16); q += __shfl_xor(q, 32);
                if (fq == 0) atomicAdd(ss + r, q);
                if (m == 3) asm volatile("" ::: "memory"); }
    }
};
__device__ __forceinline__ float silu_f(float v) { return v * __builtin_amdgcn_rcpf(1.0f + __expf(-v)); }
struct EpiSwigluN {
    static constexpr bool PERM = true, AFTER_DRAIN = false;
    bf16_t* O; int ldc; const float* ss; const float* cv;
    __device__ __forceinline__ void operator()(const f32x4 (&acc)[2][2][4][2], const Unit& u, int wr, int wc, int fr, int fq) const {
        const int row0 = u.pm * BM + wr * 64 + fr; const int col0 = u.pn * HALF + wc * 32 + 8 * fq;
        const float* cvp = cv + (size_t)((u.pm * BM) >> 11) * CVP + u.pn * BM + wc * 32 + 8 * fq;
        f32x4 cg[2], cu[2];
#pragma unroll
        for (int n = 0; n < 2; ++n) { cg[n] = *(const f32x4*)(cvp + 4 * n); cu[n] = *(const f32x4*)(cvp + HALF + 4 * n); }
#pragma unroll
        for (int ai = 0; ai < 2; ++ai)
#pragma unroll
            for (int m = 0; m < 4; ++m) { const int r = row0 + ai * HALF + m * 16; bf16_t* rowp = O + (size_t)r * ldc + col0;
                const float rs = 1.0f / sqrtf(ss[r] * (1.0f / 1024.0f) + PG8_EPS);
                const f32x4 g0 = acc[ai][0][m][0] * rs + cg[0], g1 = acc[ai][0][m][1] * rs + cg[1], u0 = acc[ai][1][m][0] * rs + cu[0], u1 = acc[ai][1][m][1] * rs + cu[1];
                u32x4 w;
                w.x = cvt_pk_bf16(silu_f(g0[0]) * u0[0], silu_f(g0[1]) * u0[1]); w.y = cvt_pk_bf16(silu_f(g0[2]) * u0[2], silu_f(g0[3]) * u0[3]);
                w.z = cvt_pk_bf16(silu_f(g1[0]) * u1[0], silu_f(g1[1]) * u1[1]); w.w = cvt_pk_bf16(silu_f(g1[2]) * u1[2], silu_f(g1[3]) * u1[3]);
                *(u32x4*)rowp = w; }
    }
};


struct DualOrder {
    StaticOrder s1, s2; const bf16_t* A2; const bf16_t* Bt2;
    __host__ __device__ void init(int M1, int N1, int M2, int N2, int G_, int c_, const bf16_t* a2, const bf16_t* b2) { s1.init(M1, N1, G_, c_); s2.init(M2, N2, G_, c_); A2 = a2; Bt2 = b2; }
    __device__ __forceinline__ bool next(int i, Unit& u) const {
        const long L = (long)i * s1.G + s1.c;
        if (L < s1.nwg) return s1.next(i, u);
        const long L2 = L - s1.nwg; if (L2 >= s2.nwg) return false;
        StaticOrder t = s2; t.c = (int)(L2 % s2.G); const bool ok = t.next((int)(L2 / s2.G), u); u.kind = 1; return ok;
    }
    template <class G_> __device__ __forceinline__ const char* pa(const G_& g, const Unit& u, size_t tstep) const { return (const char*)(u.kind ? A2 : g.A) + (size_t)u.pm * tstep; }
    template <class G_> __device__ __forceinline__ const char* pb(const G_& g, const Unit& u, size_t tstep) const { return (const char*)(u.kind ? Bt2 : g.Bt) + (size_t)u.pn * tstep; }
    __device__ __forceinline__ void a_ready(const Unit&) const {}
    __device__ __forceinline__ void done(const Unit&) const {}
};
struct EpiDualIn {
    static constexpr bool PERM = true, AFTER_DRAIN = false;
    EpiStoreBf16N a; EpiStoreBf16T b;
    __device__ __forceinline__ void operator()(const f32x4 (&acc)[2][2][4][2], const Unit& u, int wr, int wc, int fr, int fq) const { if (u.kind) b(acc, u, wr, wc, fr, fq); else a(acc, u, wr, wc, fr, fq); }
};
template <class Epi, class Sched, bool ALIGN_EPI = false, bool SP2 = false>
__device__ __forceinline__ void gemm_phase(PG8_LAS unsigned char* lds, const Gemm g, const Sched& S, const Epi& E, const int wave0) {
    unsigned z_ = 0u; asm volatile("" : "+v"(z_)); const int lane_ = (int)__builtin_amdgcn_mbcnt_hi(~0u, __builtin_amdgcn_mbcnt_lo(~0u, z_));
    const int tid = (wave0 << 6) | lane_, wid = wave0, lane = lane_, wr = wid >> 2, wc = wid & 3, fr = lane & 15, fq = lane >> 4;
    const int K = g.K, nt = K / BK;
    unsigned voffA[2], voffB[2];
#pragma unroll
    for (int i = 0; i < 2; ++i) { int R, C; stage_rc(tid * 16 + i * 8192, R, C); const int Rb = Epi::PERM ? ((R & ~31) + perm32(R & 31)) : R;
        voffA[i] = (unsigned)(R * K + C) * 2u; voffB[i] = (unsigned)(Rb * K + C) * 2u; }
    const size_t kstep = (size_t)(BK * 2);
    const size_t hstep = (size_t)HALF * K * 2;
    const size_t tstep = 2 * hstep;
    const unsigned ldsw = (unsigned)wid * 1024u;
    const int aoff = lds_byte(wr * 64 + fr, fq * 8), boff = lds_byte(wc * 32 + fr, fq * 8);
#define PG8_SA(b, h) (((b) * 2 + (h)) * HTB)
#define PG8_SB(b, h) ((4 + (b) * 2 + (h)) * HTB)
#define PG8_STAGE(bufoff, gbase, voff) do { _Pragma("unroll") for (int _i = 0; _i < 2; ++_i) \
        __builtin_amdgcn_global_load_lds((const unsigned*)((const char*)(gbase) + (voff)[_i]), (PG8_LAS unsigned*)(lds + (bufoff) + ldsw + _i * 8192), 16, 0, 0); } while (0)
#define PG8_LDA(dst, b, h) do { _Pragma("unroll") for (int m = 0; m < 4; ++m) _Pragma("unroll") for (int k = 0; k < 2; ++k) dst[m][k] = *(const PG8_LAS bf16x8*)(lds + PG8_SA(b, h) + aoff + m * 2048 + k * 1024); } while (0)
#define PG8_LDB(dst, b, h) do { _Pragma("unroll") for (int n = 0; n < 2; ++n) _Pragma("unroll") for (int k = 0; k < 2; ++k) dst[n][k] = *(const PG8_LAS bf16x8*)(lds + PG8_SB(b, h) + boff + n * 2048 + k * 1024); } while (0)
#define PG8_MMA(ai, bj, At, Bt) do { __builtin_amdgcn_s_setprio(1); _Pragma("unroll") for (int m = 0; m < 4; ++m) _Pragma("unroll") for (int n = 0; n < 2; ++n) _Pragma("unroll") for (int k = 0; k < 2; ++k) \
        acc[ai][bj][m][n] = __builtin_amdgcn_mfma_f32_16x16x32_bf16(Bt[n][k], At[m][k], acc[ai][bj][m][n], 0, 0, 0); __builtin_amdgcn_s_setprio(0); } while (0)
#define PG8_WAIT_V(n) asm volatile("s_waitcnt vmcnt(" #n ")" ::: "memory")
#define PG8_WAIT_L(n) asm volatile("s_waitcnt lgkmcnt(" #n ")" ::: "memory")
#define PG8_BAR __builtin_amdgcn_s_barrier()
#define PG8_SCHED __builtin_amdgcn_sched_barrier(0)
    Unit cur, nxt; int ui = 0;
    if (!S.next(0, cur)) return;
    f32x4 acc[2][2][4][2];
#pragma unroll
    for (int a = 0; a < 2; ++a)
#pragma unroll
        for (int b = 0; b < 2; ++b)
#pragma unroll
            for (int m = 0; m < 4; ++m)
#pragma unroll
                for (int n = 0; n < 2; ++n) acc[a][b][m][n] = (f32x4){0.f, 0.f, 0.f, 0.f};
    bf16x8 At[4][2], B0[2][2], B1[2][2];
    const char* cA = S.pa(g, cur, tstep); const char* cB = S.pb(g, cur, tstep);
    S.a_ready(cur);
    if constexpr (SP2) {
        PG8_STAGE(PG8_SB(0, 0), cB, voffB); PG8_STAGE(PG8_SB(0, 1), cB + hstep, voffB); PG8_STAGE(PG8_SA(0, 0), cA, voffA); PG8_STAGE(PG8_SA(0, 1), cA + hstep, voffA);
        if (wr == 1) PG8_BAR;
        PG8_WAIT_V(2); PG8_BAR;
        PG8_STAGE(PG8_SB(1, 0), cB + kstep, voffB); PG8_STAGE(PG8_SA(1, 0), cA + kstep, voffA); PG8_STAGE(PG8_SB(1, 1), cB + hstep + kstep, voffB);
        PG8_WAIT_V(6); PG8_BAR;
    } else {
        PG8_STAGE(PG8_SB(0, 0), cB, voffB); PG8_STAGE(PG8_SA(0, 0), cA, voffA); PG8_STAGE(PG8_SB(0, 1), cB + hstep, voffB); PG8_STAGE(PG8_SA(0, 1), cA + hstep, voffA);
        if (wr == 1) PG8_BAR;
        PG8_WAIT_V(4); PG8_BAR;
        PG8_STAGE(PG8_SB(1, 0), cB + kstep, voffB); PG8_STAGE(PG8_SA(1, 0), cA + kstep, voffA); PG8_STAGE(PG8_SB(1, 1), cB + hstep + kstep, voffB);
        PG8_WAIT_V(6); PG8_BAR;
    }
    for (;;) {
        const bool has_next = S.next(ui + 1, nxt);
        const char* nA = has_next ? S.pa(g, nxt, tstep) : cA; const char* nB = has_next ? S.pb(g, nxt, tstep) : cB;
        for (int t = 0; t < nt; t += 2) {
            const bool last = (t == nt - 2);
            const char* a1 = cA + (size_t)(t + 1) * kstep;
            const char* a2 = last ? nA : cA + (size_t)(t + 2) * kstep; const char* b2 = last ? nB : cB + (size_t)(t + 2) * kstep;
            const char* a3 = a2 + kstep; const char* b3 = b2 + kstep;
            if (last && has_next) S.a_ready(nxt);
            if constexpr (SP2) {
            PG8_LDB(B0, 0, 0); PG8_LDB(B1, 0, 1); PG8_SCHED; PG8_LDA(At, 0, 0); PG8_STAGE(PG8_SA(1, 1), a1 + hstep, voffA);
            PG8_WAIT_V(8); PG8_WAIT_L(0); PG8_BAR; PG8_MMA(0, 0, At, B0); PG8_MMA(0, 1, At, B1); PG8_BAR; PG8_SCHED;
            PG8_LDA(At, 0, 1); PG8_STAGE(PG8_SB(0, 0), b2, voffB); PG8_STAGE(PG8_SB(0, 1), b2 + hstep, voffB); PG8_STAGE(PG8_SA(0, 0), a2, voffA);
            PG8_WAIT_V(8); PG8_WAIT_L(0); PG8_BAR; PG8_MMA(1, 0, At, B0); PG8_MMA(1, 1, At, B1); PG8_BAR; PG8_SCHED;
            PG8_LDB(B0, 1, 0); PG8_LDB(B1, 1, 1); PG8_SCHED; PG8_LDA(At, 1, 0); PG8_STAGE(PG8_SA(0, 1), a2 + hstep, voffA);
            PG8_WAIT_V(8); PG8_WAIT_L(0); PG8_BAR; PG8_MMA(0, 0, At, B0); PG8_MMA(0, 1, At, B1); PG8_BAR; PG8_SCHED;
            PG8_LDA(At, 1, 1); PG8_STAGE(PG8_SB(1, 0), b3, voffB); PG8_STAGE(PG8_SB(1, 1), b3 + hstep, voffB); PG8_STAGE(PG8_SA(1, 0), a3, voffA);
            PG8_WAIT_V(8); PG8_WAIT_L(0); PG8_BAR; PG8_MMA(1, 0, At, B0); PG8_MMA(1, 1, At, B1); PG8_BAR; PG8_SCHED;
            } else {
            PG8_LDB(B0, 0, 0); PG8_SCHED; PG8_LDA(At, 0, 0); PG8_STAGE(PG8_SA(1, 1), a1 + hstep, voffA);
            PG8_WAIT_L(8); PG8_BAR; PG8_WAIT_L(0); PG8_MMA(0, 0, At, B0); PG8_BAR; PG8_SCHED;
            PG8_LDB(B1, 0, 1); PG8_STAGE(PG8_SB(0, 0), b2, voffB);
            PG8_BAR; PG8_WAIT_L(0); PG8_MMA(0, 1, At, B1); PG8_BAR;
            PG8_LDA(At, 0, 1); PG8_STAGE(PG8_SA(0, 0), a2, voffA);
            PG8_BAR; PG8_WAIT_L(0); PG8_MMA(1, 0, At, B0); PG8_BAR; PG8_SCHED;
            PG8_STAGE(PG8_SB(0, 1), b2 + hstep, voffB);
            PG8_WAIT_V(6); PG8_BAR; PG8_MMA(1, 1, At, B1); PG8_BAR;
            PG8_LDB(B0, 1, 0); PG8_SCHED; PG8_LDA(At, 1, 0); PG8_STAGE(PG8_SA(0, 1), a2 + hstep, voffA);
            PG8_WAIT_L(8); PG8_BAR; PG8_WAIT_L(0); PG8_MMA(0, 0, At, B0); PG8_BAR; PG8_SCHED;
            PG8_LDB(B1, 1, 1); PG8_STAGE(PG8_SB(1, 0), b3, voffB);
            PG8_BAR; PG8_WAIT_L(0); PG8_MMA(0, 1, At, B1); PG8_BAR;
            PG8_LDA(At, 1, 1); PG8_STAGE(PG8_SA(1, 0), a3, voffA);
            PG8_BAR; PG8_WAIT_L(0); PG8_MMA(1, 0, At, B0); PG8_BAR; PG8_SCHED;
            PG8_STAGE(PG8_SB(1, 1), b3 + hstep, voffB);
            PG8_WAIT_V(6); PG8_BAR; PG8_MMA(1, 1, At, B1); PG8_BAR;
            }
        }
        if constexpr (ALIGN_EPI) { if (wr == 0) PG8_BAR; }
        if constexpr (!Epi::AFTER_DRAIN) { E(acc, cur, wr, wc, fr, fq); S.done(cur); }
        if (!has_next) break;
#pragma unroll
        for (int a = 0; a < 2; ++a)
#pragma unroll
            for (int b = 0; b < 2; ++b)
#pragma unroll
                for (int m = 0; m < 4; ++m)
#pragma unroll
                    for (int n = 0; n < 2; ++n) acc[a][b][m][n] = (f32x4){0.f, 0.f, 0.f, 0.f};
        cur = nxt; cA = nA; cB = nB; ++ui;
        if constexpr (ALIGN_EPI) { if (wr == 1) PG8_BAR; }
    }
    PG8_WAIT_V(0);
    if constexpr (!ALIGN_EPI) { if (wr == 0) PG8_BAR; }
    PG8_BAR;
    if constexpr (Epi::AFTER_DRAIN) { E.fused(acc, cur, wr, wc, fr, fq, lds, wid, lane); S.done(cur); }
#undef PG8_SA
#undef PG8_SB
#undef PG8_STAGE
#undef PG8_LDA
#undef PG8_LDB
#undef PG8_MMA
#undef PG8_WAIT_V
#undef PG8_WAIT_L
#undef PG8_BAR
#undef PG8_SCHED
}
}

constexpr int NB = 16, SEQ = 2048, DM = 1024, MTOK = NB * SEQ, DEPTH = 2;
constexpr int P_IN = 3608, FFH = 2816, UL = 2816, NTR = 1024;
constexpr int C_SZ = 0, C_SX = 256, C_SB = 512, C_SC = 768, C_NQ = 1024, C_NK = 1280, C_MQ = 1536, C_MK = 1792, C_MV = 2048, C_MO = 2304, C_G = 2560;
constexpr int TP = MTOK + 128;
constexpr int R_HY = 0, R_NV = 768;
constexpr float EPS = 1e-6f;
constexpr int NWAVES = 8, NTHR = 512;
constexpr size_t MiB = 1u << 20;
constexpr size_t WS_CTL = 0, WS_SS = 64 * 1024, CTL_ZERO_BYTES = 64 * 1024 + 5 * 131072;
constexpr size_t WS_MOD = 1 * MiB, WS_HID2 = 2 * MiB, WS_DT = 3 * MiB, WS_FILT = 4 * MiB, WS_W = 12 * MiB;
constexpr size_t W_IN_OFF = 0, W_HY_OFF = 5 * MiB + MiB / 2, W_OUT_OFF = 7 * MiB + MiB / 2, W_GU_OFF = 9 * MiB + MiB / 2, W_DN_OFF = 20 * MiB + MiB / 2, W_LAYER = 26 * MiB;
constexpr size_t WS_XN = 64 * MiB, WS_U = 128 * MiB, WS_UHT = 320 * MiB, WS_YS = 386 * MiB, WS_NAO = 418 * MiB, WS_MLH = 434 * MiB, WS_HYO = 466 * MiB, WS_CV = 484 * MiB, WS_END = 486 * MiB;
constexpr size_t WS_XN2 = WS_UHT;
constexpr int CVP = 9472;
constexpr int LDS_BYTES = 147456, MISC_OFF = 147456 - 128;

#define GAS __attribute__((address_space(1)))
#define LAS __attribute__((address_space(3)))
typedef unsigned short bf16;
typedef unsigned v4u __attribute__((ext_vector_type(4)));
typedef float f32x4 __attribute__((ext_vector_type(4)));
typedef __bf16 bf16v2 __attribute__((ext_vector_type(2)));
typedef float f32v2 __attribute__((ext_vector_type(2)));
__device__ __forceinline__ unsigned pk2(float lo, float hi) { const f32v2 v = {lo, hi}; return __builtin_bit_cast(unsigned, __builtin_convertvector(v, bf16v2)); }
__device__ __forceinline__ unsigned f2bf(float f) { return (unsigned)__builtin_bit_cast(unsigned short, (__bf16)f); }
__device__ __forceinline__ float bf2f(unsigned h) { return __builtin_bit_cast(float, h << 16); }
__device__ __forceinline__ float bflo(unsigned w) { return __builtin_bit_cast(float, w << 16); }
__device__ __forceinline__ float bfhi(unsigned w) { return __builtin_bit_cast(float, w & 0xffff0000u); }
__device__ __forceinline__ float wave_sum(float v) {
#pragma unroll
    for (int o = 1; o < 64; o <<= 1) v += __shfl_xor(v, o);
    return v;
}
__device__ __forceinline__ float wave_max(float v) {
#pragma unroll
    for (int o = 1; o < 64; o <<= 1) v = fmaxf(v, __shfl_xor(v, o));
    return v;
}
__device__ __forceinline__ float sigmoid_f(float v) { return 1.0f / (1.0f + __expf(-v)); }
__device__ __forceinline__ float silu_ff(float v) { return v / (1.0f + __expf(-v)); }
__device__ __forceinline__ float softplus_f(float v) { return v > 20.f ? v : log1pf(__expf(v)); }

__device__ __forceinline__ int fresh_tid(int wave0) { unsigned z = 0u; asm volatile("" : "+v"(z)); const int l = (int)__builtin_amdgcn_mbcnt_hi(~0u, __builtin_amdgcn_mbcnt_lo(~0u, z)); return (wave0 << 6) | l; }
typedef short bf16x8 __attribute__((ext_vector_type(8)));
#define MFMA16(a, b, c) __builtin_amdgcn_mfma_f32_16x16x32_bf16((a), (b), (c), 0, 0, 0)
struct Args { const float* in[31]; float* out; unsigned char* ws; int ph_lo, ph_hi; };

struct Ctx {
    LAS unsigned char* lds;
    int tid, lane, wave, bid, G, wave0;
    const Args* A; float* out; unsigned char* ws;
};
#define INP(i) (F.A->in[i])

__device__ __forceinline__ const float* wsrc(const Ctx& F, int which, int l, int j, int* ld) {
    if (which == 0) { *ld = P_IN; const float* w = INP(4) + (size_t)l * DM * P_IN;
        int o; if (j < 1024) o = j; else if (j < 1536) o = 1032 + (j - 1024); else if (j < 2560) o = 1800 + (j - 1536); else if (j < 2568) o = 1024 + (j - 2560); else if (j < 2584) o = 2824 + (j - 2568); else return nullptr;
        return w + o; }
    if (which == 1) { *ld = P_IN; return INP(4) + (size_t)l * DM * P_IN + (j < 768 ? 2840 + j : 1544 + (j - 768)); }
    if (which == 2) { *ld = DM; return INP(26) + (size_t)l * DM * DM + j; }
    if (which == 3) { *ld = FFH; const int t = j >> 8, w = j & 255; return (w < 128 ? INP(27) : INP(28)) + (size_t)l * DM * FFH + t * 128 + (w & 127); }
    *ld = DM; return INP(29) + (size_t)l * FFH * DM + j;
}
__device__ __forceinline__ void transpose_item(const Ctx& F, int which, int l, int K, bf16* WT, LAS float* scr, int item, int nblk) {
    const int lane = F.lane, kb = item / nblk, nb = item % nblk, k0 = 64 * kb, n0 = 32 * nb;
    int ld = 0; const float* cp = wsrc(F, which, l, n0 + (lane & 31), &ld);
    float tv[32];
#pragma unroll
    for (int i = 0; i < 32; ++i) { const int kk = 2 * i + (lane >> 5); tv[i] = cp ? cp[(size_t)(k0 + kk) * ld] : 0.f; }
#pragma unroll
    for (int i = 0; i < 32; ++i) { const int kk = 2 * i + (lane >> 5); scr[kk * 33 + (lane & 31)] = tv[i]; }
    asm volatile("s_waitcnt lgkmcnt(0)" ::: "memory");
    const int c = lane & 7;
#pragma unroll
    for (int j = 0; j < 4; ++j) { const int n = (lane >> 3) + 8 * j; const LAS float* s = scr + (8 * c) * 33 + n;
        v4u o; o.x = pk2(s[0 * 33], s[1 * 33]); o.y = pk2(s[2 * 33], s[3 * 33]); o.z = pk2(s[4 * 33], s[5 * 33]); o.w = pk2(s[6 * 33], s[7 * 33]);
        *(v4u*)(WT + (size_t)(n0 + n) * K + k0 + 8 * c) = o; }
    asm volatile("s_waitcnt lgkmcnt(0)" ::: "memory");
}
__device__ __forceinline__ void ph_prologue(Ctx& F) {
    const int gw = F.bid * NWAVES + F.wave, NGW = F.G * NWAVES, lane = F.lane;
    LAS float* scr = (LAS float*)(F.lds + F.wave * 16384);
    constexpr int I_IN = 16 * 88, I_HY = 16 * 32, I_OUT = 16 * 32, I_GU = 16 * 176, I_DN = 44 * 32, I_L = I_IN + I_HY + I_OUT + I_GU + I_DN;
    for (int it = gw; it < DEPTH * I_L; it += NGW) {
        const int l = it / I_L; int r = it % I_L; unsigned char* wb = F.ws + WS_W + (size_t)l * W_LAYER;
        if (r < I_IN) { transpose_item(F, 0, l, DM, (bf16*)(wb + W_IN_OFF), scr, r, 88); continue; } r -= I_IN;
        if (r < I_HY) { transpose_item(F, 1, l, DM, (bf16*)(wb + W_HY_OFF), scr, r, 32); continue; } r -= I_HY;
        if (r < I_OUT) { transpose_item(F, 2, l, DM, (bf16*)(wb + W_OUT_OFF), scr, r, 32); continue; } r -= I_OUT;
        if (r < I_GU) { transpose_item(F, 3, l, DM, (bf16*)(wb + W_GU_OFF), scr, r, 176); continue; } r -= I_GU;
        transpose_item(F, 4, l, FFH, (bf16*)(wb + W_DN_OFF), scr, r, 32);
    }
    for (int it = gw; it < DEPTH * SEQ; it += NGW) {
        const int l = it / SEQ, pos = it % SEQ;
        const float* w1 = INP(18) + l * 33 * 64; const float* b1 = INP(19) + l * 64; const float* w2 = INP(20) + l * 64 * 64; const float* b2 = INP(21) + l * 64; const float* fq = INP(23) + l * 128;
        const float t = (float)pos / 2047.0f;
        float z = b1[lane] + t * w1[lane];
        const float a = 6.283185307179586f * ((float)pos / 2048.0f);
#pragma unroll
        for (int i = 0; i < 16; ++i) { const float f = 1e-4f + (float)i * ((15.0f - 1e-4f) / 15.0f); const float ang = a * f;
            z += cosf(ang) * w1[(1 + i) * 64 + lane]; z -= sinf(ang) * w1[(17 + i) * 64 + lane]; }
        const float h1 = sinf(fq[lane] * z);
        float z2 = b2[lane];
        for (int i = 0; i < 64; ++i) z2 += __shfl(h1, i) * w2[i * 64 + lane];
        const float h2 = sinf(fq[64 + lane] * z2);
        ((float*)(F.ws + WS_HID2))[(size_t)it * 64 + lane] = h2;
    }
    __syncthreads();
    LAS float* cond = (LAS float*)F.lds; LAS float* part = (LAS float*)(F.lds + 65536);
    if (F.bid < 192) {
        for (int i = F.tid; i < NB * DM; i += NTHR) cond[i] = silu_ff(INP(1)[i]);
        __syncthreads();
        for (int it = F.bid; it < 192; it += F.G) {
            const int l = it / 96, n0 = (it % 96) * 64;
            const float* W = INP(2) + (size_t)l * DM * 6144 + n0 + lane;
            float acc[16];
#pragma unroll
            for (int b = 0; b < 16; ++b) acc[b] = 0.f;
            const int kb = F.wave * 128;
            for (int k8 = 0; k8 < 128; k8 += 16) { float wv[16];
#pragma unroll
                for (int j = 0; j < 16; ++j) wv[j] = W[(size_t)(kb + k8 + j) * 6144];
#pragma unroll
                for (int j = 0; j < 16; ++j)
#pragma unroll
                    for (int b = 0; b < 16; ++b) acc[b] += cond[b * DM + kb + k8 + j] * wv[j]; }
#pragma unroll
            for (int b = 0; b < 16; ++b) part[(F.wave * 16 + b) * 64 + lane] = acc[b];
            __syncthreads();
            for (int o = F.tid; o < 1024; o += NTHR) { const int b = o >> 6, cidx = o & 63; float s = INP(3)[l * 6144 + n0 + cidx];
#pragma unroll
                for (int w = 0; w < 8; ++w) s += part[(w * 16 + b) * 64 + cidx];
                ((float*)(F.ws + WS_MOD))[(size_t)(l * NB + b) * 6144 + n0 + cidx] = s; }
            __syncthreads();
        }
    }
}

__device__ __forceinline__ void ph_xn0(Ctx& F, const float* mod_l) {
    const int gw = F.bid * NWAVES + F.wave, NGW = F.G * NWAVES;
    bf16* XN = (bf16*)(F.ws + WS_XN); float* ss = (float*)(F.ws + WS_SS);
    for (int m0 = gw * 4; m0 < MTOK; m0 += NGW * 4) {
        f32x4 v[4][4], sc[4][4];
#pragma unroll
        for (int u = 0; u < 4; ++u) { const int m = m0 + u; const f32x4* xr = (const f32x4*)(INP(0) + (size_t)m * DM) + F.lane; const float* mb = mod_l + (size_t)(m >> 11) * 6144 + 1024;
#pragma unroll
            for (int j = 0; j < 4; ++j) { v[u][j] = xr[64 * j]; sc[u][j] = *((const f32x4*)mb + F.lane + 64 * j); } }
#pragma unroll
        for (int u = 0; u < 4; ++u) { const int m = m0 + u; float s = 0.f;
#pragma unroll
            for (int j = 0; j < 4; ++j) s += (v[u][j].x * v[u][j].x + v[u][j].y * v[u][j].y) + (v[u][j].z * v[u][j].z + v[u][j].w * v[u][j].w);
            s = wave_sum(s); if (F.lane == 0) ss[m] = s;
            unsigned long long* o8 = (unsigned long long*)(XN + (size_t)m * DM) + F.lane;
#pragma unroll
            for (int j = 0; j < 4; ++j) o8[64 * j] = (unsigned long long)pk2(v[u][j].x * (1.f + sc[u][j].x), v[u][j].y * (1.f + sc[u][j].y)) | ((unsigned long long)pk2(v[u][j].z * (1.f + sc[u][j].z), v[u][j].w * (1.f + sc[u][j].w)) << 32); }
    }
}
__device__ __forceinline__ void ph_final(Ctx& F) {
    const float* g = INP(30); const float* ss = (const float*)(F.ws + WS_SS) + 4 * MTOK;
    const int gt = F.bid * NTHR + F.tid, NT = F.G * NTHR;
    for (int i0 = gt; i0 < MTOK * (DM / 4); i0 += 8 * NT) { f32x4 xv[8]; float sv[8];
#pragma unroll
        for (int u = 0; u < 8; ++u) { const int i = i0 + u * NT; xv[u] = ((const f32x4*)F.out)[i]; sv[u] = ss[i >> 8]; }
#pragma unroll
        for (int u = 0; u < 8; ++u) { const int i = i0 + u * NT; ((f32x4*)F.out)[i] = xv[u] * (1.0f / sqrtf(sv[u] * (1.f / DM) + EPS)) * *((const f32x4*)g + (i & 255)); } }
}
__device__ __forceinline__ void ph_cvec(Ctx& F) {
    const int gw = F.bid * NWAVES + F.wave, NGW = F.G * NWAVES, lane = F.lane, fr = lane & 15, fg = lane >> 4;
    for (int it = gw; it < DEPTH * (CVP / 16); it += NGW) {
        const int l = it / (CVP / 16), n0 = (it % (CVP / 16)) * 16; unsigned char* wb = F.ws + WS_W + (size_t)l * W_LAYER;
        const bf16* wt = n0 < 2816 ? (const bf16*)(wb + W_IN_OFF) + (size_t)n0 * DM : n0 < 3840 ? (const bf16*)(wb + W_HY_OFF) + (size_t)(n0 - 2816) * DM : (const bf16*)(wb + W_GU_OFF) + (size_t)(n0 - 3840) * DM;
        const float* sh = (const float*)(F.ws + WS_MOD) + (size_t)(l * NB + fr) * 6144 + (n0 < 3840 ? 0 : 3072) + 8 * fg;
        const bf16* wp = wt + (size_t)fr * DM + 8 * fg;
        f32x4 acc = (f32x4){0.f, 0.f, 0.f, 0.f};
#pragma unroll 8
        for (int ks = 0; ks < 32; ++ks) { const f32x4 a0 = *(const f32x4*)(sh + 32 * ks), a1 = *(const f32x4*)(sh + 32 * ks + 4);
            v4u aw; aw[0] = pk2(a0[0], a0[1]); aw[1] = pk2(a0[2], a0[3]); aw[2] = pk2(a1[0], a1[1]); aw[3] = pk2(a1[2], a1[3]);
            acc = MFMA16(__builtin_bit_cast(bf16x8, aw), *(const bf16x8*)(wp + 32 * ks), acc); }
        float* cvo = (float*)(F.ws + WS_CV) + (size_t)l * NB * CVP + n0 + fr;
#pragma unroll
        for (int r = 0; r < 4; ++r) cvo[(size_t)(4 * fg + r) * CVP] = acc[r];
    }
}

__device__ __forceinline__ void ph_filters(Ctx& F) {
    const int lane = F.lane, fr = lane & 15, fg = lane >> 4, w = F.wave;
    for (int it = F.bid; it < DEPTH * 2 * 32; it += F.G) {
        const int l = it >> 6, o = (it >> 5) & 1, co = it & 31;
        const int dir = fr >> 3, ch = co * 8 + (fr & 7);
        const float* w3 = INP(22) + (size_t)l * 64 * 1024 + o * 512 + dir * 256 + ch;
        bf16x8 bw[2], bwl[2];
#pragma unroll
        for (int ks = 0; ks < 2; ++ks) { v4u pw, pl;
#pragma unroll
            for (int e = 0; e < 4; ++e) { const float x0 = w3[(size_t)(32 * ks + 8 * fg + 2 * e) * 1024], x1 = w3[(size_t)(32 * ks + 8 * fg + 2 * e + 1) * 1024];
                pw[e] = pk2(x0, x1); pl[e] = pk2(x0 - bflo(pw[e]), x1 - bfhi(pw[e])); }
            bw[ks] = __builtin_bit_cast(bf16x8, pw); bwl[ks] = __builtin_bit_cast(bf16x8, pl); }
        const float delta = 3.0701134573253945f + (float)ch * ((15.350567286626972f - 3.0701134573253945f) / 255.0f);
        const float* hid = (const float*)(F.ws + WS_HID2) + (size_t)l * SEQ * 64 + (size_t)(256 * w + fr) * 64 + 8 * fg;
        float ss = 0.f;
        LAS f32x4* vals = (LAS f32x4*)F.lds + (size_t)w * 16 * 64 + lane;
#pragma unroll 2
        for (int ii = 0; ii < 16; ++ii) { const float* hp = hid + (size_t)(16 * ii) * 64;
            const f32x4 h0 = *(const f32x4*)hp, h1 = *(const f32x4*)(hp + 4), h2 = *(const f32x4*)(hp + 32), h3 = *(const f32x4*)(hp + 36);
            v4u pa, pb, qa, qb;
#pragma unroll
            for (int e = 0; e < 2; ++e) { pa[e] = pk2(h0[2 * e], h0[2 * e + 1]); pa[2 + e] = pk2(h1[2 * e], h1[2 * e + 1]); pb[e] = pk2(h2[2 * e], h2[2 * e + 1]); pb[2 + e] = pk2(h3[2 * e], h3[2 * e + 1]);
                qa[e] = pk2(h0[2 * e] - bflo(pa[e]), h0[2 * e + 1] - bfhi(pa[e])); qa[2 + e] = pk2(h1[2 * e] - bflo(pa[2 + e]), h1[2 * e + 1] - bfhi(pa[2 + e]));
                qb[e] = pk2(h2[2 * e] - bflo(pb[e]), h2[2 * e + 1] - bfhi(pb[e])); qb[2 + e] = pk2(h3[2 * e] - bflo(pb[2 + e]), h3[2 * e + 1] - bfhi(pb[2 + e])); }
            f32x4 a = (f32x4){0.f, 0.f, 0.f, 0.f};
            a = MFMA16(__builtin_bit_cast(bf16x8, qa), bw[0], a); a = MFMA16(__builtin_bit_cast(bf16x8, qb), bw[1], a);
            a = MFMA16(__builtin_bit_cast(bf16x8, pa), bwl[0], a); a = MFMA16(__builtin_bit_cast(bf16x8, pb), bwl[1], a);
            a = MFMA16(__builtin_bit_cast(bf16x8, pa), bw[0], a); a = MFMA16(__builtin_bit_cast(bf16x8, pb), bw[1], a);
#pragma unroll
            for (int r = 0; r < 4; ++r) { const int p = 256 * w + 16 * ii + 4 * fg + r; a[r] *= __expf(-((float)p / 2047.0f) * delta); ss += a[r] * a[r]; }
            vals[ii * 64] = a; }
        ss += __shfl_xor(ss, 8); ss += __shfl_xor(ss, 16); ss += __shfl_xor(ss, 32);
        LAS float* red = (LAS float*)(F.lds + 131072);
        __syncthreads();
        if (lane < 8) red[w * 8 + lane] = ss;
        __syncthreads();
        float tot = 0.f;
#pragma unroll
        for (int q = 0; q < 8; ++q) tot += red[q * 8 + (fr & 7)];
        const float scale = 1.0f / sqrtf(tot + EPS);
        bf16* fo = (bf16*)(F.ws + WS_FILT) + ((size_t)((l * 2 + o) * 256 + ch)) * 4096 + 2048;
#pragma unroll 2
        for (int ii = 0; ii < 16; ++ii) { const f32x4 a = vals[ii * 64];
#pragma unroll
            for (int r = 0; r < 4; ++r) { const int p = 256 * w + 16 * ii + 4 * fg + r; const unsigned short v = (unsigned short)f2bf(a[r] * scale);
                const bool unused = dir == 1 && p == 0;
                fo[unused ? -2048 : (dir == 0 ? -p : p)] = unused ? (unsigned short)0 : v; } }
    }
}

__device__ __forceinline__ void ph_prepass(Ctx& F, int l) {
    const bf16* U = (const bf16*)(F.ws + WS_U); bf16* XBC = (bf16*)(F.ws + WS_XN); float* DT = (float*)(F.ws + WS_DT);
    const float* cw = INP(5) + l * 3 * 768; const float* cb = INP(6) + l * 768; const float* dtb = INP(7) + l * 8;
    const int gt = F.bid * NTHR + F.tid, NT = F.G * NTHR;
    for (int it0 = gt; it0 < MTOK * 96; it0 += 4 * NT) {
        v4u um[4], u0[4], upn[4];
#pragma unroll
        for (int u = 0; u < 4; ++u) { const int it = it0 + u * NT, tok = it / 96, cg = it % 96; const bf16* up = U + (size_t)tok * UL + C_SX + cg * 8;
            um[u] = *(const v4u*)(up - UL); u0[u] = *(const v4u*)up; upn[u] = *(const v4u*)(up + UL); }
#pragma unroll
        for (int u = 0; u < 4; ++u) { const int it = it0 + u * NT, tok = it / 96, cg = it % 96, t = tok & (SEQ - 1), c0 = cg * 8;
            const v4u z4 = {0u, 0u, 0u, 0u}; const v4u a = t > 0 ? um[u] : z4, b = u0[u], cc = t < SEQ - 1 ? upn[u] : z4;
            float r[8];
#pragma unroll
            for (int q = 0; q < 4; ++q) {
                const int c = c0 + 2 * q;
                const float a0 = cw[c] * bflo(a[q]) + cw[768 + c] * bflo(b[q]) + cw[1536 + c] * bflo(cc[q]) + cb[c];
                const float a1 = cw[c + 1] * bfhi(a[q]) + cw[768 + c + 1] * bfhi(b[q]) + cw[1536 + c + 1] * bfhi(cc[q]) + cb[c + 1];
                r[2 * q] = silu_ff(a0); r[2 * q + 1] = silu_ff(a1); }
            v4u o; o.x = pk2(r[0], r[1]); o.y = pk2(r[2], r[3]); o.z = pk2(r[4], r[5]); o.w = pk2(r[6], r[7]);
            *(v4u*)(XBC + (size_t)tok * 768 + c0) = o; }
    }
    for (int it = gt; it < MTOK * 8; it += NT) { const int tok = it >> 3, j = it & 7;
        DT[it] = softplus_f(bf2f(U[(size_t)tok * UL + C_G + j]) + dtb[j]); }
}

typedef short s16x4 __attribute__((ext_vector_type(4)));
typedef unsigned u2v __attribute__((ext_vector_type(2)));
__device__ __forceinline__ bf16x8 lds_b128(LAS unsigned char* p) { return *(LAS bf16x8*)p; }
__device__ __forceinline__ bf16x8 lds_tr8(LAS unsigned char* base, int pitch, int lane) {
    const int fg = lane >> 4, q = (lane & 15) >> 2, p = lane & 3;
    LAS unsigned char* a = base + (8 * fg + q) * pitch + 8 * p;
    const s16x4 lo = __builtin_amdgcn_ds_read_tr16_b64_v4i16((LAS s16x4*)a);
    const s16x4 hi = __builtin_amdgcn_ds_read_tr16_b64_v4i16((LAS s16x4*)(a + 4 * pitch));
    bf16x8 r; r[0] = lo[0]; r[1] = lo[1]; r[2] = lo[2]; r[3] = lo[3]; r[4] = hi[0]; r[5] = hi[1]; r[6] = hi[2]; r[7] = hi[3]; return r;
}
__device__ __forceinline__ float wave_incl_sum(float a, int lane) {
#pragma unroll
    for (int o = 1; o < 64; o <<= 1) { const float t = __shfl_up(a, o); if (lane >= o) a += t; }
    return a;
}
__device__ __forceinline__ float wave_incl_max(float a, int lane) {
#pragma unroll
    for (int o = 1; o < 64; o <<= 1) { const float t = __shfl_up(a, o); if (lane >= o) a = fmaxf(a, t); }
    return a;
}
constexpr int SP_C = 272, SP_X = 144;
constexpr int SB_CS = 0, SB_BS = 17408, SB_XD = 34816, SB_XW = 44032, SB_SIZE = 53248, S_SC = 106496, S_SBF = 115712;
__device__ __forceinline__ void ssd_item(Ctx& F, int l, int it) {
    const int b = it >> 3, dir = (it >> 2) & 1, h = it & 3, grp = h >> 1;
    const int tid = F.tid, lane = F.lane, w = F.wave, fr = lane & 15, fg = lane >> 4, tb = w >> 1, half = w & 1;
    const bf16* XBC = (const bf16*)(F.ws + WS_XN); const float* DT = (const float*)(F.ws + WS_DT);
    bf16* YS = (bf16*)(F.ws + WS_YS) + (size_t)dir * MTOK * 256;
    const float A = -__expf(INP(8)[l * 8 + dir * 4 + h]); const float Dk = dir == 0 ? INP(9)[l * 4 + h] : 0.f;
    LAS unsigned char* L = F.lds;
#define SSD_TOK(c, tau) ((size_t)b * SEQ + (dir ? SEQ - 1 - ((c) * 64 + (tau)) : (c) * 64 + (tau)))
    f32x4 sacc[4];
#pragma unroll
    for (int i = 0; i < 4; ++i) sacc[i] = (f32x4){0.f, 0.f, 0.f, 0.f};
    for (int i = tid; i < 17408 / 16; i += NTHR) *(LAS v4u*)(L + S_SBF + 16 * i) = (v4u){0u, 0u, 0u, 0u};
    v4u pc0[2], pbv0[2], px0, pc1[2], pbv1[2], px1; float pdt0, pdt1;
#define SSD_LOAD(c, S) do { \
        _Pragma("unroll") for (int k = 0; k < 2; ++k) { const int idx = tid + 512 * k, tau = idx >> 4, ch = idx & 15; const bf16* rp = XBC + SSD_TOK(c, tau) * 768 + grp * 128 + 8 * ch; \
            pbv##S[k] = *(const v4u*)(rp + 256); pc##S[k] = *(const v4u*)(rp + 512); } \
        { const int tau = tid >> 3, ch = tid & 7; px##S = *(const v4u*)(XBC + SSD_TOK(c, tau) * 768 + h * 64 + 8 * ch); } \
        pdt##S = DT[SSD_TOK(c, lane) * 8 + dir * 4 + h]; } while (0)
#define SSD_STAGE(bo, dtv, acum, alast, S) do { \
        _Pragma("unroll") for (int k = 0; k < 2; ++k) { const int idx = tid + 512 * k, tau = idx >> 4, ch = idx & 15; \
            *(LAS v4u*)(L + (bo) + SB_BS + tau * SP_C + ch * 16) = pbv##S[k]; *(LAS v4u*)(L + (bo) + SB_CS + tau * SP_C + ch * 16) = pc##S[k]; } \
        { const int tau = tid >> 3, ch = tid & 7; const float dts = __shfl(dtv, tau), es = __expf((alast) - __shfl(acum, tau)) * dts; v4u od, ow; \
          _Pragma("unroll") for (int e = 0; e < 4; ++e) { const float x0 = bflo(px##S[e]), x1 = bfhi(px##S[e]); od[e] = pk2(x0 * dts, x1 * dts); ow[e] = pk2(x0 * es, x1 * es); } \
          *(LAS v4u*)(L + (bo) + SB_XD + tau * SP_X + ch * 16) = od; *(LAS v4u*)(L + (bo) + SB_XW + tau * SP_X + ch * 16) = ow; } } while (0)
#define SSD_CHUNK(c, CS, NS) do { \
        const int bo = ((c) & 1) * SB_SIZE; \
        __syncthreads();                                                       \
        if ((c) + 2 < 32) SSD_LOAD((c) + 2, CS); \
        bf16x8 ca[4]; \
        _Pragma("unroll") for (int ks = 0; ks < 4; ++ks) ca[ks] = lds_b128(L + bo + SB_CS + (16 * tb + fr) * SP_C + (32 * ks + 8 * fg) * 2); \
        f32x4 yoff[2];                                                         \
        _Pragma("unroll") for (int pbi = 0; pbi < 2; ++pbi) { yoff[pbi] = (f32x4){0.f, 0.f, 0.f, 0.f}; \
            _Pragma("unroll") for (int ks = 0; ks < 4; ++ks) yoff[pbi] = MFMA16(lds_b128(L + S_SBF + (16 * (2 * half + pbi) + fr) * SP_C + (32 * ks + 8 * fg) * 2), ca[ks], yoff[pbi]); } \
        const int tlc = 16 * tb + fr; const float atc = __shfl(acum, tlc), dtc = __shfl(dtv, tlc); \
        _Pragma("unroll") for (int sbi = 0; sbi < 2; ++sbi) { const int sb = 2 * half + sbi; f32x4 g = (f32x4){0.f, 0.f, 0.f, 0.f};     \
            if (sb <= tb) { \
                _Pragma("unroll") for (int ks = 0; ks < 4; ++ks) g = MFMA16(lds_b128(L + bo + SB_BS + (16 * sb + fr) * SP_C + (32 * ks + 8 * fg) * 2), ca[ks], g); } \
            float sv[4]; \
            _Pragma("unroll") for (int r = 0; r < 4; ++r) { const int sl = 16 * sb + 4 * fg + r; const float as_ = __shfl(acum, sl); \
                float v = sl <= tlc ? g[r] * __expf(atc - as_) : 0.f; if (sl == tlc) v += Dk / dtc; sv[r] = v; } \
            u2v so; so.x = pk2(sv[0], sv[1]); so.y = pk2(sv[2], sv[3]); *(LAS u2v*)(L + S_SC + tlc * SP_X + (16 * sb + 4 * fg) * 2) = so; } \
        { const float dec = __expf(alast); \
          _Pragma("unroll") for (int i = 0; i < 4; ++i) sacc[i] *= dec; \
          _Pragma("unroll") for (int ks = 0; ks < 2; ++ks) { const bf16x8 af = lds_tr8(L + bo + SB_BS + (32 * ks) * SP_C + (16 * w) * 2, SP_C, lane); \
              _Pragma("unroll") for (int pb = 0; pb < 4; ++pb) sacc[pb] = MFMA16(af, lds_tr8(L + bo + SB_XW + (32 * ks) * SP_X + (16 * pb) * 2, SP_X, lane), sacc[pb]); } } \
        __syncthreads();                                                       \
        { const float eat = __expf(atc); \
        _Pragma("unroll") for (int pbi = 0; pbi < 2; ++pbi) { const int pb = 2 * half + pbi; f32x4 yd = (f32x4){0.f, 0.f, 0.f, 0.f}; \
            _Pragma("unroll") for (int ks = 0; ks < 2; ++ks) yd = MFMA16(lds_tr8(L + bo + SB_XD + (32 * ks) * SP_X + (16 * pb) * 2, SP_X, lane), lds_b128(L + S_SC + (16 * tb + fr) * SP_X + (32 * ks + 8 * fg) * 2), yd); \
            u2v yo; yo.x = pk2(yd[0] + eat * yoff[pbi][0], yd[1] + eat * yoff[pbi][1]); yo.y = pk2(yd[2] + eat * yoff[pbi][2], yd[3] + eat * yoff[pbi][3]); \
            *(u2v*)(YS + SSD_TOK(c, tlc) * 256 + h * 64 + 16 * pb + 4 * fg) = yo; } } \
        _Pragma("unroll") for (int pb = 0; pb < 4; ++pb) { u2v o; o.x = pk2(sacc[pb][0], sacc[pb][1]); o.y = pk2(sacc[pb][2], sacc[pb][3]); \
            *(LAS u2v*)(L + S_SBF + (16 * pb + fr) * SP_C + (16 * w + 4 * fg) * 2) = o; } \
        if ((c) + 1 < 32) { dtv = pdt##NS; acum = wave_incl_sum(pdt##NS * A, lane); alast = __shfl(acum, 63); SSD_STAGE((((c) + 1) & 1) * SB_SIZE, dtv, acum, alast, NS); } } while (0)
    SSD_LOAD(0, 0);
    float dtv = pdt0, acum = wave_incl_sum(pdt0 * A, lane), alast = __shfl(acum, 63);
    SSD_STAGE(0, dtv, acum, alast, 0);
    SSD_LOAD(1, 1);
    for (int c2 = 0; c2 < 32; c2 += 2) { SSD_CHUNK(c2, 0, 1); SSD_CHUNK(c2 + 1, 1, 0); }
    __syncthreads();
#undef SSD_CHUNK
#undef SSD_LOAD
#undef SSD_STAGE
#undef SSD_TOK
}
constexpr int MB_QS = 0, MB_KS = 9216, MB_KW = 18432, MB_VS = 27648, MB_SIZE = 36864, M_SC = 73728, M_CBF = 82944, M_NBF = 92160;
__device__ __forceinline__ void ml_item(Ctx& F, int l, int it) {
    const int b = it >> 3, dir = (it >> 2) & 1, h = it & 3;
    const int tid = F.tid, lane = F.lane, w = F.wave, fr = lane & 15, fg = lane >> 4, tb = w >> 1, half = w & 1;
    const bf16* U = (const bf16*)(F.ws + WS_U);
    bf16* MLH = (bf16*)(F.ws + WS_MLH) + (size_t)dir * MTOK * 256;
    const float ib = INP(13)[l * 8 + dir * 4 + h], fb = INP(14)[l * 8 + dir * 4 + h];
    LAS unsigned char* L = F.lds;
#define ML_TOK(c, tau) ((size_t)b * SEQ + (dir ? SEQ - 1 - ((c) * 64 + (tau)) : (c) * 64 + (tau)))
    f32x4 cacc[2], nacc = (f32x4){0.f, 0.f, 0.f, 0.f};
    cacc[0] = (f32x4){0.f, 0.f, 0.f, 0.f}; cacc[1] = (f32x4){0.f, 0.f, 0.f, 0.f};
    for (int i = tid; i < (M_NBF + 256 - M_CBF) / 16; i += NTHR) *(LAS v4u*)(L + M_CBF + 16 * i) = (v4u){0u, 0u, 0u, 0u};
    bf16x8 ones;
#pragma unroll
    for (int j = 0; j < 8; ++j) ones[j] = (short)0x3F80;
    v4u pq0, pk0, pv0, pq1, pk1, pv1; float pli0, plf0, pli1, plf1;
#define ML_LOAD(c, S) do { \
        { const int tau = tid >> 3, ch = tid & 7; const bf16* rp = U + ML_TOK(c, tau) * UL + h * 64 + 8 * ch; pq##S = *(const v4u*)(rp + C_MQ); pk##S = *(const v4u*)(rp + C_MK); pv##S = *(const v4u*)(rp + C_MV); } \
        { const bf16* gp = U + ML_TOK(c, lane) * UL + C_G + dir * 4 + h; pli##S = bf2f(gp[8]) + ib; plf##S = -softplus_f(-(bf2f(gp[16]) + fb)); } } while (0)
#define ML_STAGE(bo, av, Mlast, S) do { const int tau = tid >> 3, ch = tid & 7; const float ks = 0.125f * __expf(__shfl(av, tau) - (Mlast)); v4u ow; \
        _Pragma("unroll") for (int e = 0; e < 4; ++e) ow[e] = pk2(bflo(pk##S[e]) * ks, bfhi(pk##S[e]) * ks); \
        *(LAS v4u*)(L + (bo) + MB_QS + tau * SP_X + ch * 16) = pq##S; *(LAS v4u*)(L + (bo) + MB_KS + tau * SP_X + ch * 16) = pk##S; \
        *(LAS v4u*)(L + (bo) + MB_KW + tau * SP_X + ch * 16) = ow; *(LAS v4u*)(L + (bo) + MB_VS + tau * SP_X + ch * 16) = pv##S; } while (0)
#define ML_CHUNK(c, CS, NS) do { \
        const int bo = ((c) & 1) * MB_SIZE; \
        __syncthreads();                                                       \
        if ((c) + 2 < 32) ML_LOAD((c) + 2, CS); \
        bf16x8 qa[2]; \
        _Pragma("unroll") for (int ks = 0; ks < 2; ++ks) qa[ks] = lds_b128(L + bo + MB_QS + (16 * tb + fr) * SP_X + (32 * ks + 8 * fg) * 2); \
        f32x4 yint[2], dint = (f32x4){0.f, 0.f, 0.f, 0.f};                     \
        _Pragma("unroll") for (int ebi = 0; ebi < 2; ++ebi) { yint[ebi] = (f32x4){0.f, 0.f, 0.f, 0.f}; \
            _Pragma("unroll") for (int ks = 0; ks < 2; ++ks) yint[ebi] = MFMA16(lds_b128(L + M_CBF + (16 * (2 * half + ebi) + fr) * SP_X + (32 * ks + 8 * fg) * 2), qa[ks], yint[ebi]); } \
        _Pragma("unroll") for (int ks = 0; ks < 2; ++ks) dint = MFMA16(lds_b128(L + M_NBF + (32 * ks + 8 * fg) * 2), qa[ks], dint); \
        const int tlc = 16 * tb + fr; const float Mtc = __shfl(Mv, tlc), btc = __shfl(bcum, tlc); \
        _Pragma("unroll") for (int sbi = 0; sbi < 2; ++sbi) { const int sb = 2 * half + sbi; f32x4 g = (f32x4){0.f, 0.f, 0.f, 0.f}; \
            if (sb <= tb) { \
                _Pragma("unroll") for (int ks = 0; ks < 2; ++ks) g = MFMA16(lds_b128(L + bo + MB_KS + (16 * sb + fr) * SP_X + (32 * ks + 8 * fg) * 2), qa[ks], g); } \
            float sv[4]; \
            _Pragma("unroll") for (int r = 0; r < 4; ++r) { const int sl = 16 * sb + 4 * fg + r; const float as_ = __shfl(av, sl); \
                sv[r] = sl <= tlc ? g[r] * 0.125f * __expf(as_ - Mtc) : 0.f; } \
            u2v so; so.x = pk2(sv[0], sv[1]); so.y = pk2(sv[2], sv[3]); *(LAS u2v*)(L + M_SC + tlc * SP_X + (16 * sb + 4 * fg) * 2) = so; } \
        { const float dec = __expf(mprev - Mlast); \
          cacc[0] *= dec; cacc[1] *= dec; nacc *= dec; \
          _Pragma("unroll") for (int ks = 0; ks < 2; ++ks) { const bf16x8 af = lds_tr8(L + bo + MB_KW + (32 * ks) * SP_X + (16 * tb) * 2, SP_X, lane); \
              nacc = MFMA16(af, ones, nacc); \
              _Pragma("unroll") for (int ebi = 0; ebi < 2; ++ebi) cacc[ebi] = MFMA16(af, lds_tr8(L + bo + MB_VS + (32 * ks) * SP_X + (16 * (2 * half + ebi)) * 2, SP_X, lane), cacc[ebi]); } } \
        __syncthreads();                                                       \
        { f32x4 dintra = (f32x4){0.f, 0.f, 0.f, 0.f}; bf16x8 sa[2]; \
          _Pragma("unroll") for (int ks = 0; ks < 2; ++ks) { sa[ks] = lds_b128(L + M_SC + (16 * tb + fr) * SP_X + (32 * ks + 8 * fg) * 2); dintra = MFMA16(ones, sa[ks], dintra); } \
          const float wi = __expf(mprev - Mtc), den = wi * dint[0] + dintra[0], dn = 1.0f / fmaxf(fabsf(den), __expf(-(btc + Mtc))); \
          _Pragma("unroll") for (int ebi = 0; ebi < 2; ++ebi) { const int eb = 2 * half + ebi; f32x4 yd = (f32x4){0.f, 0.f, 0.f, 0.f}; \
              _Pragma("unroll") for (int ks = 0; ks < 2; ++ks) yd = MFMA16(lds_tr8(L + bo + MB_VS + (32 * ks) * SP_X + (16 * eb) * 2, SP_X, lane), sa[ks], yd); \
              u2v ho; ho.x = pk2((wi * yint[ebi][0] + yd[0]) * dn, (wi * yint[ebi][1] + yd[1]) * dn); ho.y = pk2((wi * yint[ebi][2] + yd[2]) * dn, (wi * yint[ebi][3] + yd[3]) * dn); \
              *(u2v*)(MLH + ML_TOK(c, tlc) * 256 + h * 64 + 16 * eb + 4 * fg) = ho; } } \
        _Pragma("unroll") for (int ebi = 0; ebi < 2; ++ebi) { u2v o; o.x = pk2(cacc[ebi][0], cacc[ebi][1]); o.y = pk2(cacc[ebi][2], cacc[ebi][3]); \
            *(LAS u2v*)(L + M_CBF + (16 * (2 * half + ebi) + fr) * SP_X + (16 * tb + 4 * fg) * 2) = o; } \
        if (half == 0 && fr == 0) { u2v o; o.x = pk2(nacc[0], nacc[1]); o.y = pk2(nacc[2], nacc[3]); *(LAS u2v*)(L + M_NBF + (16 * tb + 4 * fg) * 2) = o; } \
        mprev = blast + Mlast; \
        if ((c) + 1 < 32) { bcum = wave_incl_sum(plf##NS, lane); av = pli##NS - bcum; Mv = fmaxf(mprev, wave_incl_max(av, lane)); Mlast = __shfl(Mv, 63); blast = __shfl(bcum, 63); \
            ML_STAGE((((c) + 1) & 1) * MB_SIZE, av, Mlast, NS); } } while (0)
    float mprev = 0.f;
    ML_LOAD(0, 0);
    float bcum = wave_incl_sum(plf0, lane), av = pli0 - bcum, Mv = fmaxf(mprev, wave_incl_max(av, lane)), Mlast = __shfl(Mv, 63), blast = __shfl(bcum, 63);
    ML_STAGE(0, av, Mlast, 0);
    ML_LOAD(1, 1);
    for (int c2 = 0; c2 < 32; c2 += 2) { ML_CHUNK(c2, 0, 1); ML_CHUNK(c2 + 1, 1, 0); }
    __syncthreads();
#undef ML_CHUNK
#undef ML_LOAD
#undef ML_STAGE
#undef ML_TOK
}
constexpr int NA_RPB_OFF = 135168;
__device__ __forceinline__ void na_wave_item(Ctx& F, int l, int wi) {
    const int jb = wi & 3, r = (wi >> 2) & 31, h = (wi >> 7) & 3, b = wi >> 9, lane = F.lane, fr = lane & 15, fg = lane >> 4;
    const bf16* U = (const bf16*)(F.ws + WS_U); const bf16* VT = (const bf16*)(F.ws + WS_UHT) + (size_t)(R_NV + h * 64) * TP; bf16* NAO = (bf16*)(F.ws + WS_NAO);
    const LAS float* rpb = (const LAS float*)(F.lds + NA_RPB_OFF) + h * 15 * 31;
    const int rs = min(max(r - 4, 0), 24), ks0 = min(max(16 * jb - 8, 0), 32);
    const int jq = 16 * jb + fr, cs = min(max(jq - 8, 0), 48);
    const size_t tb0 = (size_t)b * SEQ;
    bf16x8 qb[2];
    { const bf16* qp = U + (tb0 + r * 64 + jq) * UL + C_NQ + h * 64 + 8 * fg; qb[0] = *(const bf16x8*)qp; qb[1] = *(const bf16x8*)(qp + 32); }
    const int kcl = ks0 + 8 * (fr >> 2) + (fr & 3);
    const bf16* kbase = U + (tb0 + rs * 64 + kcl) * UL + C_NK + h * 64 + 8 * fg;
    const bf16* vbase = VT + (size_t)fr * TP + tb0 + rs * 64 + ks0 + 8 * fg;
    float sc[16][4];
#pragma unroll
    for (int hb = 0; hb < 2; ++hb) {
        bf16x8 kf[16];
#pragma unroll
        for (int t = 0; t < 8; ++t) { const int T = 8 * hb + t; const bf16* kp = kbase + (size_t)((T >> 1) * 64 + 4 * (T & 1)) * UL; kf[2 * t] = *(const bf16x8*)kp; kf[2 * t + 1] = *(const bf16x8*)(kp + 32); }
#pragma unroll
        for (int t = 0; t < 8; ++t) { const int T = 8 * hb + t, krow = rs + (T >> 1);
            f32x4 s = (f32x4){0.f, 0.f, 0.f, 0.f}; s = MFMA16(kf[2 * t], qb[0], s); s = MFMA16(kf[2 * t + 1], qb[1], s);
#pragma unroll
            for (int e = 0; e < 4; ++e) { const int kc = ks0 + 8 * fg + 4 * (T & 1) + e; const bool valid = kc >= cs && kc < cs + 16;
                const int dc = min(max(kc - jq + 15, 0), 30);
                sc[T][e] = valid ? s[e] * 0.125f + rpb[(krow - r + 7) * 31 + dc] : -1e30f; } }
        asm volatile("" ::: "memory"); }
    bf16x8 vf[16];
#pragma unroll
    for (int ks = 0; ks < 4; ++ks)
#pragma unroll
        for (int d = 0; d < 4; ++d) vf[4 * ks + d] = *(const bf16x8*)(vbase + (size_t)(16 * d) * TP + ks * 64);
    float mx = -1e30f;
#pragma unroll
    for (int T = 0; T < 16; ++T)
#pragma unroll
        for (int e = 0; e < 4; ++e) mx = fmaxf(mx, sc[T][e]);
    mx = fmaxf(mx, __shfl_xor(mx, 16)); mx = fmaxf(mx, __shfl_xor(mx, 32));
    float sum = 0.f;
#pragma unroll
    for (int T = 0; T < 16; ++T)
#pragma unroll
        for (int e = 0; e < 4; ++e) { sc[T][e] = __expf(sc[T][e] - mx); sum += sc[T][e]; }
    sum += __shfl_xor(sum, 16); sum += __shfl_xor(sum, 32);
    f32x4 oacc[4];
#pragma unroll
    for (int d = 0; d < 4; ++d) oacc[d] = (f32x4){0.f, 0.f, 0.f, 0.f};
#pragma unroll
    for (int hb = 0; hb < 2; ++hb) {
        if (hb == 1) {
#pragma unroll
            for (int ks = 0; ks < 4; ++ks)
#pragma unroll
                for (int d = 0; d < 4; ++d) vf[4 * ks + d] = *(const bf16x8*)(vbase + (size_t)(16 * d) * TP + (4 + ks) * 64); }
#pragma unroll
        for (int k4 = 0; k4 < 4; ++k4) { const int ks = 4 * hb + k4;
            bf16x8 pa; { v4u pw; pw[0] = pk2(sc[2 * ks][0], sc[2 * ks][1]); pw[1] = pk2(sc[2 * ks][2], sc[2 * ks][3]); pw[2] = pk2(sc[2 * ks + 1][0], sc[2 * ks + 1][1]); pw[3] = pk2(sc[2 * ks + 1][2], sc[2 * ks + 1][3]); pa = __builtin_bit_cast(bf16x8, pw); }
#pragma unroll
            for (int d = 0; d < 4; ++d) oacc[d] = MFMA16(pa, vf[4 * k4 + d], oacc[d]); } }
#pragma unroll
    for (int e = 0; e < 4; ++e) { const int q = 4 * fg + e; const float inv = 1.0f / __shfl(sum, q);
        bf16* op = NAO + (tb0 + r * 64 + 16 * jb + q) * 256 + h * 64 + fr;
#pragma unroll
        for (int d = 0; d < 4; ++d) op[16 * d] = (bf16)f2bf(oacc[d][e] * inv); }
}
constexpr int HY_CP = 8224, HY_ZP = 4112, HY_ZB = 8 * HY_CP;
__device__ __forceinline__ void hy_load_row(const bf16* R, int tid, v4u& cur, v4u& prev) {
    cur = *(const v4u*)(R + 8 * tid); prev = *(const v4u*)(R + 8 * tid - 8);
}
__device__ __forceinline__ void hy_write_copies(LAS unsigned char* L, int tid, const v4u cur, v4u prev) {
    if (tid == 0) prev = (v4u){0u, 0u, 0u, 0u};
    unsigned wd[9] = {prev[0], prev[1], prev[2], prev[3], cur[0], cur[1], cur[2], cur[3], 0u};
#pragma unroll
    for (int rho = 0; rho < 8; ++rho) { const int wo = (8 - rho) >> 1; v4u o;
        if ((rho & 1) == 0) { o[0] = wd[wo]; o[1] = wd[wo + 1]; o[2] = wd[wo + 2]; o[3] = wd[wo + 3]; }
        else {
#pragma unroll
            for (int j = 0; j < 4; ++j) o[j] = (wd[wo + j] >> 16) | (wd[wo + j + 1] << 16); }
        *(LAS v4u*)(L + rho * HY_CP + 16 * tid) = o; }
}
__device__ __forceinline__ float hy_gate4(const bf16* grow, int tok, int t, float w0, float w1, float w2, float bias, float* out4) {
    const u2v c4 = *(const u2v*)(grow + tok); const float lf = t > 0 ? bf2f(grow[tok - 1]) : 0.f, rt = t + 4 < SEQ ? bf2f(grow[tok + 4]) : 0.f;
    const float v0 = bflo(c4.x), v1 = bfhi(c4.x), v2 = bflo(c4.y), v3 = bfhi(c4.y);
    out4[0] = w0 * lf + w1 * v0 + w2 * v1 + bias; out4[1] = w0 * v0 + w1 * v1 + w2 * v2 + bias; out4[2] = w0 * v1 + w1 * v2 + w2 * v3 + bias; out4[3] = w0 * v2 + w1 * v3 + w2 * rt + bias;
    return 0.f;
}
__device__ __forceinline__ void hy_item(Ctx& F, int l, int c) {
    LAS unsigned char* L = F.lds;
    const bf16* UHT = (const bf16*)(F.ws + WS_UHT); bf16* HYO = (bf16*)(F.ws + WS_HYO);
    const float* cw = INP(16) + l * 3 * 768; const float* cb = INP(17) + l * 768; const float* skip = INP(24) + l * 512;
    const int tid = fresh_tid(F.wave0), lane = tid & 63, w = F.wave0, fr = lane & 15, fg = lane >> 4;
    const bf16* FR = (const bf16*)(F.ws + WS_FILT) + (size_t)(l * 2 * 256 + c) * 4096;
    { v4u fc, fp; hy_load_row(FR, tid, fc, fp); hy_write_copies(L, tid, fc, fp); }
    { const float w0 = cw[c], w1 = cw[768 + c], w2 = cw[1536 + c], bias = cb[c]; const bf16* row = UHT + (size_t)c * TP;
#pragma unroll
      for (int k = 0; k < 8; ++k) { const int u = tid + 512 * k, b = u >> 8, t0 = (u & 255) * 8, tok = b * SEQ + t0;
          const v4u cv = *(const v4u*)(row + tok); const unsigned short lraw = row[tok - 1], rraw = row[tok + 8]; const float lf = t0 > 0 ? bf2f(lraw) : 0.f, rt = t0 + 8 < SEQ ? bf2f(rraw) : 0.f;
          float x[10]; x[0] = lf; x[9] = rt;
#pragma unroll
          for (int e = 0; e < 4; ++e) { x[1 + 2 * e] = bflo(cv[e]); x[2 + 2 * e] = bfhi(cv[e]); }
          v4u o;
#pragma unroll
          for (int e = 0; e < 4; ++e) o[e] = pk2(w0 * x[2 * e] + w1 * x[2 * e + 1] + w2 * x[2 * e + 2] + bias, w0 * x[2 * e + 1] + w1 * x[2 * e + 2] + w2 * x[2 * e + 3] + bias);
          *(LAS v4u*)(L + HY_ZB + b * HY_ZP + t0 * 2) = o; } }
    __syncthreads();
    const int abase = (fr & 7) * HY_CP + 4096 + 16 * (fg - (fr >> 3)) - 32 * 16 * w;
    const int bbase = HY_ZB + fr * HY_ZP + 16 * fg;
    for (int o = 0; o < 2; ++o) {
        const int gc = 256 * (o + 1) + c; const bf16* grow = UHT + (size_t)gc * TP;
        u2v gcv[16]; v4u fc, fp;
#pragma unroll
        for (int ii = 0; ii < 8; ++ii) { const int t = 16 * (16 * w + ii) + 4 * fg, tok = fr * SEQ + t; gcv[ii] = *(const u2v*)(grow + tok); }
        f32x4 acc[16];
#pragma unroll
        for (int i = 0; i < 16; ++i) acc[i] = (f32x4){0.f, 0.f, 0.f, 0.f};
        bf16x8 af[16];
#pragma unroll
        for (int m = 2; m <= 15; ++m) af[(16 - m) & 15] = lds_b128(L + abase - 32 * m);
        for (int j0 = 0; j0 < 64; j0 += 8) {
#pragma unroll
            for (int jj = 0; jj < 8; ++jj) { const int j = j0 + jj;
                af[(2 * jj) & 15] = lds_b128(L + abase + 64 * j); af[(2 * jj + 15) & 15] = lds_b128(L + abase + 64 * j - 32);
                const bf16x8 bfr = lds_b128(L + bbase + 64 * j);
#pragma unroll
                for (int ii = 0; ii < 16; ++ii) acc[ii] = MFMA16(af[(2 * jj - ii + 16) & 15], bfr, acc[ii]); }
        }
        __syncthreads();
        if (o == 0) hy_load_row(FR + (size_t)256 * 4096, tid, fc, fp);
        const float w0 = cw[gc], w1 = cw[768 + gc], w2 = cw[1536 + gc], bias = cb[gc];
        const float sk = skip[o * 256 + c];
        unsigned gnb[16];
#pragma unroll
        for (int ii = 8; ii < 16; ++ii) { const int t = 16 * (16 * w + ii) + 4 * fg, tok = fr * SEQ + t; gcv[ii] = *(const u2v*)(grow + tok); }
#pragma unroll
        for (int ii = 0; ii < 16; ++ii) { const int t = 16 * (16 * w + ii) + 4 * fg, tok = fr * SEQ + t; gnb[ii] = (unsigned)grow[tok - 1] | ((unsigned)grow[tok + 4] << 16); }
        if (o == 0) hy_write_copies(L, tid, fc, fp);
#pragma unroll
        for (int ii = 0; ii < 16; ++ii) { const int t = 16 * (16 * w + ii) + 4 * fg, tok = fr * SEQ + t;
            const float lf = t > 0 ? bflo(gnb[ii]) : 0.f, rt = t + 4 < SEQ ? bfhi(gnb[ii]) : 0.f, v0 = bflo(gcv[ii].x), v1 = bfhi(gcv[ii].x), v2 = bflo(gcv[ii].y), v3 = bfhi(gcv[ii].y);
            const float xg0 = w0 * lf + w1 * v0 + w2 * v1 + bias, xg1 = w0 * v0 + w1 * v1 + w2 * v2 + bias, xg2 = w0 * v1 + w1 * v2 + w2 * v3 + bias, xg3 = w0 * v2 + w1 * v3 + w2 * rt + bias;
            LAS u2v* zp = (LAS u2v*)(L + HY_ZB + fr * HY_ZP + t * 2); const u2v zo = *zp;
            const float z0 = xg0 * (acc[ii][0] + sk * bflo(zo.x)), z1 = xg1 * (acc[ii][1] + sk * bfhi(zo.x)), z2 = xg2 * (acc[ii][2] + sk * bflo(zo.y)), z3 = xg3 * (acc[ii][3] + sk * bfhi(zo.y));
            u2v zn; zn.x = pk2(z0, z1); zn.y = pk2(z2, z3);
            if (o == 0) *zp = zn; else *(u2v*)(HYO + (size_t)c * TP + tok) = zn; }
        __syncthreads();
    }
}
#ifndef MIXREP
#define MIXREP 0
#endif
__device__ __forceinline__ void ph_mixers(Ctx& F, int l, int rep) {
    for (int q_ = 0; q_ < ((MIXREP & 1) ? 2 : 1); ++q_)
    for (int it = F.bid; it < 256; it += F.G) { if (it < 128) ssd_item(F, l, it); else ml_item(F, l, it - 128); }
    F.tid = fresh_tid(F.wave0); F.lane = F.tid & 63; F.wave = F.wave0;
    for (int i = F.tid; i < 4 * 15 * 31; i += NTHR) ((LAS float*)(F.lds + NA_RPB_OFF))[i] = INP(11)[(size_t)l * 4 * 15 * 31 + i];
    volatile LAS int* slot = (volatile LAS int*)(F.lds + MISC_OFF);
    unsigned* ctr = (unsigned*)(F.ws + WS_CTL) + 64 * (1 + l + 2 * rep);
    for (;;) {
        __syncthreads();
        if (F.tid == 0) slot[0] = (int)atomicAdd(ctr, 1u);
        __syncthreads();
        const int it = slot[0];
        if (it >= 256 + 256) break;
        if (it < 256) { hy_item(F, l, it); if (MIXREP & 2) hy_item(F, l, it); }
        else {
#pragma unroll 1
            for (int q = 0; q < 4; ++q) na_wave_item(F, l, ((it - 256) * 4 + q) * 8 + F.wave); }
    }
}

__device__ __forceinline__ void ph_finalize(Ctx& F, int l) {
    const int lane = F.lane, c0 = lane * 4, tid = F.tid;
    const bf16* U = (const bf16*)(F.ws + WS_U); const bf16* YS = (const bf16*)(F.ws + WS_YS); const bf16* NAO = (const bf16*)(F.ws + WS_NAO);
    const bf16* MLH = (const bf16*)(F.ws + WS_MLH); const bf16* HYO = (const bf16*)(F.ws + WS_HYO); bf16* YM = (bf16*)(F.ws + WS_XN);
    const f32x4 gs = *(const f32x4*)(INP(10) + l * 256 + c0), gn = *(const f32x4*)(INP(12) + l * 256 + c0), gm = *(const f32x4*)(INP(15) + l * 256 + c0), gh = *(const f32x4*)(INP(25) + l * 256 + c0);
    constexpr int HP = 144;
    for (int it = F.bid; it < MTOK / 64; it += F.G) {
        const int tok0 = it * 64;
        __syncthreads();
#pragma unroll
        for (int k = 0; k < 4; ++k) { const int u = tid + 512 * k, c = u >> 3, ch = u & 7; *(LAS v4u*)(F.lds + c * HP + ch * 16) = *(const v4u*)(HYO + (size_t)c * TP + tok0 + ch * 8); }
        __syncthreads();
        typedef unsigned u2 __attribute__((ext_vector_type(2)));
#pragma unroll 1
        for (int q0 = 0; q0 < 8; q0 += 8) {
            u2 ys0[8], ys1[8], zz[8], na[8], m0[8], m1[8], og[8]; float hv[8][4];
#pragma unroll
            for (int j = 0; j < 8; ++j) { const int tl = F.wave * 8 + q0 + j; const size_t tok = (size_t)(tok0 + tl);
                ys0[j] = *(const u2*)(YS + tok * 256 + c0); ys1[j] = *(const u2*)(YS + (MTOK + tok) * 256 + c0); zz[j] = *(const u2*)(U + tok * UL + C_SZ + c0);
                na[j] = *(const u2*)(NAO + tok * 256 + c0); m0[j] = *(const u2*)(MLH + tok * 256 + c0); m1[j] = *(const u2*)(MLH + (MTOK + tok) * 256 + c0); og[j] = *(const u2*)(U + tok * UL + C_MO + c0);
                const LAS bf16* hp = (const LAS bf16*)(F.lds + c0 * HP + tl * 2); hv[j][0] = bf2f(hp[0]); hv[j][1] = bf2f(hp[HP / 2]); hv[j][2] = bf2f(hp[HP]); hv[j][3] = bf2f(hp[3 * HP / 2]); }
#pragma unroll
            for (int j = 0; j < 8; ++j) { const size_t tok = (size_t)(tok0 + F.wave * 8 + q0 + j); bf16* yo = YM + tok * DM + c0;
                { const float v0 = (bflo(ys0[j].x) + bflo(ys1[j].x)) * silu_ff(bflo(zz[j].x)), v1 = (bfhi(ys0[j].x) + bfhi(ys1[j].x)) * silu_ff(bfhi(zz[j].x)), v2 = (bflo(ys0[j].y) + bflo(ys1[j].y)) * silu_ff(bflo(zz[j].y)), v3 = (bfhi(ys0[j].y) + bfhi(ys1[j].y)) * silu_ff(bfhi(zz[j].y));
                  const float rs = 1.0f / sqrtf(wave_sum(v0 * v0 + v1 * v1 + v2 * v2 + v3 * v3) * (1.f / 256.f) + EPS);
                  u2 o; o.x = pk2(v0 * rs * gs.x, v1 * rs * gs.y); o.y = pk2(v2 * rs * gs.z, v3 * rs * gs.w); *(u2*)yo = o; }
                { const float v0 = bflo(na[j].x), v1 = bfhi(na[j].x), v2 = bflo(na[j].y), v3 = bfhi(na[j].y);
                  const float rs = 1.0f / sqrtf(wave_sum(v0 * v0 + v1 * v1 + v2 * v2 + v3 * v3) * (1.f / 256.f) + EPS);
                  u2 o; o.x = pk2(v0 * rs * gn.x, v1 * rs * gn.y); o.y = pk2(v2 * rs * gn.z, v3 * rs * gn.w); *(u2*)(yo + 256) = o; }
                { const float v0 = bflo(m0[j].x) + bflo(m1[j].x), v1 = bfhi(m0[j].x) + bfhi(m1[j].x), v2 = bflo(m0[j].y) + bflo(m1[j].y), v3 = bfhi(m0[j].y) + bfhi(m1[j].y);
                  float ss = v0 * v0 + v1 * v1 + v2 * v2 + v3 * v3;
                  ss += __shfl_xor(ss, 1); ss += __shfl_xor(ss, 2); ss += __shfl_xor(ss, 4); ss += __shfl_xor(ss, 8);
                  const float rs = 1.0f / sqrtf(ss * (1.f / 64.f) + EPS);
                  u2 o; o.x = pk2(v0 * rs * gm.x * sigmoid_f(bflo(og[j].x)), v1 * rs * gm.y * sigmoid_f(bfhi(og[j].x))); o.y = pk2(v2 * rs * gm.z * sigmoid_f(bflo(og[j].y)), v3 * rs * gm.w * sigmoid_f(bfhi(og[j].y)));
                  *(u2*)(yo + 512) = o; }
                { const float v0 = hv[j][0], v1 = hv[j][1], v2 = hv[j][2], v3 = hv[j][3];
                  const float rs = 1.0f / sqrtf(wave_sum(v0 * v0 + v1 * v1 + v2 * v2 + v3 * v3) * (1.f / 256.f) + EPS);
                  u2 o; o.x = pk2(v0 * rs * gh.x, v1 * rs * gh.y); o.y = pk2(v2 * rs * gh.z, v3 * rs * gh.w); *(u2*)(yo + 768) = o; }
            }
        }
    }
}

#define XB_TMO      128
#define XB_XCNT(j)  (256  + 64 * (j))
#define XB_XSUB(j)  (1280 + 64 * (j))
#define XB_XGEN(j)  (2304 + 64 * (j))
#define XB_TOP      3328
#define XB_TOPGEN   3392
#define XCD_BAR_WORDS 3456
#define XB_SPIN_CAP (1u << 18)

__device__ __forceinline__ unsigned xb_ld(unsigned* p)              { return __hip_atomic_load(p, __ATOMIC_RELAXED, __HIP_MEMORY_SCOPE_AGENT); }
__device__ __forceinline__ unsigned xb_add(unsigned* p, unsigned v) { return __hip_atomic_fetch_add(p, v, __ATOMIC_RELAXED, __HIP_MEMORY_SCOPE_AGENT); }
__device__ __forceinline__ unsigned xb_xcc_id() { return (unsigned)__builtin_amdgcn_s_getreg((3 << 11) | 20) & 0xFu; }
#define XB_SPIN(cond, bar) do { unsigned _sp = 0; while (cond) { __builtin_amdgcn_s_sleep(1); \
    if ((++_sp & 255u) == 0u) { if (xb_ld(&(bar)[XB_TMO])) break; if (_sp > XB_SPIN_CAP) { atomicAdd(&(bar)[XB_TMO], 1u); break; } } } } while (0)

struct XcdBarrier {
    unsigned* bar; unsigned x;
    volatile LAS unsigned* st;
};

__device__ __forceinline__ XcdBarrier xcd_barrier_post(unsigned* bar, volatile LAS unsigned* st) {
    XcdBarrier b; b.bar = bar; b.x = xb_xcc_id(); b.st = st;
    if (threadIdx.x == 0) (void)xb_add(&bar[XB_XCNT(b.x)], 1u);
    return b;
}
__device__ __forceinline__ void xcd_barrier_complete(unsigned* bar, unsigned x, unsigned& nloc, unsigned& nx) {
    const unsigned G = gridDim.x * gridDim.y * gridDim.z;
    unsigned sum, cnt, mine, sp = 0u;
    for (;;) {
        sum = 0u; cnt = 0u; mine = 0u;
#pragma unroll
        for (unsigned j = 0; j < 16; ++j) { const unsigned c = xb_ld(&bar[XB_XCNT(j)]); sum += c; cnt += (c > 0u) ? 1u : 0u; mine = (j == x) ? c : mine; }
        if (sum == G) break;
        __builtin_amdgcn_s_sleep(1);
        if ((++sp & 255u) == 0u) { if (xb_ld(&bar[XB_TMO])) break; if (sp > XB_SPIN_CAP) { atomicAdd(&bar[XB_TMO], 1u); break; } }
    }
    nloc = mine > 0u ? mine : 1u; nx = cnt > 0u ? cnt : 1u;
}

__device__ __forceinline__ void xcd_barrier(const XcdBarrier& b, const bool leader) {
    asm volatile("s_waitcnt vmcnt(0)" ::: "memory");
    __syncthreads();
    if (leader) {
        unsigned* bar = b.bar;
        __builtin_amdgcn_s_waitcnt(0);
        unsigned nloc = b.st[0], nx = b.st[1];
        if (nloc == 0u) { xcd_barrier_complete(bar, b.x, nloc, nx); b.st[0] = nloc; b.st[1] = nx; }
        const unsigned old = xb_add(&bar[XB_XSUB(b.x)], 1u);
        const unsigned gen = old / nloc;
        if (old + 1u == (gen + 1u) * nloc) {
            __builtin_amdgcn_fence(__ATOMIC_RELEASE, "agent");
            asm volatile("s_waitcnt vmcnt(0)" ::: "memory");
            const unsigned og = xb_add(&bar[XB_TOP], 1u);
            const unsigned tg = og / nx;
            if (og + 1u == (tg + 1u) * nx) xb_add(&bar[XB_TOPGEN], 1u);
            else XB_SPIN(xb_ld(&bar[XB_TOPGEN]) == tg, bar);
            __builtin_amdgcn_fence(__ATOMIC_ACQUIRE, "agent");
            xb_add(&bar[XB_XGEN(b.x)], 1u);
            asm volatile("s_waitcnt vmcnt(0)" ::: "memory");
        } else {
            XB_SPIN(xb_ld(&bar[XB_XGEN(b.x)]) == gen, bar);
            __builtin_amdgcn_fence(__ATOMIC_ACQUIRE, "agent");
            asm volatile("s_waitcnt vmcnt(0)" ::: "memory");
        }
    }
    __syncthreads();
}

constexpr int N_PHASES = 2 + 9 * DEPTH;
#ifndef MK_MULTI
#define MK_MULTI 1
#endif
__global__ void __launch_bounds__(NTHR, 2) hybrid_fwd(Args args) {
    extern __shared__ __attribute__((aligned(16))) unsigned char lds_raw[];
    Ctx F;
    F.lds = (LAS unsigned char*)lds_raw; F.tid = threadIdx.x; F.lane = F.tid & 63; F.wave = __builtin_amdgcn_readfirstlane(F.tid >> 6); F.wave0 = F.wave;
    F.bid = blockIdx.x; F.G = gridDim.x; F.out = args.out; F.ws = args.ws; F.A = &args;
#if MK_MULTI
    const int lo = args.ph_lo, hi = args.ph_hi;
#else
    constexpr int lo = 0, hi = N_PHASES;
#endif
#if MK_MULTI
#define SEAM(k) do { } while (0)
#else
    for (int u = F.tid; u < 32; u += NTHR) ((LAS unsigned*)(F.lds + MISC_OFF))[u] = 0u;
    __syncthreads();
    XcdBarrier bar = xcd_barrier_post((unsigned*)(F.ws + WS_CTL) + 4096, (volatile LAS unsigned*)(F.lds + MISC_OFF) + 8);
#define SEAM(k) do { if ((k) + 1 < hi) { XcdBarrier b2_ = bar; asm volatile("" : "+s"(b2_.x)); xcd_barrier(b2_, fresh_tid(F.wave0) == 0); } } while (0)
#endif
#ifndef PHMASK
#define PHMASK 0xFFFFF
#endif
#define FRESH() do { F.tid = fresh_tid(F.wave0); F.lane = F.tid & 63; F.wave = F.wave0; } while (0)
#define IN(k) (((PHMASK >> (k)) & 1) && lo <= (k) && (k) < hi)
#define INL(j) (((PHMASK >> (2 + (j))) & 1) && lo <= (pb + (j)) && (pb + (j)) < hi)
#ifndef REPMASK
#define REPMASK 0
#endif
#define REPS(k) for (int rep_ = 0; rep_ < ((((REPMASK) >> (k)) & 1) ? 2 : 1); ++rep_)
    const float* MOD = (const float*)(F.ws + WS_MOD); float* SS = (float*)(F.ws + WS_SS); const float* CV = (const float*)(F.ws + WS_CV);
    if (IN(0)) { REPS(0) { FRESH(); ph_prologue(F); __syncthreads(); } SEAM(0); }
    if (IN(1)) { REPS(1) { FRESH(); ph_filters(F); FRESH(); ph_cvec(F); FRESH(); ph_xn0(F, MOD); __syncthreads(); } SEAM(1); }
#pragma unroll 1
    for (int l = 0; l < DEPTH; ++l) {
        const int pb = 2 + 9 * l; unsigned char* wb = F.ws + WS_W + (size_t)l * W_LAYER; const float* mod_l = MOD + (size_t)l * NB * 6144; const float* cv_l = CV + (size_t)l * NB * CVP;
        float* ss_in = SS + (size_t)(2 * l) * MTOK; float* ss_ff = SS + (size_t)(2 * l + 1) * MTOK; float* ss_nx = SS + (size_t)(2 * l + 2) * MTOK;
        if (INL(0)) { REPS(2) { FRESH();
            pg8::Gemm g{(const pg8::bf16_t*)(F.ws + WS_XN), (const pg8::bf16_t*)(wb + W_IN_OFF), MTOK, UL, DM};
            pg8::DualOrder S; S.init(MTOK, UL, NTR, MTOK, F.G, F.bid, (const pg8::bf16_t*)(wb + W_HY_OFF), (const pg8::bf16_t*)(F.ws + WS_XN));
            pg8::EpiDualIn E{{(pg8::bf16_t*)(F.ws + WS_U), UL, ss_in, cv_l}, {(pg8::bf16_t*)(F.ws + WS_UHT), TP, ss_in, cv_l + 2816}};
            pg8::gemm_phase<pg8::EpiDualIn, pg8::DualOrder, true, true>(F.lds, g, S, E, F.wave0);
            __syncthreads(); }
            SEAM(pb + 0);
        }
        if (INL(1)) { REPS(3) { FRESH(); ph_prepass(F, l); } SEAM(pb + 1); }
        if (INL(2)) { REPS(4) { FRESH(); ph_mixers(F, l, rep_); } SEAM(pb + 2); }
        if (INL(3)) { REPS(5) { FRESH(); ph_finalize(F, l); } SEAM(pb + 3); }
        if (INL(4)) { FRESH();
            pg8::Gemm g{(const pg8::bf16_t*)(F.ws + WS_XN), (const pg8::bf16_t*)(wb + W_OUT_OFF), MTOK, DM, DM}; pg8::StaticOrder S; S.init(MTOK, DM, F.G, F.bid);
            pg8::EpiResidN E{l == 0 ? INP(0) : (const float*)F.out, F.out, mod_l + 2048, mod_l + 4096, (pg8::bf16_t*)(F.ws + WS_XN2), ss_ff};
            pg8::gemm_phase<pg8::EpiResidN, pg8::StaticOrder, true, true>(F.lds, g, S, E, F.wave0);
            SEAM(pb + 4);
        }
        if (INL(6)) { REPS(8) { FRESH();
            pg8::Gemm g{(const pg8::bf16_t*)(F.ws + WS_XN2), (const pg8::bf16_t*)(wb + W_GU_OFF), MTOK, 2 * FFH, DM}; pg8::StaticOrder S; S.init(MTOK, 2 * FFH, F.G, F.bid);
            pg8::EpiSwigluN E{(pg8::bf16_t*)(F.ws + WS_U), FFH, ss_ff, cv_l + 3840}; pg8::gemm_phase<pg8::EpiSwigluN, pg8::StaticOrder, true, true>(F.lds, g, S, E, F.wave0); __syncthreads(); }
            SEAM(pb + 6);
        }
        if (INL(7)) { FRESH();
            pg8::Gemm g{(const pg8::bf16_t*)(F.ws + WS_U), (const pg8::bf16_t*)(wb + W_DN_OFF), MTOK, DM, FFH}; pg8::StaticOrder S; S.init(MTOK, DM, F.G, F.bid);
            pg8::EpiResidN E{(const float*)F.out, F.out, mod_l + 5120, mod_l + (size_t)NB * 6144 + 1024, l + 1 < DEPTH ? (pg8::bf16_t*)(F.ws + WS_XN) : nullptr, ss_nx};
            pg8::gemm_phase<pg8::EpiResidN, pg8::StaticOrder, true, true>(F.lds, g, S, E, F.wave0);
            SEAM(pb + 7);
        }
        if (INL(8)) { if (l + 1 == DEPTH) { FRESH(); ph_final(F); } }
    }
#undef IN
#undef INL
#undef SEAM
}

extern "C" void kernel_launch(void* const* d_in, const int* in_sizes, int n_in, void* d_out, int out_size, void* d_ws, size_t ws_size, hipStream_t stream) {
    static int grid = 0;
    if (grid == 0) {
        if (n_in != 31 || out_size != MTOK * DM || ws_size < WS_END) { fprintf(stderr, "kernel_launch: unexpected problem shape (n_in %d out %d ws %zu)\n", n_in, out_size, ws_size); grid = -1; return; }
        int dev = 0, cus = 0, per_cu = 0;
        hipGetDevice(&dev); hipDeviceGetAttribute(&cus, hipDeviceAttributeMultiprocessorCount, dev);
        if (hipFuncSetAttribute((const void*)hybrid_fwd, hipFuncAttributeMaxDynamicSharedMemorySize, LDS_BYTES) != hipSuccess) { fprintf(stderr, "kernel_launch: hipFuncSetAttribute failed\n"); grid = -1; return; }
        if (hipOccupancyMaxActiveBlocksPerMultiprocessor(&per_cu, (const void*)hybrid_fwd, NTHR, LDS_BYTES) != hipSuccess || per_cu < 1) { fprintf(stderr, "kernel_launch: occupancy query says %d blocks per CU\n", per_cu); grid = -1; (void)hipGetLastError(); return; }
        grid = cus;
    }
    if (grid < 0) return;
    hipMemsetAsync((char*)d_ws + WS_CTL, 0, CTL_ZERO_BYTES, stream);
    Args a{};
    for (int i = 0; i < 31; ++i) a.in[i] = (const float*)d_in[i];
    a.out = (float*)d_out; a.ws = (unsigned char*)d_ws;
#if MK_MULTI
    for (int p = 0; p < N_PHASES; ++p) { a.ph_lo = p; a.ph_hi = p + 1; hipLaunchKernelGGL(hybrid_fwd, dim3(grid), dim3(NTHR), LDS_BYTES, stream, a); }
#else
    a.ph_lo = 0; a.ph_hi = N_PHASES;
    hipLaunchKernelGGL(hybrid_fwd, dim3(grid), dim3(NTHR), LDS_BYTES, stream, a);
#endif
}
```

```cpp
#include <hip/hip_runtime.h>
#include <hip/hip_cooperative_groups.h>
#include <cstdio>
#include <cstdint>
namespace cg = cooperative_groups;
#define MK_MULTI 0
namespace pg8 {
#define PG8_LAS __attribute__((address_space(3)))
typedef unsigned short bf16_t;
typedef short bf16x8 __attribute__((ext_vector_type(8)));
typedef float f32x4 __attribute__((ext_vector_type(4)));
typedef unsigned u32x4 __attribute__((ext_vector_type(4)));
constexpr int BM = 256, BK = 64, HALF = 128, HTB = HALF * BK * 2  , STAGE_BYTES = 8 * HTB, NXCD = 8, WGM = 8;

__host__ __device__ __forceinline__ int lds_byte(int r, int c) { const int st = (r >> 4) * 2 + (c >> 5), rr = r & 15, cc = c & 31, ob = rr * 64 + cc * 2; return st * 1024 + (ob ^ (((ob >> 9) & 1) << 5)); }
__host__ __device__ __forceinline__ void stage_rc(int b, int& R, int& C) { const int st = b / 1024, sb = b % 1024, swz = sb ^ (((sb >> 9) & 1) << 5); R = (st >> 1) * 16 + swz / 64; C = (st & 1) * 32 + (swz % 64) / 2; }
__host__ __device__ __forceinline__ int perm32(int rho) { const int n = rho >> 4, i = rho & 15; return 8 * (i >> 2) + 4 * n + (i & 3); }

struct Unit { int pm, pn, kind; };
struct Gemm { const bf16_t* A; const bf16_t* Bt; int M, N, K; };

struct StaticOrder {
    int nM, nN, nwg, G, c;
    __host__ __device__ void init(int M, int N, int G_, int c_) { nM = M / BM; nN = N / BM; nwg = nM * nN; G = G_; c = c_; }
    __host__ __device__ bool next(int i, Unit& u) const {
        const long L = (long)i * G + c; if (L >= nwg) return false;
        int wgid = (int)L; { const int q = nwg / NXCD, r = nwg % NXCD, xcd = wgid % NXCD, off = wgid / NXCD; wgid = (xcd < r ? xcd * (q + 1) : r * (q + 1) + (xcd - r) * q) + off; }
        const int nig = WGM * nN, gid = wgid / nig, fm = gid * WGM, gsz = (nM - fm) < WGM ? (nM - fm) : WGM;
        u.pm = fm + ((wgid % nig) % gsz); u.pn = (wgid % nig) / gsz; u.kind = 0; return true;
    }
    template <class G_> __device__ __forceinline__ const char* pa(const G_& g, const Unit& u, size_t tstep) const { return (const char*)g.A + (size_t)u.pm * tstep; }
    template <class G_> __device__ __forceinline__ const char* pb(const G_& g, const Unit& u, size_t tstep) const { return (const char*)g.Bt + (size_t)u.pn * tstep; }
    __device__ __forceinline__ void a_ready(const Unit&) const {}
    __device__ __forceinline__ void done(const Unit&) const {}
};

__device__ __forceinline__ unsigned cvt_pk_bf16(float lo, float hi) { unsigned r; asm volatile("v_cvt_pk_bf16_f32 %0, %1, %2" : "=v"(r) : "v"(lo), "v"(hi)); return r; }
constexpr float PG8_EPS = 1e-6f;
constexpr int CVP = 9472;
struct EpiStoreBf16N {
    static constexpr bool PERM = true, AFTER_DRAIN = false;
    bf16_t* O; int ldc; const float* ss; const float* cv;
    __device__ __forceinline__ void operator()(const f32x4 (&acc)[2][2][4][2], const Unit& u, int wr, int wc, int fr, int fq) const {
        const int row0 = u.pm * BM + wr * 64 + fr; const int col0 = u.pn * BM + wc * 32 + 8 * fq;
        const float* cvp = cv + (size_t)((u.pm * BM) >> 11) * CVP + col0;
        f32x4 cvv[2][2];
#pragma unroll
        for (int bj = 0; bj < 2; ++bj)
#pragma unroll
            for (int n = 0; n < 2; ++n) cvv[bj][n] = *(const f32x4*)(cvp + bj * HALF + 4 * n);
#pragma unroll
        for (int ai = 0; ai < 2; ++ai)
#pragma unroll
            for (int m = 0; m < 4; ++m) { const int r = row0 + ai * HALF + m * 16; bf16_t* rowp = O + (size_t)r * ldc + col0;
                const float rs = 1.0f / sqrtf(ss[r] * (1.0f / 1024.0f) + PG8_EPS);
#pragma unroll
                for (int bj = 0; bj < 2; ++bj) { const f32x4 v0 = acc[ai][bj][m][0] * rs + cvv[bj][0], v1 = acc[ai][bj][m][1] * rs + cvv[bj][1];
                    u32x4 w; w.x = cvt_pk_bf16(v0[0], v0[1]); w.y = cvt_pk_bf16(v0[2], v0[3]); w.z = cvt_pk_bf16(v1[0], v1[1]); w.w = cvt_pk_bf16(v1[2], v1[3]);
                    *(u32x4*)(rowp + bj * HALF) = w; } }
    }
};
struct EpiStoreBf16T {
    static constexpr bool PERM = true, AFTER_DRAIN = false;
    bf16_t* O; int ldc; const float* ss; const float* cv;
    __device__ __forceinline__ void operator()(const f32x4 (&acc)[2][2][4][2], const Unit& u, int wr, int wc, int fr, int fq) const {
        const int row0 = u.pm * BM + wr * 64 + fr; const int col0 = u.pn * BM + wc * 32 + 8 * fq;
        const float* cvp = cv + (size_t)((u.pn * BM) >> 11) * CVP;
        f32x4 rsv[2][2];
#pragma unroll
        for (int bj = 0; bj < 2; ++bj)
#pragma unroll
            for (int n = 0; n < 2; ++n) { const f32x4 s4 = *(const f32x4*)(ss + col0 + bj * HALF + 4 * n);
#pragma unroll
                for (int j = 0; j < 4; ++j) rsv[bj][n][j] = 1.0f / sqrtf(s4[j] * (1.0f / 1024.0f) + PG8_EPS); }
#pragma unroll
        for (int ai = 0; ai < 2; ++ai)
#pragma unroll
            for (int m = 0; m < 4; ++m) { const int r = row0 + ai * HALF + m * 16; bf16_t* rowp = O + (size_t)r * ldc + col0; const float c = cvp[r];
#pragma unroll
                for (int bj = 0; bj < 2; ++bj) { const f32x4 v0 = acc[ai][bj][m][0] * rsv[bj][0] + c, v1 = acc[ai][bj][m][1] * rsv[bj][1] + c;
                    u32x4 w; w.x = cvt_pk_bf16(v0[0], v0[1]); w.y = cvt_pk_bf16(v0[2], v0[3]); w.z = cvt_pk_bf16(v1[0], v1[1]); w.w = cvt_pk_bf16(v1[2], v1[3]);
                    *(u32x4*)(rowp + bj * HALF) = w; } }
    }
};
struct EpiResidN {
    static constexpr bool PERM = false, AFTER_DRAIN = false;
    const float* base; float* out; const float* gate; const float* scn; bf16_t* an; float* ss;
    __device__ __forceinline__ void operator()(const f32x4 (&acc)[2][2][4][2], const Unit& u, int wr, int wc, int fr, int fq) const {
        const int col0 = u.pn * BM + wc * 32 + 4 * fq; const size_t bo = (size_t)((u.pm * BM) >> 11) * 6144 + col0;
        f32x4 gv[2][2], sv[2][2];
#pragma unroll
        for (int bj = 0; bj < 2; ++bj)
#pragma unroll
            for (int n = 0; n < 2; ++n) { gv[bj][n] = *(const f32x4*)(gate + bo + bj * HALF + n * 16); sv[bj][n] = an ? *(const f32x4*)(scn + bo + bj * HALF + n * 16) + 1.0f : (f32x4){0.f, 0.f, 0.f, 0.f}; }
#pragma unroll
        for (int ai = 0; ai < 2; ++ai)
#pragma unroll
            for (int m = 0; m < 4; ++m) { const int r = u.pm * BM + ai * HALF + wr * 64 + m * 16 + fr; const size_t off = (size_t)r * 1024 + col0; float q = 0.f;
#pragma unroll
                for (int bj = 0; bj < 2; ++bj)
#pragma unroll
                    for (int n = 0; n < 2; ++n) { const f32x4 bs = *(const f32x4*)(base + off + bj * HALF + n * 16); const f32x4 o = bs + gv[bj][n] * acc[ai][bj][m][n];
                        *(f32x4*)(out + off + bj * HALF + n * 16) = o; q += (o[0] * o[0] + o[1] * o[1]) + (o[2] * o[2] + o[3] * o[3]);
                        if (an) { const f32x4 a = o * sv[bj][n]; typedef unsigned u32x2 __attribute__((ext_vector_type(2))); u32x2 w; w.x = cvt_pk_bf16(a[0], a[1]); w.y = cvt_pk_bf16(a[2], a[3]); *(u32x2*)(an + off + bj * HALF + n * 16) = w; } }
                q += __shfl_xor(q, 16); q += __shfl_xor(q, 32);
                if (fq == 0) atomicAdd(ss + r, q);
                if (m == 3) asm volatile("" ::: "memory"); }
    }
};
__device__ __forceinline__ float silu_f(float v) { return v * __builtin_amdgcn_rcpf(1.0f + __expf(-v)); }
struct EpiSwigluN {
    static constexpr bool PERM = true, AFTER_DRAIN = false;
    bf16_t* O; int ldc; const float* ss; const float* cv;
    __device__ __forceinline__ void operator()(const f32x4 (&acc)[2][2][4][2], const Unit& u, int wr, int wc, int fr, int fq) const {
        const int row0 = u.pm * BM + wr * 64 + fr; const int col0 = u.pn * HALF + wc * 32 + 8 * fq;
        const float* cvp = cv + (size_t)((u.pm * BM) >> 11) * CVP + u.pn * BM + wc * 32 + 8 * fq;
        f32x4 cg[2], cu[2];
#pragma unroll
        for (int n = 0; n < 2; ++n) { cg[n] = *(const f32x4*)(cvp + 4 * n); cu[n] = *(const f32x4*)(cvp + HALF + 4 * n); }
#pragma unroll
        for (int ai = 0; ai < 2; ++ai)
#pragma unroll
            for (int m = 0; m < 4; ++m) { const int r = row0 + ai * HALF + m * 16; bf16_t* rowp = O + (size_t)r * ldc + col0;
                const float rs = 1.0f / sqrtf(ss[r] * (1.0f / 1024.0f) + PG8_EPS);
                const f32x4 g0 = acc[ai][0][m][0] * rs + cg[0], g1 = acc[ai][0][m][1] * rs + cg[1], u0 = acc[ai][1][m][0] * rs + cu[0], u1 = acc[ai][1][m][1] * rs + cu[1];
                u32x4 w;
                w.x = cvt_pk_bf16(silu_f(g0[0]) * u0[0], silu_f(g0[1]) * u0[1]); w.y = cvt_pk_bf16(silu_f(g0[2]) * u0[2], silu_f(g0[3]) * u0[3]);
                w.z = cvt_pk_bf16(silu_f(g1[0]) * u1[0], silu_f(g1[1]) * u1[1]); w.w = cvt_pk_bf16(silu_f(g1[2]) * u1[2], silu_f(g1[3]) * u1[3]);
                *(u32x4*)rowp = w; }
    }
};


struct DualOrder {
    StaticOrder s1, s2; const bf16_t* A2; const bf16_t* Bt2;
    __host__ __device__ void init(int M1, int N1, int M2, int N2, int G_, int c_, const bf16_t* a2, const bf16_t* b2) { s1.init(M1, N1, G_, c_); s2.init(M2, N2, G_, c_); A2 = a2; Bt2 = b2; }
    __device__ __forceinline__ bool next(int i, Unit& u) const {
        const long L = (long)i * s1.G + s1.c;
        if (L < s1.nwg) return s1.next(i, u);
        const long L2 = L - s1.nwg; if (L2 >= s2.nwg) return false;
        StaticOrder t = s2; t.c = (int)(L2 % s2.G); const bool ok = t.next((int)(L2 / s2.G), u); u.kind = 1; return ok;
    }
    template <class G_> __device__ __forceinline__ const char* pa(const G_& g, const Unit& u, size_t tstep) const { return (const char*)(u.kind ? A2 : g.A) + (size_t)u.pm * tstep; }
    template <class G_> __device__ __forceinline__ const char* pb(const G_& g, const Unit& u, size_t tstep) const { return (const char*)(u.kind ? Bt2 : g.Bt) + (size_t)u.pn * tstep; }
    __device__ __forceinline__ void a_ready(const Unit&) const {}
    __device__ __forceinline__ void done(const Unit&) const {}
};
struct EpiDualIn {
    static constexpr bool PERM = true, AFTER_DRAIN = false;
    EpiStoreBf16N a; EpiStoreBf16T b;
    __device__ __forceinline__ void operator()(const f32x4 (&acc)[2][2][4][2], const Unit& u, int wr, int wc, int fr, int fq) const { if (u.kind) b(acc, u, wr, wc, fr, fq); else a(acc, u, wr, wc, fr, fq); }
};
template <class Epi, class Sched, bool ALIGN_EPI = false, bool SP2 = false>
__device__ __forceinline__ void gemm_phase(PG8_LAS unsigned char* lds, const Gemm g, const Sched& S, const Epi& E, const int wave0) {
    unsigned z_ = 0u; asm volatile("" : "+v"(z_)); const int lane_ = (int)__builtin_amdgcn_mbcnt_hi(~0u, __builtin_amdgcn_mbcnt_lo(~0u, z_));
    const int tid = (wave0 << 6) | lane_, wid = wave0, lane = lane_, wr = wid >> 2, wc = wid & 3, fr = lane & 15, fq = lane >> 4;
    const int K = g.K, nt = K / BK;
    unsigned voffA[2], voffB[2];
#pragma unroll
    for (int i = 0; i < 2; ++i) { int R, C; stage_rc(tid * 16 + i * 8192, R, C); const int Rb = Epi::PERM ? ((R & ~31) + perm32(R & 31)) : R;
        voffA[i] = (unsigned)(R * K + C) * 2u; voffB[i] = (unsigned)(Rb * K + C) * 2u; }
    const size_t kstep = (size_t)(BK * 2);
    const size_t hstep = (size_t)HALF * K * 2;
    const size_t tstep = 2 * hstep;
    const unsigned ldsw = (unsigned)wid * 1024u;
    const int aoff = lds_byte(wr * 64 + fr, fq * 8), boff = lds_byte(wc * 32 + fr, fq * 8);
#define PG8_SA(b, h) (((b) * 2 + (h)) * HTB)
#define PG8_SB(b, h) ((4 + (b) * 2 + (h)) * HTB)
#define PG8_STAGE(bufoff, gbase, voff) do { _Pragma("unroll") for (int _i = 0; _i < 2; ++_i) \
        __builtin_amdgcn_global_load_lds((const unsigned*)((const char*)(gbase) + (voff)[_i]), (PG8_LAS unsigned*)(lds + (bufoff) + ldsw + _i * 8192), 16, 0, 0); } while (0)
#define PG8_LDA(dst, b, h) do { _Pragma("unroll") for (int m = 0; m < 4; ++m) _Pragma("unroll") for (int k = 0; k < 2; ++k) dst[m][k] = *(const PG8_LAS bf16x8*)(lds + PG8_SA(b, h) + aoff + m * 2048 + k * 1024); } while (0)
#define PG8_LDB(dst, b, h) do { _Pragma("unroll") for (int n = 0; n < 2; ++n) _Pragma("unroll") for (int k = 0; k < 2; ++k) dst[n][k] = *(const PG8_LAS bf16x8*)(lds + PG8_SB(b, h) + boff + n * 2048 + k * 1024); } while (0)
#define PG8_MMA(ai, bj, At, Bt) do { __builtin_amdgcn_s_setprio(1); _Pragma("unroll") for (int m = 0; m < 4; ++m) _Pragma("unroll") for (int n = 0; n < 2; ++n) _Pragma("unroll") for (int k = 0; k < 2; ++k) \
        acc[ai][bj][m][n] = __builtin_amdgcn_mfma_f32_16x16x32_bf16(Bt[n][k], At[m][k], acc[ai][bj][m][n], 0, 0, 0); __builtin_amdgcn_s_setprio(0); } while (0)
#define PG8_WAIT_V(n) asm volatile("s_waitcnt vmcnt(" #n ")" ::: "memory")
#define PG8_WAIT_L(n) asm volatile("s_waitcnt lgkmcnt(" #n ")" ::: "memory")
#define PG8_BAR __builtin_amdgcn_s_barrier()
#define PG8_SCHED __builtin_amdgcn_sched_barrier(0)
    Unit cur, nxt; int ui = 0;
    if (!S.next(0, cur)) return;
    f32x4 acc[2][2][4][2];
#pragma unroll
    for (int a = 0; a < 2; ++a)
#pragma unroll
        for (int b = 0; b < 2; ++b)
#pragma unroll
            for (int m = 0; m < 4; ++m)
#pragma unroll
                for (int n = 0; n < 2; ++n) acc[a][b][m][n] = (f32x4){0.f, 0.f, 0.f, 0.f};
    bf16x8 At[4][2], B0[2][2], B1[2][2];
    const char* cA = S.pa(g, cur, tstep); const char* cB = S.pb(g, cur, tstep);
    S.a_ready(cur);
    if constexpr (SP2) {
        PG8_STAGE(PG8_SB(0, 0), cB, voffB); PG8_STAGE(PG8_SB(0, 1), cB + hstep, voffB); PG8_STAGE(PG8_SA(0, 0), cA, voffA); PG8_STAGE(PG8_SA(0, 1), cA + hstep, voffA);
        if (wr == 1) PG8_BAR;
        PG8_WAIT_V(2); PG8_BAR;
        PG8_STAGE(PG8_SB(1, 0), cB + kstep, voffB); PG8_STAGE(PG8_SA(1, 0), cA + kstep, voffA); PG8_STAGE(PG8_SB(1, 1), cB + hstep + kstep, voffB);
        PG8_WAIT_V(6); PG8_BAR;
    } else {
        PG8_STAGE(PG8_SB(0, 0), cB, voffB); PG8_STAGE(PG8_SA(0, 0), cA, voffA); PG8_STAGE(PG8_SB(0, 1), cB + hstep, voffB); PG8_STAGE(PG8_SA(0, 1), cA + hstep, voffA);
        if (wr == 1) PG8_BAR;
        PG8_WAIT_V(4); PG8_BAR;
        PG8_STAGE(PG8_SB(1, 0), cB + kstep, voffB); PG8_STAGE(PG8_SA(1, 0), cA + kstep, voffA); PG8_STAGE(PG8_SB(1, 1), cB + hstep + kstep, voffB);
        PG8_WAIT_V(6); PG8_BAR;
    }
    for (;;) {
        const bool has_next = S.next(ui + 1, nxt);
        const char* nA = has_next ? S.pa(g, nxt, tstep) : cA; const char* nB = has_next ? S.pb(g, nxt, tstep) : cB;
        for (int t = 0; t < nt; t += 2) {
            const bool last = (t == nt - 2);
            const char* a1 = cA + (size_t)(t + 1) * kstep;
            const char* a2 = last ? nA : cA + (size_t)(t + 2) * kstep; const char* b2 = last ? nB : cB + (size_t)(t + 2) * kstep;
            const char* a3 = a2 + kstep; const char* b3 = b2 + kstep;
            if (last && has_next) S.a_ready(nxt);
            if constexpr (SP2) {
            PG8_LDB(B0, 0, 0); PG8_LDB(B1, 0, 1); PG8_SCHED; PG8_LDA(At, 0, 0); PG8_STAGE(PG8_SA(1, 1), a1 + hstep, voffA);
            PG8_WAIT_V(8); PG8_WAIT_L(0); PG8_BAR; PG8_MMA(0, 0, At, B0); PG8_MMA(0, 1, At, B1); PG8_BAR; PG8_SCHED;
            PG8_LDA(At, 0, 1); PG8_STAGE(PG8_SB(0, 0), b2, voffB); PG8_STAGE(PG8_SB(0, 1), b2 + hstep, voffB); PG8_STAGE(PG8_SA(0, 0), a2, voffA);
            PG8_WAIT_V(8); PG8_WAIT_L(0); PG8_BAR; PG8_MMA(1, 0, At, B0); PG8_MMA(1, 1, At, B1); PG8_BAR; PG8_SCHED;
            PG8_LDB(B0, 1, 0); PG8_LDB(B1, 1, 1); PG8_SCHED; PG8_LDA(At, 1, 0); PG8_STAGE(PG8_SA(0, 1), a2 + hstep, voffA);
            PG8_WAIT_V(8); PG8_WAIT_L(0); PG8_BAR; PG8_MMA(0, 0, At, B0); PG8_MMA(0, 1, At, B1); PG8_BAR; PG8_SCHED;
            PG8_LDA(At, 1, 1); PG8_STAGE(PG8_SB(1, 0), b3, voffB); PG8_STAGE(PG8_SB(1, 1), b3 + hstep, voffB); PG8_STAGE(PG8_SA(1, 0), a3, voffA);
            PG8_WAIT_V(8); PG8_WAIT_L(0); PG8_BAR; PG8_MMA(1, 0, At, B0); PG8_MMA(1, 1, At, B1); PG8_BAR; PG8_SCHED;
            } else {
            PG8_LDB(B0, 0, 0); PG8_SCHED; PG8_LDA(At, 0, 0); PG8_STAGE(PG8_SA(1, 1), a1 + hstep, voffA);
            PG8_WAIT_L(8); PG8_BAR; PG8_WAIT_L(0); PG8_MMA(0, 0, At, B0); PG8_BAR; PG8_SCHED;
            PG8_LDB(B1, 0, 1); PG8_STAGE(PG8_SB(0, 0), b2, voffB);
            PG8_BAR; PG8_WAIT_L(0); PG8_MMA(0, 1, At, B1); PG8_BAR;
            PG8_LDA(At, 0, 1); PG8_STAGE(PG8_SA(0, 0), a2, voffA);
            PG8_BAR; PG8_WAIT_L(0); PG8_MMA(1, 0, At, B0); PG8_BAR; PG8_SCHED;
            PG8_STAGE(PG8_SB(0, 1), b2 + hstep, voffB);
            PG8_WAIT_V(6); PG8_BAR; PG8_MMA(1, 1, At, B1); PG8_BAR;
            PG8_LDB(B0, 1, 0); PG8_SCHED; PG8_LDA(At, 1, 0); PG8_STAGE(PG8_SA(0, 1), a2 + hstep, voffA);
            PG8_WAIT_L(8); PG8_BAR; PG8_WAIT_L(0); PG8_MMA(0, 0, At, B0); PG8_BAR; PG8_SCHED;
            PG8_LDB(B1, 1, 1); PG8_STAGE(PG8_SB(1, 0), b3, voffB);
            PG8_BAR; PG8_WAIT_L(0); PG8_MMA(0, 1, At, B1); PG8_BAR;
            PG8_LDA(At, 1, 1); PG8_STAGE(PG8_SA(1, 0), a3, voffA);
            PG8_BAR; PG8_WAIT_L(0); PG8_MMA(1, 0, At, B0); PG8_BAR; PG8_SCHED;
            PG8_STAGE(PG8_SB(1, 1), b3 + hstep, voffB);
            PG8_WAIT_V(6); PG8_BAR; PG8_MMA(1, 1, At, B1); PG8_BAR;
            }
        }
        if constexpr (ALIGN_EPI) { if (wr == 0) PG8_BAR; }
        if constexpr (!Epi::AFTER_DRAIN) { E(acc, cur, wr, wc, fr, fq); S.done(cur); }
        if (!has_next) break;
#pragma unroll
        for (int a = 0; a < 2; ++a)
#pragma unroll
            for (int b = 0; b < 2; ++b)
#pragma unroll
                for (int m = 0; m < 4; ++m)
#pragma unroll
                    for (int n = 0; n < 2; ++n) acc[a][b][m][n] = (f32x4){0.f, 0.f, 0.f, 0.f};
        cur = nxt; cA = nA; cB = nB; ++ui;
        if constexpr (ALIGN_EPI) { if (wr == 1) PG8_BAR; }
    }
    PG8_WAIT_V(0);
    if constexpr (!ALIGN_EPI) { if (wr == 0) PG8_BAR; }
    PG8_BAR;
    if constexpr (Epi::AFTER_DRAIN) { E.fused(acc, cur, wr, wc, fr, fq, lds, wid, lane); S.done(cur); }
#undef PG8_SA
#undef PG8_SB
#undef PG8_STAGE
#undef PG8_LDA
#undef PG8_LDB
#undef PG8_MMA
#undef PG8_WAIT_V
#undef PG8_WAIT_L
#undef PG8_BAR
#undef PG8_SCHED
}
}

constexpr int NB = 16, SEQ = 2048, DM = 1024, MTOK = NB * SEQ, DEPTH = 2;
constexpr int P_IN = 3608, FFH = 2816, UL = 2816, NTR = 1024;
constexpr int C_SZ = 0, C_SX = 256, C_SB = 512, C_SC = 768, C_NQ = 1024, C_NK = 1280, C_MQ = 1536, C_MK = 1792, C_MV = 2048, C_MO = 2304, C_G = 2560;
constexpr int TP = MTOK + 128;
constexpr int R_HY = 0, R_NV = 768;
constexpr float EPS = 1e-6f;
constexpr int NWAVES = 8, NTHR = 512;
constexpr size_t MiB = 1u << 20;
constexpr size_t WS_CTL = 0, WS_SS = 64 * 1024, CTL_ZERO_BYTES = 64 * 1024 + 5 * 131072;
constexpr size_t WS_MOD = 1 * MiB, WS_HID2 = 2 * MiB, WS_DT = 3 * MiB, WS_FILT = 4 * MiB, WS_W = 12 * MiB;
constexpr size_t W_IN_OFF = 0, W_HY_OFF = 5 * MiB + MiB / 2, W_OUT_OFF = 7 * MiB + MiB / 2, W_GU_OFF = 9 * MiB + MiB / 2, W_DN_OFF = 20 * MiB + MiB / 2, W_LAYER = 26 * MiB;
constexpr size_t WS_XN = 64 * MiB, WS_U = 128 * MiB, WS_UHT = 320 * MiB, WS_YS = 386 * MiB, WS_NAO = 418 * MiB, WS_MLH = 434 * MiB, WS_HYO = 466 * MiB, WS_CV = 484 * MiB, WS_END = 486 * MiB;
constexpr size_t WS_XN2 = WS_UHT;
constexpr int CVP = 9472;
constexpr int LDS_BYTES = 147456, MISC_OFF = 147456 - 128;

#define GAS __attribute__((address_space(1)))
#define LAS __attribute__((address_space(3)))
typedef unsigned short bf16;
typedef unsigned v4u __attribute__((ext_vector_type(4)));
typedef float f32x4 __attribute__((ext_vector_type(4)));
typedef __bf16 bf16v2 __attribute__((ext_vector_type(2)));
typedef float f32v2 __attribute__((ext_vector_type(2)));
__device__ __forceinline__ unsigned pk2(float lo, float hi) { const f32v2 v = {lo, hi}; return __builtin_bit_cast(unsigned, __builtin_convertvector(v, bf16v2)); }
__device__ __forceinline__ unsigned f2bf(float f) { return (unsigned)__builtin_bit_cast(unsigned short, (__bf16)f); }
__device__ __forceinline__ float bf2f(unsigned h) { return __builtin_bit_cast(float, h << 16); }
__device__ __forceinline__ float bflo(unsigned w) { return __builtin_bit_cast(float, w << 16); }
__device__ __forceinline__ float bfhi(unsigned w) { return __builtin_bit_cast(float, w & 0xffff0000u); }
__device__ __forceinline__ float wave_sum(float v) {
#pragma unroll
    for (int o = 1; o < 64; o <<= 1) v += __shfl_xor(v, o);
    return v;
}
__device__ __forceinline__ float wave_max(float v) {
#pragma unroll
    for (int o = 1; o < 64; o <<= 1) v = fmaxf(v, __shfl_xor(v, o));
    return v;
}
__device__ __forceinline__ float sigmoid_f(float v) { return 1.0f / (1.0f + __expf(-v)); }
__device__ __forceinline__ float silu_ff(float v) { return v / (1.0f + __expf(-v)); }
__device__ __forceinline__ float softplus_f(float v) { return v > 20.f ? v : log1pf(__expf(v)); }

__device__ __forceinline__ int fresh_tid(int wave0) { unsigned z = 0u; asm volatile("" : "+v"(z)); const int l = (int)__builtin_amdgcn_mbcnt_hi(~0u, __builtin_amdgcn_mbcnt_lo(~0u, z)); return (wave0 << 6) | l; }
typedef short bf16x8 __attribute__((ext_vector_type(8)));
#define MFMA16(a, b, c) __builtin_amdgcn_mfma_f32_16x16x32_bf16((a), (b), (c), 0, 0, 0)
struct Args { const float* in[31]; float* out; unsigned char* ws; int ph_lo, ph_hi; };

struct Ctx {
    LAS unsigned char* lds;
    int tid, lane, wave, bid, G, wave0;
    const Args* A; float* out; unsigned char* ws;
};
#define INP(i) (F.A->in[i])

__device__ __forceinline__ const float* wsrc(const Ctx& F, int which, int l, int j, int* ld) {
    if (which == 0) { *ld = P_IN; const float* w = INP(4) + (size_t)l * DM * P_IN;
        int o; if (j < 1024) o = j; else if (j < 1536) o = 1032 + (j - 1024); else if (j < 2560) o = 1800 + (j - 1536); else if (j < 2568) o = 1024 + (j - 2560); else if (j < 2584) o = 2824 + (j - 2568); else return nullptr;
        return w + o; }
    if (which == 1) { *ld = P_IN; return INP(4) + (size_t)l * DM * P_IN + (j < 768 ? 2840 + j : 1544 + (j - 768)); }
    if (which == 2) { *ld = DM; return INP(26) + (size_t)l * DM * DM + j; }
    if (which == 3) { *ld = FFH; const int t = j >> 8, w = j & 255; return (w < 128 ? INP(27) : INP(28)) + (size_t)l * DM * FFH + t * 128 + (w & 127); }
    *ld = DM; return INP(29) + (size_t)l * FFH * DM + j;
}
__device__ __forceinline__ void transpose_item(const Ctx& F, int which, int l, int K, bf16* WT, LAS float* scr, int item, int nblk) {
    const int lane = F.lane, kb = item / nblk, nb = item % nblk, k0 = 64 * kb, n0 = 32 * nb;
    int ld = 0; const float* cp = wsrc(F, which, l, n0 + (lane & 31), &ld);
    float tv[32];
#pragma unroll
    for (int i = 0; i < 32; ++i) { const int kk = 2 * i + (lane >> 5); tv[i] = cp ? cp[(size_t)(k0 + kk) * ld] : 0.f; }
#pragma unroll
    for (int i = 0; i < 32; ++i) { const int kk = 2 * i + (lane >> 5); scr[kk * 33 + (lane & 31)] = tv[i]; }
    asm volatile("s_waitcnt lgkmcnt(0)" ::: "memory");
    const int c = lane & 7;
#pragma unroll
    for (int j = 0; j < 4; ++j) { const int n = (lane >> 3) + 8 * j; const LAS float* s = scr + (8 * c) * 33 + n;
        v4u o; o.x = pk2(s[0 * 33], s[1 * 33]); o.y = pk2(s[2 * 33], s[3 * 33]); o.z = pk2(s[4 * 33], s[5 * 33]); o.w = pk2(s[6 * 33], s[7 * 33]);
        *(v4u*)(WT + (size_t)(n0 + n) * K + k0 + 8 * c) = o; }
    asm volatile("s_waitcnt lgkmcnt(0)" ::: "memory");
}
__device__ __forceinline__ void ph_prologue(Ctx& F) {
    const int gw = F.bid * NWAVES + F.wave, NGW = F.G * NWAVES, lane = F.lane;
    LAS float* scr = (LAS float*)(F.lds + F.wave * 16384);
    constexpr int I_IN = 16 * 88, I_HY = 16 * 32, I_OUT = 16 * 32, I_GU = 16 * 176, I_DN = 44 * 32, I_L = I_IN + I_HY + I_OUT + I_GU + I_DN;
    for (int it = gw; it < DEPTH * I_L; it += NGW) {
        const int l = it / I_L; int r = it % I_L; unsigned char* wb = F.ws + WS_W + (size_t)l * W_LAYER;
        if (r < I_IN) { transpose_item(F, 0, l, DM, (bf16*)(wb + W_IN_OFF), scr, r, 88); continue; } r -= I_IN;
        if (r < I_HY) { transpose_item(F, 1, l, DM, (bf16*)(wb + W_HY_OFF), scr, r, 32); continue; } r -= I_HY;
        if (r < I_OUT) { transpose_item(F, 2, l, DM, (bf16*)(wb + W_OUT_OFF), scr, r, 32); continue; } r -= I_OUT;
        if (r < I_GU) { transpose_item(F, 3, l, DM, (bf16*)(wb + W_GU_OFF), scr, r, 176); continue; } r -= I_GU;
        transpose_item(F, 4, l, FFH, (bf16*)(wb + W_DN_OFF), scr, r, 32);
    }
    for (int it = gw; it < DEPTH * SEQ; it += NGW) {
        const int l = it / SEQ, pos = it % SEQ;
        const float* w1 = INP(18) + l * 33 * 64; const float* b1 = INP(19) + l * 64; const float* w2 = INP(20) + l * 64 * 64; const float* b2 = INP(21) + l * 64; const float* fq = INP(23) + l * 128;
        const float t = (float)pos / 2047.0f;
        float z = b1[lane] + t * w1[lane];
        const float a = 6.283185307179586f * ((float)pos / 2048.0f);
#pragma unroll
        for (int i = 0; i < 16; ++i) { const float f = 1e-4f + (float)i * ((15.0f - 1e-4f) / 15.0f); const float ang = a * f;
            z += cosf(ang) * w1[(1 + i) * 64 + lane]; z -= sinf(ang) * w1[(17 + i) * 64 + lane]; }
        const float h1 = sinf(fq[lane] * z);
        float z2 = b2[lane];
        for (int i = 0; i < 64; ++i) z2 += __shfl(h1, i) * w2[i * 64 + lane];
        const float h2 = sinf(fq[64 + lane] * z2);
        ((float*)(F.ws + WS_HID2))[(size_t)it * 64 + lane] = h2;
    }
    __syncthreads();
    LAS float* cond = (LAS float*)F.lds; LAS float* part = (LAS float*)(F.lds + 65536);
    if (F.bid < 192) {
        for (int i = F.tid; i < NB * DM; i += NTHR) cond[i] = silu_ff(INP(1)[i]);
        __syncthreads();
        for (int it = F.bid; it < 192; it += F.G) {
            const int l = it / 96, n0 = (it % 96) * 64;
            const float* W = INP(2) + (size_t)l * DM * 6144 + n0 + lane;
            float acc[16];
#pragma unroll
            for (int b = 0; b < 16; ++b) acc[b] = 0.f;
            const int kb = F.wave * 128;
            for (int k8 = 0; k8 < 128; k8 += 16) { float wv[16];
#pragma unroll
                for (int j = 0; j < 16; ++j) wv[j] = W[(size_t)(kb + k8 + j) * 6144];
#pragma unroll
                for (int j = 0; j < 16; ++j)
#pragma unroll
                    for (int b = 0; b < 16; ++b) acc[b] += cond[b * DM + kb + k8 + j] * wv[j]; }
#pragma unroll
            for (int b = 0; b < 16; ++b) part[(F.wave * 16 + b) * 64 + lane] = acc[b];
            __syncthreads();
            for (int o = F.tid; o < 1024; o += NTHR) { const int b = o >> 6, cidx = o & 63; float s = INP(3)[l * 6144 + n0 + cidx];
#pragma unroll
                for (int w = 0; w < 8; ++w) s += part[(w * 16 + b) * 64 + cidx];
                ((float*)(F.ws + WS_MOD))[(size_t)(l * NB + b) * 6144 + n0 + cidx] = s; }
            __syncthreads();
        }
    }
}

__device__ __forceinline__ void ph_xn0(Ctx& F, const float* mod_l) {
    const int gw = F.bid * NWAVES + F.wave, NGW = F.G * NWAVES;
    bf16* XN = (bf16*)(F.ws + WS_XN); float* ss = (float*)(F.ws + WS_SS);
    for (int m0 = gw * 4; m0 < MTOK; m0 += NGW * 4) {
        f32x4 v[4][4], sc[4][4];
#pragma unroll
        for (int u = 0; u < 4; ++u) { const int m = m0 + u; const f32x4* xr = (const f32x4*)(INP(0) + (size_t)m * DM) + F.lane; const float* mb = mod_l + (size_t)(m >> 11) * 6144 + 1024;
#pragma unroll
            for (int j = 0; j < 4; ++j) { v[u][j] = xr[64 * j]; sc[u][j] = *((const f32x4*)mb + F.lane + 64 * j); } }
#pragma unroll
        for (int u = 0; u < 4; ++u) { const int m = m0 + u; float s = 0.f;
#pragma unroll
            for (int j = 0; j < 4; ++j) s += (v[u][j].x * v[u][j].x + v[u][j].y * v[u][j].y) + (v[u][j].z * v[u][j].z + v[u][j].w * v[u][j].w);
            s = wave_sum(s); if (F.lane == 0) ss[m] = s;
            unsigned long long* o8 = (unsigned long long*)(XN + (size_t)m * DM) + F.lane;
#pragma unroll
            for (int j = 0; j < 4; ++j) o8[64 * j] = (unsigned long long)pk2(v[u][j].x * (1.f + sc[u][j].x), v[u][j].y * (1.f + sc[u][j].y)) | ((unsigned long long)pk2(v[u][j].z * (1.f + sc[u][j].z), v[u][j].w * (1.f + sc[u][j].w)) << 32); }
    }
}
__device__ __forceinline__ void ph_final(Ctx& F) {
    const float* g = INP(30); const float* ss = (const float*)(F.ws + WS_SS) + 4 * MTOK;
    const int gt = F.bid * NTHR + F.tid, NT = F.G * NTHR;
    for (int i0 = gt; i0 < MTOK * (DM / 4); i0 += 8 * NT) { f32x4 xv[8]; float sv[8];
#pragma unroll
        for (int u = 0; u < 8; ++u) { const int i = i0 + u * NT; xv[u] = ((const f32x4*)F.out)[i]; sv[u] = ss[i >> 8]; }
#pragma unroll
        for (int u = 0; u < 8; ++u) { const int i = i0 + u * NT; ((f32x4*)F.out)[i] = xv[u] * (1.0f / sqrtf(sv[u] * (1.f / DM) + EPS)) * *((const f32x4*)g + (i & 255)); } }
}
__device__ __forceinline__ void ph_cvec(Ctx& F) {
    const int gw = F.bid * NWAVES + F.wave, NGW = F.G * NWAVES, lane = F.lane, fr = lane & 15, fg = lane >> 4;
    for (int it = gw; it < DEPTH * (CVP / 16); it += NGW) {
        const int l = it / (CVP / 16), n0 = (it % (CVP / 16)) * 16; unsigned char* wb = F.ws + WS_W + (size_t)l * W_LAYER;
        const bf16* wt = n0 < 2816 ? (const bf16*)(wb + W_IN_OFF) + (size_t)n0 * DM : n0 < 3840 ? (const bf16*)(wb + W_HY_OFF) + (size_t)(n0 - 2816) * DM : (const bf16*)(wb + W_GU_OFF) + (size_t)(n0 - 3840) * DM;
        const float* sh = (const float*)(F.ws + WS_MOD) + (size_t)(l * NB + fr) * 6144 + (n0 < 3840 ? 0 : 3072) + 8 * fg;
        const bf16* wp = wt + (size_t)fr * DM + 8 * fg;
        f32x4 acc = (f32x4){0.f, 0.f, 0.f, 0.f};
#pragma unroll 8
        for (int ks = 0; ks < 32; ++ks) { const f32x4 a0 = *(const f32x4*)(sh + 32 * ks), a1 = *(const f32x4*)(sh + 32 * ks + 4);
            v4u aw; aw[0] = pk2(a0[0], a0[1]); aw[1] = pk2(a0[2], a0[3]); aw[2] = pk2(a1[0], a1[1]); aw[3] = pk2(a1[2], a1[3]);
            acc = MFMA16(__builtin_bit_cast(bf16x8, aw), *(const bf16x8*)(wp + 32 * ks), acc); }
        float* cvo = (float*)(F.ws + WS_CV) + (size_t)l * NB * CVP + n0 + fr;
#pragma unroll
        for (int r = 0; r < 4; ++r) cvo[(size_t)(4 * fg + r) * CVP] = acc[r];
    }
}

__device__ __forceinline__ void ph_filters(Ctx& F) {
    const int lane = F.lane, fr = lane & 15, fg = lane >> 4, w = F.wave;
    for (int it = F.bid; it < DEPTH * 2 * 32; it += F.G) {
        const int l = it >> 6, o = (it >> 5) & 1, co = it & 31;
        const int dir = fr >> 3, ch = co * 8 + (fr & 7);
        const float* w3 = INP(22) + (size_t)l * 64 * 1024 + o * 512 + dir * 256 + ch;
        bf16x8 bw[2], bwl[2];
#pragma unroll
        for (int ks = 0; ks < 2; ++ks) { v4u pw, pl;
#pragma unroll
            for (int e = 0; e < 4; ++e) { const float x0 = w3[(size_t)(32 * ks + 8 * fg + 2 * e) * 1024], x1 = w3[(size_t)(32 * ks + 8 * fg + 2 * e + 1) * 1024];
                pw[e] = pk2(x0, x1); pl[e] = pk2(x0 - bflo(pw[e]), x1 - bfhi(pw[e])); }
            bw[ks] = __builtin_bit_cast(bf16x8, pw); bwl[ks] = __builtin_bit_cast(bf16x8, pl); }
        const float delta = 3.0701134573253945f + (float)ch * ((15.350567286626972f - 3.0701134573253945f) / 255.0f);
        const float* hid = (const float*)(F.ws + WS_HID2) + (size_t)l * SEQ * 64 + (size_t)(256 * w + fr) * 64 + 8 * fg;
        float ss = 0.f;
        LAS f32x4* vals = (LAS f32x4*)F.lds + (size_t)w * 16 * 64 + lane;
#pragma unroll 2
        for (int ii = 0; ii < 16; ++ii) { const float* hp = hid + (size_t)(16 * ii) * 64;
            const f32x4 h0 = *(const f32x4*)hp, h1 = *(const f32x4*)(hp + 4), h2 = *(const f32x4*)(hp + 32), h3 = *(const f32x4*)(hp + 36);
            v4u pa, pb, qa, qb;
#pragma unroll
            for (int e = 0; e < 2; ++e) { pa[e] = pk2(h0[2 * e], h0[2 * e + 1]); pa[2 + e] = pk2(h1[2 * e], h1[2 * e + 1]); pb[e] = pk2(h2[2 * e], h2[2 * e + 1]); pb[2 + e] = pk2(h3[2 * e], h3[2 * e + 1]);
                qa[e] = pk2(h0[2 * e] - bflo(pa[e]), h0[2 * e + 1] - bfhi(pa[e])); qa[2 + e] = pk2(h1[2 * e] - bflo(pa[2 + e]), h1[2 * e + 1] - bfhi(pa[2 + e]));
                qb[e] = pk2(h2[2 * e] - bflo(pb[e]), h2[2 * e + 1] - bfhi(pb[e])); qb[2 + e] = pk2(h3[2 * e] - bflo(pb[2 + e]), h3[2 * e + 1] - bfhi(pb[2 + e])); }
            f32x4 a = (f32x4){0.f, 0.f, 0.f, 0.f};
            a = MFMA16(__builtin_bit_cast(bf16x8, qa), bw[0], a); a = MFMA16(__builtin_bit_cast(bf16x8, qb), bw[1], a);
            a = MFMA16(__builtin_bit_cast(bf16x8, pa), bwl[0], a); a = MFMA16(__builtin_bit_cast(bf16x8, pb), bwl[1], a);
            a = MFMA16(__builtin_bit_cast(bf16x8, pa), bw[0], a); a = MFMA16(__builtin_bit_cast(bf16x8, pb), bw[1], a);
#pragma unroll
            for (int r = 0; r < 4; ++r) { const int p = 256 * w + 16 * ii + 4 * fg + r; a[r] *= __expf(-((float)p / 2047.0f) * delta); ss += a[r] * a[r]; }
            vals[ii * 64] = a; }
        ss += __shfl_xor(ss, 8); ss += __shfl_xor(ss, 16); ss += __shfl_xor(ss, 32);
        LAS float* red = (LAS float*)(F.lds + 131072);
        __syncthreads();
        if (lane < 8) red[w * 8 + lane] = ss;
        __syncthreads();
        float tot = 0.f;
#pragma unroll
        for (int q = 0; q < 8; ++q) tot += red[q * 8 + (fr & 7)];
        const float scale = 1.0f / sqrtf(tot + EPS);
        bf16* fo = (bf16*)(F.ws + WS_FILT) + ((size_t)((l * 2 + o) * 256 + ch)) * 4096 + 2048;
#pragma unroll 2
        for (int ii = 0; ii < 16; ++ii) { const f32x4 a = vals[ii * 64];
#pragma unroll
            for (int r = 0; r < 4; ++r) { const int p = 256 * w + 16 * ii + 4 * fg + r; const unsigned short v = (unsigned short)f2bf(a[r] * scale);
                const bool unused = dir == 1 && p == 0;
                fo[unused ? -2048 : (dir == 0 ? -p : p)] = unused ? (unsigned short)0 : v; } }
    }
}

__device__ __forceinline__ void ph_prepass(Ctx& F, int l) {
    const bf16* U = (const bf16*)(F.ws + WS_U); bf16* XBC = (bf16*)(F.ws + WS_XN); float* DT = (float*)(F.ws + WS_DT);
    const float* cw = INP(5) + l * 3 * 768; const float* cb = INP(6) + l * 768; const float* dtb = INP(7) + l * 8;
    const int gt = F.bid * NTHR + F.tid, NT = F.G * NTHR;
    for (int it0 = gt; it0 < MTOK * 96; it0 += 4 * NT) {
        v4u um[4], u0[4], upn[4];
#pragma unroll
        for (int u = 0; u < 4; ++u) { const int it = it0 + u * NT, tok = it / 96, cg = it % 96; const bf16* up = U + (size_t)tok * UL + C_SX + cg * 8;
            um[u] = *(const v4u*)(up - UL); u0[u] = *(const v4u*)up; upn[u] = *(const v4u*)(up + UL); }
#pragma unroll
        for (int u = 0; u < 4; ++u) { const int it = it0 + u * NT, tok = it / 96, cg = it % 96, t = tok & (SEQ - 1), c0 = cg * 8;
            const v4u z4 = {0u, 0u, 0u, 0u}; const v4u a = t > 0 ? um[u] : z4, b = u0[u], cc = t < SEQ - 1 ? upn[u] : z4;
            float r[8];
#pragma unroll
            for (int q = 0; q < 4; ++q) {
                const int c = c0 + 2 * q;
                const float a0 = cw[c] * bflo(a[q]) + cw[768 + c] * bflo(b[q]) + cw[1536 + c] * bflo(cc[q]) + cb[c];
                const float a1 = cw[c + 1] * bfhi(a[q]) + cw[768 + c + 1] * bfhi(b[q]) + cw[1536 + c + 1] * bfhi(cc[q]) + cb[c + 1];
                r[2 * q] = silu_ff(a0); r[2 * q + 1] = silu_ff(a1); }
            v4u o; o.x = pk2(r[0], r[1]); o.y = pk2(r[2], r[3]); o.z = pk2(r[4], r[5]); o.w = pk2(r[6], r[7]);
            *(v4u*)(XBC + (size_t)tok * 768 + c0) = o; }
    }
    for (int it = gt; it < MTOK * 8; it += NT) { const int tok = it >> 3, j = it & 7;
        DT[it] = softplus_f(bf2f(U[(size_t)tok * UL + C_G + j]) + dtb[j]); }
}

typedef short s16x4 __attribute__((ext_vector_type(4)));
typedef unsigned u2v __attribute__((ext_vector_type(2)));
__device__ __forceinline__ bf16x8 lds_b128(LAS unsigned char* p) { return *(LAS bf16x8*)p; }
__device__ __forceinline__ bf16x8 lds_tr8(LAS unsigned char* base, int pitch, int lane) {
    const int fg = lane >> 4, q = (lane & 15) >> 2, p = lane & 3;
    LAS unsigned char* a = base + (8 * fg + q) * pitch + 8 * p;
    const s16x4 lo = __builtin_amdgcn_ds_read_tr16_b64_v4i16((LAS s16x4*)a);
    const s16x4 hi = __builtin_amdgcn_ds_read_tr16_b64_v4i16((LAS s16x4*)(a + 4 * pitch));
    bf16x8 r; r[0] = lo[0]; r[1] = lo[1]; r[2] = lo[2]; r[3] = lo[3]; r[4] = hi[0]; r[5] = hi[1]; r[6] = hi[2]; r[7] = hi[3]; return r;
}
__device__ __forceinline__ float wave_incl_sum(float a, int lane) {
#pragma unroll
    for (int o = 1; o < 64; o <<= 1) { const float t = __shfl_up(a, o); if (lane >= o) a += t; }
    return a;
}
__device__ __forceinline__ float wave_incl_max(float a, int lane) {
#pragma unroll
    for (int o = 1; o < 64; o <<= 1) { const float t = __shfl_up(a, o); if (lane >= o) a = fmaxf(a, t); }
    return a;
}
constexpr int SP_C = 272, SP_X = 144;
constexpr int SB_CS = 0, SB_BS = 17408, SB_XD = 34816, SB_XW = 44032, SB_SIZE = 53248, S_SC = 106496, S_SBF = 115712;
__device__ __forceinline__ void ssd_item(Ctx& F, int l, int it) {
    const int b = it >> 3, dir = (it >> 2) & 1, h = it & 3, grp = h >> 1;
    const int tid = F.tid, lane = F.lane, w = F.wave, fr = lane & 15, fg = lane >> 4, tb = w >> 1, half = w & 1;
    const bf16* XBC = (const bf16*)(F.ws + WS_XN); const float* DT = (const float*)(F.ws + WS_DT);
    bf16* YS = (bf16*)(F.ws + WS_YS) + (size_t)dir * MTOK * 256;
    const float A = -__expf(INP(8)[l * 8 + dir * 4 + h]); const float Dk = dir == 0 ? INP(9)[l * 4 + h] : 0.f;
    LAS unsigned char* L = F.lds;
#define SSD_TOK(c, tau) ((size_t)b * SEQ + (dir ? SEQ - 1 - ((c) * 64 + (tau)) : (c) * 64 + (tau)))
    f32x4 sacc[4];
#pragma unroll
    for (int i = 0; i < 4; ++i) sacc[i] = (f32x4){0.f, 0.f, 0.f, 0.f};
    for (int i = tid; i < 17408 / 16; i += NTHR) *(LAS v4u*)(L + S_SBF + 16 * i) = (v4u){0u, 0u, 0u, 0u};
    v4u pc0[2], pbv0[2], px0, pc1[2], pbv1[2], px1; float pdt0, pdt1;
#define SSD_LOAD(c, S) do { \
        _Pragma("unroll") for (int k = 0; k < 2; ++k) { const int idx = tid + 512 * k, tau = idx >> 4, ch = idx & 15; const bf16* rp = XBC + SSD_TOK(c, tau) * 768 + grp * 128 + 8 * ch; \
            pbv##S[k] = *(const v4u*)(rp + 256); pc##S[k] = *(const v4u*)(rp + 512); } \
        { const int tau = tid >> 3, ch = tid & 7; px##S = *(const v4u*)(XBC + SSD_TOK(c, tau) * 768 + h * 64 + 8 * ch); } \
        pdt##S = DT[SSD_TOK(c, lane) * 8 + dir * 4 + h]; } while (0)
#define SSD_STAGE(bo, dtv, acum, alast, S) do { \
        _Pragma("unroll") for (int k = 0; k < 2; ++k) { const int idx = tid + 512 * k, tau = idx >> 4, ch = idx & 15; \
            *(LAS v4u*)(L + (bo) + SB_BS + tau * SP_C + ch * 16) = pbv##S[k]; *(LAS v4u*)(L + (bo) + SB_CS + tau * SP_C + ch * 16) = pc##S[k]; } \
        { const int tau = tid >> 3, ch = tid & 7; const float dts = __shfl(dtv, tau), es = __expf((alast) - __shfl(acum, tau)) * dts; v4u od, ow; \
          _Pragma("unroll") for (int e = 0; e < 4; ++e) { const float x0 = bflo(px##S[e]), x1 = bfhi(px##S[e]); od[e] = pk2(x0 * dts, x1 * dts); ow[e] = pk2(x0 * es, x1 * es); } \
          *(LAS v4u*)(L + (bo) + SB_XD + tau * SP_X + ch * 16) = od; *(LAS v4u*)(L + (bo) + SB_XW + tau * SP_X + ch * 16) = ow; } } while (0)
#define SSD_CHUNK(c, CS, NS) do { \
        const int bo = ((c) & 1) * SB_SIZE; \
        __syncthreads();                                                       \
        if ((c) + 2 < 32) SSD_LOAD((c) + 2, CS); \
        bf16x8 ca[4]; \
        _Pragma("unroll") for (int ks = 0; ks < 4; ++ks) ca[ks] = lds_b128(L + bo + SB_CS + (16 * tb + fr) * SP_C + (32 * ks + 8 * fg) * 2); \
        f32x4 yoff[2];                                                         \
        _Pragma("unroll") for (int pbi = 0; pbi < 2; ++pbi) { yoff[pbi] = (f32x4){0.f, 0.f, 0.f, 0.f}; \
            _Pragma("unroll") for (int ks = 0; ks < 4; ++ks) yoff[pbi] = MFMA16(lds_b128(L + S_SBF + (16 * (2 * half + pbi) + fr) * SP_C + (32 * ks + 8 * fg) * 2), ca[ks], yoff[pbi]); } \
        const int tlc = 16 * tb + fr; const float atc = __shfl(acum, tlc), dtc = __shfl(dtv, tlc); \
        _Pragma("unroll") for (int sbi = 0; sbi < 2; ++sbi) { const int sb = 2 * half + sbi; f32x4 g = (f32x4){0.f, 0.f, 0.f, 0.f};     \
            if (sb <= tb) { \
                _Pragma("unroll") for (int ks = 0; ks < 4; ++ks) g = MFMA16(lds_b128(L + bo + SB_BS + (16 * sb + fr) * SP_C + (32 * ks + 8 * fg) * 2), ca[ks], g); } \
            float sv[4]; \
            _Pragma("unroll") for (int r = 0; r < 4; ++r) { const int sl = 16 * sb + 4 * fg + r; const float as_ = __shfl(acum, sl); \
                float v = sl <= tlc ? g[r] * __expf(atc - as_) : 0.f; if (sl == tlc) v += Dk / dtc; sv[r] = v; } \
            u2v so; so.x = pk2(sv[0], sv[1]); so.y = pk2(sv[2], sv[3]); *(LAS u2v*)(L + S_SC + tlc * SP_X + (16 * sb + 4 * fg) * 2) = so; } \
        { const float dec = __expf(alast); \
          _Pragma("unroll") for (int i = 0; i < 4; ++i) sacc[i] *= dec; \
          _Pragma("unroll") for (int ks = 0; ks < 2; ++ks) { const bf16x8 af = lds_tr8(L + bo + SB_BS + (32 * ks) * SP_C + (16 * w) * 2, SP_C, lane); \
              _Pragma("unroll") for (int pb = 0; pb < 4; ++pb) sacc[pb] = MFMA16(af, lds_tr8(L + bo + SB_XW + (32 * ks) * SP_X + (16 * pb) * 2, SP_X, lane), sacc[pb]); } } \
        __syncthreads();                                                       \
        { const float eat = __expf(atc); \
        _Pragma("unroll") for (int pbi = 0; pbi < 2; ++pbi) { const int pb = 2 * half + pbi; f32x4 yd = (f32x4){0.f, 0.f, 0.f, 0.f}; \
            _Pragma("unroll") for (int ks = 0; ks < 2; ++ks) yd = MFMA16(lds_tr8(L + bo + SB_XD + (32 * ks) * SP_X + (16 * pb) * 2, SP_X, lane), lds_b128(L + S_SC + (16 * tb + fr) * SP_X + (32 * ks + 8 * fg) * 2), yd); \
            u2v yo; yo.x = pk2(yd[0] + eat * yoff[pbi][0], yd[1] + eat * yoff[pbi][1]); yo.y = pk2(yd[2] + eat * yoff[pbi][2], yd[3] + eat * yoff[pbi][3]); \
            *(u2v*)(YS + SSD_TOK(c, tlc) * 256 + h * 64 + 16 * pb + 4 * fg) = yo; } } \
        _Pragma("unroll") for (int pb = 0; pb < 4; ++pb) { u2v o; o.x = pk2(sacc[pb][0], sacc[pb][1]); o.y = pk2(sacc[pb][2], sacc[pb][3]); \
            *(LAS u2v*)(L + S_SBF + (16 * pb + fr) * SP_C + (16 * w + 4 * fg) * 2) = o; } \
        if ((c) + 1 < 32) { dtv = pdt##NS; acum = wave_incl_sum(pdt##NS * A, lane); alast = __shfl(acum, 63); SSD_STAGE((((c) + 1) & 1) * SB_SIZE, dtv, acum, alast, NS); } } while (0)
    SSD_LOAD(0, 0);
    float dtv = pdt0, acum = wave_incl_sum(pdt0 * A, lane), alast = __shfl(acum, 63);
    SSD_STAGE(0, dtv, acum, alast, 0);
    SSD_LOAD(1, 1);
    for (int c2 = 0; c2 < 32; c2 += 2) { SSD_CHUNK(c2, 0, 1); SSD_CHUNK(c2 + 1, 1, 0); }
    __syncthreads();
#undef SSD_CHUNK
#undef SSD_LOAD
#undef SSD_STAGE
#undef SSD_TOK
}
constexpr int MB_QS = 0, MB_KS = 9216, MB_KW = 18432, MB_VS = 27648, MB_SIZE = 36864, M_SC = 73728, M_CBF = 82944, M_NBF = 92160;
__device__ __forceinline__ void ml_item(Ctx& F, int l, int it) {
    const int b = it >> 3, dir = (it >> 2) & 1, h = it & 3;
    const int tid = F.tid, lane = F.lane, w = F.wave, fr = lane & 15, fg = lane >> 4, tb = w >> 1, half = w & 1;
    const bf16* U = (const bf16*)(F.ws + WS_U);
    bf16* MLH = (bf16*)(F.ws + WS_MLH) + (size_t)dir * MTOK * 256;
    const float ib = INP(13)[l * 8 + dir * 4 + h], fb = INP(14)[l * 8 + dir * 4 + h];
    LAS unsigned char* L = F.lds;
#define ML_TOK(c, tau) ((size_t)b * SEQ + (dir ? SEQ - 1 - ((c) * 64 + (tau)) : (c) * 64 + (tau)))
    f32x4 cacc[2], nacc = (f32x4){0.f, 0.f, 0.f, 0.f};
    cacc[0] = (f32x4){0.f, 0.f, 0.f, 0.f}; cacc[1] = (f32x4){0.f, 0.f, 0.f, 0.f};
    for (int i = tid; i < (M_NBF + 256 - M_CBF) / 16; i += NTHR) *(LAS v4u*)(L + M_CBF + 16 * i) = (v4u){0u, 0u, 0u, 0u};
    bf16x8 ones;
#pragma unroll
    for (int j = 0; j < 8; ++j) ones[j] = (short)0x3F80;
    v4u pq0, pk0, pv0, pq1, pk1, pv1; float pli0, plf0, pli1, plf1;
#define ML_LOAD(c, S) do { \
        { const int tau = tid >> 3, ch = tid & 7; const bf16* rp = U + ML_TOK(c, tau) * UL + h * 64 + 8 * ch; pq##S = *(const v4u*)(rp + C_MQ); pk##S = *(const v4u*)(rp + C_MK); pv##S = *(const v4u*)(rp + C_MV); } \
        { const bf16* gp = U + ML_TOK(c, lane) * UL + C_G + dir * 4 + h; pli##S = bf2f(gp[8]) + ib; plf##S = -softplus_f(-(bf2f(gp[16]) + fb)); } } while (0)
#define ML_STAGE(bo, av, Mlast, S) do { const int tau = tid >> 3, ch = tid & 7; const float ks = 0.125f * __expf(__shfl(av, tau) - (Mlast)); v4u ow; \
        _Pragma("unroll") for (int e = 0; e < 4; ++e) ow[e] = pk2(bflo(pk##S[e]) * ks, bfhi(pk##S[e]) * ks); \
        *(LAS v4u*)(L + (bo) + MB_QS + tau * SP_X + ch * 16) = pq##S; *(LAS v4u*)(L + (bo) + MB_KS + tau * SP_X + ch * 16) = pk##S; \
        *(LAS v4u*)(L + (bo) + MB_KW + tau * SP_X + ch * 16) = ow; *(LAS v4u*)(L + (bo) + MB_VS + tau * SP_X + ch * 16) = pv##S; } while (0)
#define ML_CHUNK(c, CS, NS) do { \
        const int bo = ((c) & 1) * MB_SIZE; \
        __syncthreads();                                                       \
        if ((c) + 2 < 32) ML_LOAD((c) + 2, CS); \
        bf16x8 qa[2]; \
        _Pragma("unroll") for (int ks = 0; ks < 2; ++ks) qa[ks] = lds_b128(L + bo + MB_QS + (16 * tb + fr) * SP_X + (32 * ks + 8 * fg) * 2); \
        f32x4 yint[2], dint = (f32x4){0.f, 0.f, 0.f, 0.f};                     \
        _Pragma("unroll") for (int ebi = 0; ebi < 2; ++ebi) { yint[ebi] = (f32x4){0.f, 0.f, 0.f, 0.f}; \
            _Pragma("unroll") for (int ks = 0; ks < 2; ++ks) yint[ebi] = MFMA16(lds_b128(L + M_CBF + (16 * (2 * half + ebi) + fr) * SP_X + (32 * ks + 8 * fg) * 2), qa[ks], yint[ebi]); } \
        _Pragma("unroll") for (int ks = 0; ks < 2; ++ks) dint = MFMA16(lds_b128(L + M_NBF + (32 * ks + 8 * fg) * 2), qa[ks], dint); \
        const int tlc = 16 * tb + fr; const float Mtc = __shfl(Mv, tlc), btc = __shfl(bcum, tlc); \
        _Pragma("unroll") for (int sbi = 0; sbi < 2; ++sbi) { const int sb = 2 * half + sbi; f32x4 g = (f32x4){0.f, 0.f, 0.f, 0.f}; \
            if (sb <= tb) { \
                _Pragma("unroll") for (int ks = 0; ks < 2; ++ks) g = MFMA16(lds_b128(L + bo + MB_KS + (16 * sb + fr) * SP_X + (32 * ks + 8 * fg) * 2), qa[ks], g); } \
            float sv[4]; \
            _Pragma("unroll") for (int r = 0; r < 4; ++r) { const int sl = 16 * sb + 4 * fg + r; const float as_ = __shfl(av, sl); \
                sv[r] = sl <= tlc ? g[r] * 0.125f * __expf(as_ - Mtc) : 0.f; } \
            u2v so; so.x = pk2(sv[0], sv[1]); so.y = pk2(sv[2], sv[3]); *(LAS u2v*)(L + M_SC + tlc * SP_X + (16 * sb + 4 * fg) * 2) = so; } \
        { const float dec = __expf(mprev - Mlast); \
          cacc[0] *= dec; cacc[1] *= dec; nacc *= dec; \
          _Pragma("unroll") for (int ks = 0; ks < 2; ++ks) { const bf16x8 af = lds_tr8(L + bo + MB_KW + (32 * ks) * SP_X + (16 * tb) * 2, SP_X, lane); \
              nacc = MFMA16(af, ones, nacc); \
              _Pragma("unroll") for (int ebi = 0; ebi < 2; ++ebi) cacc[ebi] = MFMA16(af, lds_tr8(L + bo + MB_VS + (32 * ks) * SP_X + (16 * (2 * half + ebi)) * 2, SP_X, lane), cacc[ebi]); } } \
        __syncthreads();                                                       \
        { f32x4 dintra = (f32x4){0.f, 0.f, 0.f, 0.f}; bf16x8 sa[2]; \
          _Pragma("unroll") for (int ks = 0; ks < 2; ++ks) { sa[ks] = lds_b128(L + M_SC + (16 * tb + fr) * SP_X + (32 * ks + 8 * fg) * 2); dintra = MFMA16(ones, sa[ks], dintra); } \
          const float wi = __expf(mprev - Mtc), den = wi * dint[0] + dintra[0], dn = 1.0f / fmaxf(fabsf(den), __expf(-(btc + Mtc))); \
          _Pragma("unroll") for (int ebi = 0; ebi < 2; ++ebi) { const int eb = 2 * half + ebi; f32x4 yd = (f32x4){0.f, 0.f, 0.f, 0.f}; \
              _Pragma("unroll") for (int ks = 0; ks < 2; ++ks) yd = MFMA16(lds_tr8(L + bo + MB_VS + (32 * ks) * SP_X + (16 * eb) * 2, SP_X, lane), sa[ks], yd); \
              u2v ho; ho.x = pk2((wi * yint[ebi][0] + yd[0]) * dn, (wi * yint[ebi][1] + yd[1]) * dn); ho.y = pk2((wi * yint[ebi][2] + yd[2]) * dn, (wi * yint[ebi][3] + yd[3]) * dn); \
              *(u2v*)(MLH + ML_TOK(c, tlc) * 256 + h * 64 + 16 * eb + 4 * fg) = ho; } } \
        _Pragma("unroll") for (int ebi = 0; ebi < 2; ++ebi) { u2v o; o.x = pk2(cacc[ebi][0], cacc[ebi][1]); o.y = pk2(cacc[ebi][2], cacc[ebi][3]); \
            *(LAS u2v*)(L + M_CBF + (16 * (2 * half + ebi) + fr) * SP_X + (16 * tb + 4 * fg) * 2) = o; } \
        if (half == 0 && fr == 0) { u2v o; o.x = pk2(nacc[0], nacc[1]); o.y = pk2(nacc[2], nacc[3]); *(LAS u2v*)(L + M_NBF + (16 * tb + 4 * fg) * 2) = o; } \
        mprev = blast + Mlast; \
        if ((c) + 1 < 32) { bcum = wave_incl_sum(plf##NS, lane); av = pli##NS - bcum; Mv = fmaxf(mprev, wave_incl_max(av, lane)); Mlast = __shfl(Mv, 63); blast = __shfl(bcum, 63); \
            ML_STAGE((((c) + 1) & 1) * MB_SIZE, av, Mlast, NS); } } while (0)
    float mprev = 0.f;
    ML_LOAD(0, 0);
    float bcum = wave_incl_sum(plf0, lane), av = pli0 - bcum, Mv = fmaxf(mprev, wave_incl_max(av, lane)), Mlast = __shfl(Mv, 63), blast = __shfl(bcum, 63);
    ML_STAGE(0, av, Mlast, 0);
    ML_LOAD(1, 1);
    for (int c2 = 0; c2 < 32; c2 += 2) { ML_CHUNK(c2, 0, 1); ML_CHUNK(c2 + 1, 1, 0); }
    __syncthreads();
#undef ML_CHUNK
#undef ML_LOAD
#undef ML_STAGE
#undef ML_TOK
}
constexpr int NA_K_OFF = 0, NA_V_OFF = 65536, NA_VP = 1040, NA_RPB_OFF = 65536 + 64 * 1040;
__device__ __forceinline__ int na_swz(int tk) { return (tk & 3) | (((tk >> 3) & 1) << 2); }
__device__ __forceinline__ void na_block_item(Ctx& F, int l, int it) {
    const int r = it & 31, h = (it >> 5) & 3, b = it >> 7;
    const int tid = fresh_tid(F.wave0), lane = tid & 63, w = F.wave0, fr = lane & 15, fg = lane >> 4;
    LAS unsigned char* L = F.lds;
    const bf16* U = (const bf16*)(F.ws + WS_U); const bf16* VT = (const bf16*)(F.ws + WS_UHT) + (size_t)(R_NV + h * 64) * TP; bf16* NAO = (bf16*)(F.ws + WS_NAO);
    const int rs = min(max(r - 4, 0), 24);
    const size_t tb0 = (size_t)b * SEQ;
    __syncthreads();
    { v4u kv[8], vv[8];
#pragma unroll
      for (int k = 0; k < 8; ++k) { const int id = tid + 512 * k, tk = id >> 3, ch = id & 7; kv[k] = *(const v4u*)(U + (tb0 + rs * 64 + tk) * UL + C_NK + h * 64 + 8 * ch); }
#pragma unroll
      for (int k = 0; k < 8; ++k) { const int id = tid + 512 * k, d = id >> 6, sg = id & 63; vv[k] = *(const v4u*)(VT + (size_t)d * TP + tb0 + rs * 64 + 8 * sg); }
#pragma unroll
      for (int k = 0; k < 8; ++k) { const int id = tid + 512 * k, tk = id >> 3, ch = id & 7; *(LAS v4u*)(L + NA_K_OFF + tk * 128 + ((ch ^ na_swz(tk)) << 4)) = kv[k]; }
#pragma unroll
      for (int k = 0; k < 8; ++k) { const int id = tid + 512 * k, d = id >> 6, sg = id & 63; *(LAS v4u*)(L + NA_V_OFF + d * NA_VP + sg * 16) = vv[k]; } }
    __syncthreads();
    if (w < 4) {
        const int jb = w;
        const LAS float* rpb = (const LAS float*)(L + NA_RPB_OFF) + h * 15 * 31;
        const int ks0 = min(max(16 * jb - 8, 0), 32);
        const int jq = 16 * jb + fr, cs = min(max(jq - 8, 0), 48);
        bf16x8 qb[2];
        { const bf16* qp = U + (tb0 + r * 64 + jq) * UL + C_NQ + h * 64 + 8 * fg; qb[0] = *(const bf16x8*)qp; qb[1] = *(const bf16x8*)(qp + 32); }
        const int kcl = ks0 + 8 * (fr >> 2) + (fr & 3);
        float sc[16][4];
#pragma unroll
        for (int T = 0; T < 16; ++T) { const int krow = rs + (T >> 1), tk = (T >> 1) * 64 + kcl + 4 * (T & 1), sw = na_swz(tk);
            const bf16x8 k0 = lds_b128(L + NA_K_OFF + tk * 128 + ((fg ^ sw) << 4)), k1 = lds_b128(L + NA_K_OFF + tk * 128 + (((4 + fg) ^ sw) << 4));
            f32x4 s = (f32x4){0.f, 0.f, 0.f, 0.f}; s = MFMA16(k0, qb[0], s); s = MFMA16(k1, qb[1], s);
#pragma unroll
            for (int e = 0; e < 4; ++e) { const int kc = ks0 + 8 * fg + 4 * (T & 1) + e; const bool valid = kc >= cs && kc < cs + 16;
                const int dc = min(max(kc - jq + 15, 0), 30);
                sc[T][e] = valid ? s[e] * 0.125f + rpb[(krow - r + 7) * 31 + dc] : -1e30f; } }
        float mx = -1e30f;
#pragma unroll
        for (int T = 0; T < 16; ++T)
#pragma unroll
            for (int e = 0; e < 4; ++e) mx = fmaxf(mx, sc[T][e]);
        mx = fmaxf(mx, __shfl_xor(mx, 16)); mx = fmaxf(mx, __shfl_xor(mx, 32));
        float sum = 0.f;
#pragma unroll
        for (int T = 0; T < 16; ++T)
#pragma unroll
            for (int e = 0; e < 4; ++e) { sc[T][e] = __expf(sc[T][e] - mx); sum += sc[T][e]; }
        sum += __shfl_xor(sum, 16); sum += __shfl_xor(sum, 32);
        f32x4 oacc[4];
#pragma unroll
        for (int d = 0; d < 4; ++d) oacc[d] = (f32x4){0.f, 0.f, 0.f, 0.f};
#pragma unroll
        for (int ks = 0; ks < 8; ++ks) {
            bf16x8 pa; { v4u pw; pw[0] = pk2(sc[2 * ks][0], sc[2 * ks][1]); pw[1] = pk2(sc[2 * ks][2], sc[2 * ks][3]); pw[2] = pk2(sc[2 * ks + 1][0], sc[2 * ks + 1][1]); pw[3] = pk2(sc[2 * ks + 1][2], sc[2 * ks + 1][3]); pa = __builtin_bit_cast(bf16x8, pw); }
#pragma unroll
            for (int d = 0; d < 4; ++d) oacc[d] = MFMA16(pa, lds_b128(L + NA_V_OFF + (16 * d + fr) * NA_VP + (ks * 64 + ks0 + 8 * fg) * 2), oacc[d]); }
#pragma unroll
        for (int e = 0; e < 4; ++e) { const int q = 4 * fg + e; const float inv = 1.0f / __shfl(sum, q);
            bf16* op = NAO + (tb0 + r * 64 + 16 * jb + q) * 256 + h * 64 + fr;
#pragma unroll
            for (int d = 0; d < 4; ++d) op[16 * d] = (bf16)f2bf(oacc[d][e] * inv); }
    }
}
constexpr int HY_CP = 8224, HY_ZP = 4112, HY_ZB = 8 * HY_CP;
__device__ __forceinline__ void hy_load_row(const bf16* R, int tid, v4u& cur, v4u& prev) {
    cur = *(const v4u*)(R + 8 * tid); prev = *(const v4u*)(R + 8 * tid - 8);
}
__device__ __forceinline__ void hy_write_copies(LAS unsigned char* L, int tid, const v4u cur, v4u prev) {
    if (tid == 0) prev = (v4u){0u, 0u, 0u, 0u};
    unsigned wd[9] = {prev[0], prev[1], prev[2], prev[3], cur[0], cur[1], cur[2], cur[3], 0u};
#pragma unroll
    for (int rho = 0; rho < 8; ++rho) { const int wo = (8 - rho) >> 1; v4u o;
        if ((rho & 1) == 0) { o[0] = wd[wo]; o[1] = wd[wo + 1]; o[2] = wd[wo + 2]; o[3] = wd[wo + 3]; }
        else {
#pragma unroll
            for (int j = 0; j < 4; ++j) o[j] = (wd[wo + j] >> 16) | (wd[wo + j + 1] << 16); }
        *(LAS v4u*)(L + rho * HY_CP + 16 * tid) = o; }
}
__device__ __forceinline__ float hy_gate4(const bf16* grow, int tok, int t, float w0, float w1, float w2, float bias, float* out4) {
    const u2v c4 = *(const u2v*)(grow + tok); const float lf = t > 0 ? bf2f(grow[tok - 1]) : 0.f, rt = t + 4 < SEQ ? bf2f(grow[tok + 4]) : 0.f;
    const float v0 = bflo(c4.x), v1 = bfhi(c4.x), v2 = bflo(c4.y), v3 = bfhi(c4.y);
    out4[0] = w0 * lf + w1 * v0 + w2 * v1 + bias; out4[1] = w0 * v0 + w1 * v1 + w2 * v2 + bias; out4[2] = w0 * v1 + w1 * v2 + w2 * v3 + bias; out4[3] = w0 * v2 + w1 * v3 + w2 * rt + bias;
    return 0.f;
}
__device__ __forceinline__ void hy_item(Ctx& F, int l, int c) {
    LAS unsigned char* L = F.lds;
    const bf16* UHT = (const bf16*)(F.ws + WS_UHT); bf16* HYO = (bf16*)(F.ws + WS_HYO);
    const float* cw = INP(16) + l * 3 * 768; const float* cb = INP(17) + l * 768; const float* skip = INP(24) + l * 512;
    const int tid = fresh_tid(F.wave0), lane = tid & 63, w = F.wave0, fr = lane & 15, fg = lane >> 4;
    const bf16* FR = (const bf16*)(F.ws + WS_FILT) + (size_t)(l * 2 * 256 + c) * 4096;
    { v4u fc, fp; hy_load_row(FR, tid, fc, fp); hy_write_copies(L, tid, fc, fp); }
    { const float w0 = cw[c], w1 = cw[768 + c], w2 = cw[1536 + c], bias = cb[c]; const bf16* row = UHT + (size_t)c * TP;
      v4u cv[8]; unsigned nb[8];
#pragma unroll
      for (int k = 0; k < 8; ++k) { const int u = tid + 512 * k, b = u >> 8, t0 = (u & 255) * 8, tok = b * SEQ + t0;
          cv[k] = *(const v4u*)(row + tok); nb[k] = (unsigned)row[tok - 1] | ((unsigned)row[tok + 8] << 16); }
#pragma unroll
      for (int k = 0; k < 8; ++k) asm volatile("" : "+v"(nb[k]));
#pragma unroll
      for (int k = 0; k < 8; ++k) { const int u = tid + 512 * k, b = u >> 8, t0 = (u & 255) * 8;
          const float lf = t0 > 0 ? bflo(nb[k]) : 0.f, rt = t0 + 8 < SEQ ? bfhi(nb[k]) : 0.f;
          float x[10]; x[0] = lf; x[9] = rt;
#pragma unroll
          for (int e = 0; e < 4; ++e) { x[1 + 2 * e] = bflo(cv[k][e]); x[2 + 2 * e] = bfhi(cv[k][e]); }
          v4u o;
#pragma unroll
          for (int e = 0; e < 4; ++e) o[e] = pk2(w0 * x[2 * e] + w1 * x[2 * e + 1] + w2 * x[2 * e + 2] + bias, w0 * x[2 * e + 1] + w1 * x[2 * e + 2] + w2 * x[2 * e + 3] + bias);
          *(LAS v4u*)(L + HY_ZB + b * HY_ZP + t0 * 2) = o; } }
    __syncthreads();
    const int abase = (fr & 7) * HY_CP + 4096 + 16 * (fg - (fr >> 3)) - 32 * 16 * w;
    const int bbase = HY_ZB + fr * HY_ZP + 16 * fg;
    for (int o = 0; o < 2; ++o) {
        const int gc = 256 * (o + 1) + c; const bf16* grow = UHT + (size_t)gc * TP;
        u2v gcv[16]; v4u fc, fp;
#pragma unroll
        for (int ii = 0; ii < 8; ++ii) { const int t = 16 * (16 * w + ii) + 4 * fg, tok = fr * SEQ + t; gcv[ii] = *(const u2v*)(grow + tok); }
        f32x4 acc[16];
#pragma unroll
        for (int i = 0; i < 16; ++i) acc[i] = (f32x4){0.f, 0.f, 0.f, 0.f};
        bf16x8 af[16];
#pragma unroll
        for (int m = 2; m <= 15; ++m) af[(16 - m) & 15] = lds_b128(L + abase - 32 * m);
        for (int j0 = 0; j0 < 64; j0 += 8) {
#pragma unroll
            for (int jj = 0; jj < 8; ++jj) { const int j = j0 + jj;
                af[(2 * jj) & 15] = lds_b128(L + abase + 64 * j); af[(2 * jj + 15) & 15] = lds_b128(L + abase + 64 * j - 32);
                const bf16x8 bfr = lds_b128(L + bbase + 64 * j);
#pragma unroll
                for (int ii = 0; ii < 16; ++ii) acc[ii] = MFMA16(af[(2 * jj - ii + 16) & 15], bfr, acc[ii]); }
        }
        __syncthreads();
        if (o == 0) hy_load_row(FR + (size_t)256 * 4096, tid, fc, fp);
        const float w0 = cw[gc], w1 = cw[768 + gc], w2 = cw[1536 + gc], bias = cb[gc];
        const float sk = skip[o * 256 + c];
        unsigned gnb[16];
#pragma unroll
        for (int ii = 8; ii < 16; ++ii) { const int t = 16 * (16 * w + ii) + 4 * fg, tok = fr * SEQ + t; gcv[ii] = *(const u2v*)(grow + tok); }
#pragma unroll
        for (int ii = 0; ii < 16; ++ii) { const int t = 16 * (16 * w + ii) + 4 * fg, tok = fr * SEQ + t; gnb[ii] = (unsigned)grow[tok - 1] | ((unsigned)grow[tok + 4] << 16); }
#pragma unroll
        for (int ii = 0; ii < 16; ++ii) asm volatile("" : "+v"(gnb[ii]));
        if (o == 0) hy_write_copies(L, tid, fc, fp);
#pragma unroll
        for (int ii = 0; ii < 16; ++ii) { const int t = 16 * (16 * w + ii) + 4 * fg, tok = fr * SEQ + t;
            const float lf = t > 0 ? bflo(gnb[ii]) : 0.f, rt = t + 4 < SEQ ? bfhi(gnb[ii]) : 0.f, v0 = bflo(gcv[ii].x), v1 = bfhi(gcv[ii].x), v2 = bflo(gcv[ii].y), v3 = bfhi(gcv[ii].y);
            const float xg0 = w0 * lf + w1 * v0 + w2 * v1 + bias, xg1 = w0 * v0 + w1 * v1 + w2 * v2 + bias, xg2 = w0 * v1 + w1 * v2 + w2 * v3 + bias, xg3 = w0 * v2 + w1 * v3 + w2 * rt + bias;
            LAS u2v* zp = (LAS u2v*)(L + HY_ZB + fr * HY_ZP + t * 2); const u2v zo = *zp;
            const float z0 = xg0 * (acc[ii][0] + sk * bflo(zo.x)), z1 = xg1 * (acc[ii][1] + sk * bfhi(zo.x)), z2 = xg2 * (acc[ii][2] + sk * bflo(zo.y)), z3 = xg3 * (acc[ii][3] + sk * bfhi(zo.y));
            u2v zn; zn.x = pk2(z0, z1); zn.y = pk2(z2, z3);
            if (o == 0) *zp = zn; else *(u2v*)(HYO + (size_t)c * TP + tok) = zn; }
        __syncthreads();
    }
}
#ifndef MIXREP
#define MIXREP 0
#endif
__device__ __forceinline__ void ph_mixers(Ctx& F, int l, int rep) {
    for (int q_ = 0; q_ < ((MIXREP & 1) ? 2 : 1); ++q_)
    for (int it = F.bid; it < 256; it += F.G) { if (it < 128) ssd_item(F, l, it); else ml_item(F, l, it - 128); }
    F.tid = fresh_tid(F.wave0); F.lane = F.tid & 63; F.wave = F.wave0;
    for (int i = F.tid; i < 4 * 15 * 31; i += NTHR) ((LAS float*)(F.lds + NA_RPB_OFF))[i] = INP(11)[(size_t)l * 4 * 15 * 31 + i];
    volatile LAS int* slot = (volatile LAS int*)(F.lds + MISC_OFF);
    unsigned* ctr = (unsigned*)(F.ws + WS_CTL) + 64 * (1 + l + 2 * rep);
    for (;;) {
        __syncthreads();
        if (F.tid == 0) slot[0] = (int)atomicAdd(ctr, 1u);
        __syncthreads();
        const int it = slot[0];
        if (it >= 256 + 2048) break;
        if (it < 256) { hy_item(F, l, it); if (MIXREP & 2) hy_item(F, l, it); }
        else na_block_item(F, l, it - 256);
    }
}

__device__ __forceinline__ void ph_finalize(Ctx& F, int l) {
    const int lane = F.lane, c0 = lane * 4, tid = F.tid;
    const bf16* U = (const bf16*)(F.ws + WS_U); const bf16* YS = (const bf16*)(F.ws + WS_YS); const bf16* NAO = (const bf16*)(F.ws + WS_NAO);
    const bf16* MLH = (const bf16*)(F.ws + WS_MLH); const bf16* HYO = (const bf16*)(F.ws + WS_HYO); bf16* YM = (bf16*)(F.ws + WS_XN);
    const f32x4 gs = *(const f32x4*)(INP(10) + l * 256 + c0), gn = *(const f32x4*)(INP(12) + l * 256 + c0), gm = *(const f32x4*)(INP(15) + l * 256 + c0), gh = *(const f32x4*)(INP(25) + l * 256 + c0);
    constexpr int HP = 144;
    for (int it = F.bid; it < MTOK / 64; it += F.G) {
        const int tok0 = it * 64;
        __syncthreads();
#pragma unroll
        for (int k = 0; k < 4; ++k) { const int u = tid + 512 * k, c = u >> 3, ch = u & 7; *(LAS v4u*)(F.lds + c * HP + ch * 16) = *(const v4u*)(HYO + (size_t)c * TP + tok0 + ch * 8); }
        __syncthreads();
        typedef unsigned u2 __attribute__((ext_vector_type(2)));
#pragma unroll 1
        for (int q0 = 0; q0 < 8; q0 += 8) {
            u2 ys0[8], ys1[8], zz[8], na[8], m0[8], m1[8], og[8]; float hv[8][4];
#pragma unroll
            for (int j = 0; j < 8; ++j) { const int tl = F.wave * 8 + q0 + j; const size_t tok = (size_t)(tok0 + tl);
                ys0[j] = *(const u2*)(YS + tok * 256 + c0); ys1[j] = *(const u2*)(YS + (MTOK + tok) * 256 + c0); zz[j] = *(const u2*)(U + tok * UL + C_SZ + c0);
                na[j] = *(const u2*)(NAO + tok * 256 + c0); m0[j] = *(const u2*)(MLH + tok * 256 + c0); m1[j] = *(const u2*)(MLH + (MTOK + tok) * 256 + c0); og[j] = *(const u2*)(U + tok * UL + C_MO + c0);
                const LAS bf16* hp = (const LAS bf16*)(F.lds + c0 * HP + tl * 2); hv[j][0] = bf2f(hp[0]); hv[j][1] = bf2f(hp[HP / 2]); hv[j][2] = bf2f(hp[HP]); hv[j][3] = bf2f(hp[3 * HP / 2]); }
#pragma unroll
            for (int j = 0; j < 8; ++j) { const size_t tok = (size_t)(tok0 + F.wave * 8 + q0 + j); bf16* yo = YM + tok * DM + c0;
                { const float v0 = (bflo(ys0[j].x) + bflo(ys1[j].x)) * silu_ff(bflo(zz[j].x)), v1 = (bfhi(ys0[j].x) + bfhi(ys1[j].x)) * silu_ff(bfhi(zz[j].x)), v2 = (bflo(ys0[j].y) + bflo(ys1[j].y)) * silu_ff(bflo(zz[j].y)), v3 = (bfhi(ys0[j].y) + bfhi(ys1[j].y)) * silu_ff(bfhi(zz[j].y));
                  const float rs = 1.0f / sqrtf(wave_sum(v0 * v0 + v1 * v1 + v2 * v2 + v3 * v3) * (1.f / 256.f) + EPS);
                  u2 o; o.x = pk2(v0 * rs * gs.x, v1 * rs * gs.y); o.y = pk2(v2 * rs * gs.z, v3 * rs * gs.w); *(u2*)yo = o; }
                { const float v0 = bflo(na[j].x), v1 = bfhi(na[j].x), v2 = bflo(na[j].y), v3 = bfhi(na[j].y);
                  const float rs = 1.0f / sqrtf(wave_sum(v0 * v0 + v1 * v1 + v2 * v2 + v3 * v3) * (1.f / 256.f) + EPS);
                  u2 o; o.x = pk2(v0 * rs * gn.x, v1 * rs * gn.y); o.y = pk2(v2 * rs * gn.z, v3 * rs * gn.w); *(u2*)(yo + 256) = o; }
                { const float v0 = bflo(m0[j].x) + bflo(m1[j].x), v1 = bfhi(m0[j].x) + bfhi(m1[j].x), v2 = bflo(m0[j].y) + bflo(m1[j].y), v3 = bfhi(m0[j].y) + bfhi(m1[j].y);
                  float ss = v0 * v0 + v1 * v1 + v2 * v2 + v3 * v3;
                  ss += __shfl_xor(ss, 1); ss += __shfl_xor(ss, 2); ss += __shfl_xor(ss, 4); ss += __shfl_xor(ss, 8);
                  const float rs = 1.0f / sqrtf(ss * (1.f / 64.f) + EPS);
                  u2 o; o.x = pk2(v0 * rs * gm.x * sigmoid_f(bflo(og[j].x)), v1 * rs * gm.y * sigmoid_f(bfhi(og[j].x))); o.y = pk2(v2 * rs * gm.z * sigmoid_f(bflo(og[j].y)), v3 * rs * gm.w * sigmoid_f(bfhi(og[j].y)));
                  *(u2*)(yo + 512) = o; }
                { const float v0 = hv[j][0], v1 = hv[j][1], v2 = hv[j][2], v3 = hv[j][3];
                  const float rs = 1.0f / sqrtf(wave_sum(v0 * v0 + v1 * v1 + v2 * v2 + v3 * v3) * (1.f / 256.f) + EPS);
                  u2 o; o.x = pk2(v0 * rs * gh.x, v1 * rs * gh.y); o.y = pk2(v2 * rs * gh.z, v3 * rs * gh.w); *(u2*)(yo + 768) = o; }
            }
        }
    }
}

#define XB_TMO      128
#define XB_XCNT(j)  (256  + 64 * (j))
#define XB_XSUB(j)  (1280 + 64 * (j))
#define XB_XGEN(j)  (2304 + 64 * (j))
#define XB_TOP      3328
#define XB_TOPGEN   3392
#define XCD_BAR_WORDS 3456
#define XB_SPIN_CAP (1u << 18)

__device__ __forceinline__ unsigned xb_ld(unsigned* p)              { return __hip_atomic_load(p, __ATOMIC_RELAXED, __HIP_MEMORY_SCOPE_AGENT); }
__device__ __forceinline__ unsigned xb_add(unsigned* p, unsigned v) { return __hip_atomic_fetch_add(p, v, __ATOMIC_RELAXED, __HIP_MEMORY_SCOPE_AGENT); }
__device__ __forceinline__ unsigned xb_xcc_id() { return (unsigned)__builtin_amdgcn_s_getreg((3 << 11) | 20) & 0xFu; }
#define XB_SPIN(cond, bar) do { unsigned _sp = 0; while (cond) { __builtin_amdgcn_s_sleep(1); \
    if ((++_sp & 255u) == 0u) { if (xb_ld(&(bar)[XB_TMO])) break; if (_sp > XB_SPIN_CAP) { atomicAdd(&(bar)[XB_TMO], 1u); break; } } } } while (0)

struct XcdBarrier {
    unsigned* bar; unsigned x;
    volatile LAS unsigned* st;
};

__device__ __forceinline__ XcdBarrier xcd_barrier_post(unsigned* bar, volatile LAS unsigned* st) {
    XcdBarrier b; b.bar = bar; b.x = xb_xcc_id(); b.st = st;
    if (threadIdx.x == 0) (void)xb_add(&bar[XB_XCNT(b.x)], 1u);
    return b;
}
__device__ __forceinline__ void xcd_barrier_complete(unsigned* bar, unsigned x, unsigned& nloc, unsigned& nx) {
    const unsigned G = gridDim.x * gridDim.y * gridDim.z;
    unsigned sum, cnt, mine, sp = 0u;
    for (;;) {
        sum = 0u; cnt = 0u; mine = 0u;
#pragma unroll
        for (unsigned j = 0; j < 16; ++j) { const unsigned c = xb_ld(&bar[XB_XCNT(j)]); sum += c; cnt += (c > 0u) ? 1u : 0u; mine = (j == x) ? c : mine; }
        if (sum == G) break;
        __builtin_amdgcn_s_sleep(1);
        if ((++sp & 255u) == 0u) { if (xb_ld(&bar[XB_TMO])) break; if (sp > XB_SPIN_CAP) { atomicAdd(&bar[XB_TMO], 1u); break; } }
    }
    nloc = mine > 0u ? mine : 1u; nx = cnt > 0u ? cnt : 1u;
}

__device__ __forceinline__ void xcd_barrier(const XcdBarrier& b, const bool leader) {
    asm volatile("s_waitcnt vmcnt(0)" ::: "memory");
    __syncthreads();
    if (leader) {
        unsigned* bar = b.bar;
        __builtin_amdgcn_s_waitcnt(0);
        unsigned nloc = b.st[0], nx = b.st[1];
        if (nloc == 0u) { xcd_barrier_complete(bar, b.x, nloc, nx); b.st[0] = nloc; b.st[1] = nx; }
        const unsigned old = xb_add(&bar[XB_XSUB(b.x)], 1u);
        const unsigned gen = old / nloc;
        if (old + 1u == (gen + 1u) * nloc) {
            __builtin_amdgcn_fence(__ATOMIC_RELEASE, "agent");
            asm volatile("s_waitcnt vmcnt(0)" ::: "memory");
            const unsigned og = xb_add(&bar[XB_TOP], 1u);
            const unsigned tg = og / nx;
            if (og + 1u == (tg + 1u) * nx) xb_add(&bar[XB_TOPGEN], 1u);
            else XB_SPIN(xb_ld(&bar[XB_TOPGEN]) == tg, bar);
            __builtin_amdgcn_fence(__ATOMIC_ACQUIRE, "agent");
            xb_add(&bar[XB_XGEN(b.x)], 1u);
            asm volatile("s_waitcnt vmcnt(0)" ::: "memory");
        } else {
            XB_SPIN(xb_ld(&bar[XB_XGEN(b.x)]) == gen, bar);
            __builtin_amdgcn_fence(__ATOMIC_ACQUIRE, "agent");
            asm volatile("s_waitcnt vmcnt(0)" ::: "memory");
        }
    }
    __syncthreads();
}

constexpr int N_PHASES = 2 + 9 * DEPTH;
#ifndef MK_MULTI
#define MK_MULTI 1
#endif
__global__ void __launch_bounds__(NTHR, 2) hybrid_fwd(Args args) {
    extern __shared__ __attribute__((aligned(16))) unsigned char lds_raw[];
    Ctx F;
    F.lds = (LAS unsigned char*)lds_raw; F.tid = threadIdx.x; F.lane = F.tid & 63; F.wave = __builtin_amdgcn_readfirstlane(F.tid >> 6); F.wave0 = F.wave;
    F.bid = blockIdx.x; F.G = gridDim.x; F.out = args.out; F.ws = args.ws; F.A = &args;
#if MK_MULTI
    const int lo = args.ph_lo, hi = args.ph_hi;
#else
    constexpr int lo = 0, hi = N_PHASES;
#endif
#if MK_MULTI
#define SEAM(k) do { } while (0)
#else
    for (int u = F.tid; u < 32; u += NTHR) ((LAS unsigned*)(F.lds + MISC_OFF))[u] = 0u;
    __syncthreads();
    XcdBarrier bar = xcd_barrier_post((unsigned*)(F.ws + WS_CTL) + 4096, (volatile LAS unsigned*)(F.lds + MISC_OFF) + 8);
#define SEAM(k) do { if ((k) + 1 < hi) { XcdBarrier b2_ = bar; asm volatile("" : "+s"(b2_.x)); xcd_barrier(b2_, fresh_tid(F.wave0) == 0); } } while (0)
#endif
#ifndef PHMASK
#define PHMASK 0xFFFFF
#endif
#define FRESH() do { F.tid = fresh_tid(F.wave0); F.lane = F.tid & 63; F.wave = F.wave0; } while (0)
#define IN(k) (((PHMASK >> (k)) & 1) && lo <= (k) && (k) < hi)
#define INL(j) (((PHMASK >> (2 + (j))) & 1) && lo <= (pb + (j)) && (pb + (j)) < hi)
#ifndef REPMASK
#define REPMASK 0
#endif
#define REPS(k) for (int rep_ = 0; rep_ < ((((REPMASK) >> (k)) & 1) ? 2 : 1); ++rep_)
    const float* MOD = (const float*)(F.ws + WS_MOD); float* SS = (float*)(F.ws + WS_SS); const float* CV = (const float*)(F.ws + WS_CV);
    if (IN(0)) { REPS(0) { FRESH(); ph_prologue(F); __syncthreads(); } SEAM(0); }
    if (IN(1)) { REPS(1) { FRESH(); ph_filters(F); FRESH(); ph_cvec(F); FRESH(); ph_xn0(F, MOD); __syncthreads(); } SEAM(1); }
#pragma unroll 1
    for (int l = 0; l < DEPTH; ++l) {
        const int pb = 2 + 9 * l; unsigned char* wb = F.ws + WS_W + (size_t)l * W_LAYER; const float* mod_l = MOD + (size_t)l * NB * 6144; const float* cv_l = CV + (size_t)l * NB * CVP;
        float* ss_in = SS + (size_t)(2 * l) * MTOK; float* ss_ff = SS + (size_t)(2 * l + 1) * MTOK; float* ss_nx = SS + (size_t)(2 * l + 2) * MTOK;
        if (INL(0)) { REPS(2) { FRESH();
            pg8::Gemm g{(const pg8::bf16_t*)(F.ws + WS_XN), (const pg8::bf16_t*)(wb + W_IN_OFF), MTOK, UL, DM};
            pg8::DualOrder S; S.init(MTOK, UL, NTR, MTOK, F.G, F.bid, (const pg8::bf16_t*)(wb + W_HY_OFF), (const pg8::bf16_t*)(F.ws + WS_XN));
            pg8::EpiDualIn E{{(pg8::bf16_t*)(F.ws + WS_U), UL, ss_in, cv_l}, {(pg8::bf16_t*)(F.ws + WS_UHT), TP, ss_in, cv_l + 2816}};
            pg8::gemm_phase<pg8::EpiDualIn, pg8::DualOrder, true, true>(F.lds, g, S, E, F.wave0);
            __syncthreads(); }
            SEAM(pb + 0);
        }
        if (INL(1)) { REPS(3) { FRESH(); ph_prepass(F, l); } SEAM(pb + 1); }
        if (INL(2)) { REPS(4) { FRESH(); ph_mixers(F, l, rep_); } SEAM(pb + 2); }
        if (INL(3)) { REPS(5) { FRESH(); ph_finalize(F, l); } SEAM(pb + 3); }
        if (INL(4)) { FRESH();
            pg8::Gemm g{(const pg8::bf16_t*)(F.ws + WS_XN), (const pg8::bf16_t*)(wb + W_OUT_OFF), MTOK, DM, DM}; pg8::StaticOrder S; S.init(MTOK, DM, F.G, F.bid);
            pg8::EpiResidN E{l == 0 ? INP(0) : (const float*)F.out, F.out, mod_l + 2048, mod_l + 4096, (pg8::bf16_t*)(F.ws + WS_XN2), ss_ff};
            pg8::gemm_phase<pg8::EpiResidN, pg8::StaticOrder, true, true>(F.lds, g, S, E, F.wave0);
            SEAM(pb + 4);
        }
        if (INL(6)) { REPS(8) { FRESH();
            pg8::Gemm g{(const pg8::bf16_t*)(F.ws + WS_XN2), (const pg8::bf16_t*)(wb + W_GU_OFF), MTOK, 2 * FFH, DM}; pg8::StaticOrder S; S.init(MTOK, 2 * FFH, F.G, F.bid);
            pg8::EpiSwigluN E{(pg8::bf16_t*)(F.ws + WS_U), FFH, ss_ff, cv_l + 3840}; pg8::gemm_phase<pg8::EpiSwigluN, pg8::StaticOrder, true, true>(F.lds, g, S, E, F.wave0); __syncthreads(); }
            SEAM(pb + 6);
        }
        if (INL(7)) { FRESH();
            pg8::Gemm g{(const pg8::bf16_t*)(F.ws + WS_U), (const pg8::bf16_t*)(wb + W_DN_OFF), MTOK, DM, FFH}; pg8::StaticOrder S; S.init(MTOK, DM, F.G, F.bid);
            pg8::EpiResidN E{(const float*)F.out, F.out, mod_l + 5120, mod_l + (size_t)NB * 6144 + 1024, l + 1 < DEPTH ? (pg8::bf16_t*)(F.ws + WS_XN) : nullptr, ss_nx};
            pg8::gemm_phase<pg8::EpiResidN, pg8::StaticOrder, true, true>(F.lds, g, S, E, F.wave0);
            SEAM(pb + 7);
        }
        if (INL(8)) { if (l + 1 == DEPTH) { FRESH(); ph_final(F); } }
    }
#undef IN
#undef INL
#undef SEAM
}

extern "C" void kernel_launch(void* const* d_in, const int* in_sizes, int n_in, void* d_out, int out_size, void* d_ws, size_t ws_size, hipStream_t stream) {
    static int grid = 0;
    if (grid == 0) {
        if (n_in != 31 || out_size != MTOK * DM || ws_size < WS_END) { fprintf(stderr, "kernel_launch: unexpected problem shape (n_in %d out %d ws %zu)\n", n_in, out_size, ws_size); grid = -1; return; }
        int dev = 0, cus = 0, per_cu = 0;
        hipGetDevice(&dev); hipDeviceGetAttribute(&cus, hipDeviceAttributeMultiprocessorCount, dev);
        if (hipFuncSetAttribute((const void*)hybrid_fwd, hipFuncAttributeMaxDynamicSharedMemorySize, LDS_BYTES) != hipSuccess) { fprintf(stderr, "kernel_launch: hipFuncSetAttribute failed\n"); grid = -1; return; }
        if (hipOccupancyMaxActiveBlocksPerMultiprocessor(&per_cu, (const void*)hybrid_fwd, NTHR, LDS_BYTES) != hipSuccess || per_cu < 1) { fprintf(stderr, "kernel_launch: occupancy query says %d blocks per CU\n", per_cu); grid = -1; (void)hipGetLastError(); return; }
        grid = cus;
    }
    if (grid < 0) return;
    hipMemsetAsync((char*)d_ws + WS_CTL, 0, CTL_ZERO_BYTES, stream);
    Args a{};
    for (int i = 0; i < 31; ++i) a.in[i] = (const float*)d_in[i];
    a.out = (float*)d_out; a.ws = (unsigned char*)d_ws;
#if MK_MULTI
    for (int p = 0; p < N_PHASES; ++p) { a.ph_lo = p; a.ph_hi = p + 1; hipLaunchKernelGGL(hybrid_fwd, dim3(grid), dim3(NTHR), LDS_BYTES, stream, a); }
#else
    a.ph_lo = 0; a.ph_hi = N_PHASES;
    hipLaunchKernelGGL(hybrid_fwd, dim3(grid), dim3(NTHR), LDS_BYTES, stream, a);
#endif
}
```

```cpp
#include <hip/hip_runtime.h>
#include <hip/hip_cooperative_groups.h>
#include <cstdio>
#include <cstdint>
namespace cg = cooperative_groups;
#define MK_MULTI 0
namespace pg8 {
#define PG8_LAS __attribute__((address_space(3)))
typedef unsigned short bf16_t;
typedef short bf16x8 __attribute__((ext_vector_type(8)));
typedef float f32x4 __attribute__((ext_vector_type(4)));
typedef unsigned u32x4 __attribute__((ext_vector_type(4)));
constexpr int BM = 256, BK = 64, HALF = 128, HTB = HALF * BK * 2  , STAGE_BYTES = 8 * HTB, NXCD = 8, WGM = 8;

__host__ __device__ __forceinline__ int lds_byte(int r, int c) { const int st = (r >> 4) * 2 + (c >> 5), rr = r & 15, cc = c & 31, ob = rr * 64 + cc * 2; return st * 1024 + (ob ^ (((ob >> 9) & 1) << 5)); }
__host__ __device__ __forceinline__ void stage_rc(int b, int& R, int& C) { const int st = b / 1024, sb = b % 1024, swz = sb ^ (((sb >> 9) & 1) << 5); R = (st >> 1) * 16 + swz / 64; C = (st & 1) * 32 + (swz % 64) / 2; }
__host__ __device__ __forceinline__ int perm32(int rho) { const int n = rho >> 4, i = rho & 15; return 8 * (i >> 2) + 4 * n + (i & 3); }

struct Unit { int pm, pn, kind; };
struct Gemm { const bf16_t* A; const bf16_t* Bt; int M, N, K; };

struct StaticOrder {
    int nM, nN, nwg, G, c;
    __host__ __device__ void init(int M, int N, int G_, int c_) { nM = M / BM; nN = N / BM; nwg = nM * nN; G = G_; c = c_; }
    __host__ __device__ bool next(int i, Unit& u) const {
        const long L = (long)i * G + c; if (L >= nwg) return false;
        int wgid = (int)L; { const int q = nwg / NXCD, r = nwg % NXCD, xcd = wgid % NXCD, off = wgid / NXCD; wgid = (xcd < r ? xcd * (q + 1) : r * (q + 1) + (xcd - r) * q) + off; }
        const int nig = WGM * nN, gid = wgid / nig, fm = gid * WGM, gsz = (nM - fm) < WGM ? (nM - fm) : WGM;
        u.pm = fm + ((wgid % nig) % gsz); u.pn = (wgid % nig) / gsz; u.kind = 0; return true;
    }
    template <class G_> __device__ __forceinline__ const char* pa(const G_& g, const Unit& u, size_t tstep) const { return (const char*)g.A + (size_t)u.pm * tstep; }
    template <class G_> __device__ __forceinline__ const char* pb(const G_& g, const Unit& u, size_t tstep) const { return (const char*)g.Bt + (size_t)u.pn * tstep; }
    __device__ __forceinline__ void a_ready(const Unit&) const {}
    __device__ __forceinline__ void done(const Unit&) const {}
};

__device__ __forceinline__ unsigned cvt_pk_bf16(float lo, float hi) { unsigned r; asm volatile("v_cvt_pk_bf16_f32 %0, %1, %2" : "=v"(r) : "v"(lo), "v"(hi)); return r; }
constexpr float PG8_EPS = 1e-6f;
constexpr int CVP = 9472;
struct EpiStoreBf16N {
    static constexpr bool PERM = true, AFTER_DRAIN = false;
    bf16_t* O; int ldc; const float* ss; const float* cv;
    __device__ __forceinline__ void operator()(const f32x4 (&acc)[2][2][4][2], const Unit& u, int wr, int wc, int fr, int fq) const {
        const int row0 = u.pm * BM + wr * 64 + fr; const int col0 = u.pn * BM + wc * 32 + 8 * fq;
        const float* cvp = cv + (size_t)((u.pm * BM) >> 11) * CVP + col0;
        f32x4 cvv[2][2];
#pragma unroll
        for (int bj = 0; bj < 2; ++bj)
#pragma unroll
            for (int n = 0; n < 2; ++n) cvv[bj][n] = *(const f32x4*)(cvp + bj * HALF + 4 * n);
#pragma unroll
        for (int ai = 0; ai < 2; ++ai)
#pragma unroll
            for (int m = 0; m < 4; ++m) { const int r = row0 + ai * HALF + m * 16; bf16_t* rowp = O + (size_t)r * ldc + col0;
                const float rs = 1.0f / sqrtf(ss[r] * (1.0f / 1024.0f) + PG8_EPS);
#pragma unroll
                for (int bj = 0; bj < 2; ++bj) { const f32x4 v0 = acc[ai][bj][m][0] * rs + cvv[bj][0], v1 = acc[ai][bj][m][1] * rs + cvv[bj][1];
                    u32x4 w; w.x = cvt_pk_bf16(v0[0], v0[1]); w.y = cvt_pk_bf16(v0[2], v0[3]); w.z = cvt_pk_bf16(v1[0], v1[1]); w.w = cvt_pk_bf16(v1[2], v1[3]);
                    *(u32x4*)(rowp + bj * HALF) = w; } }
    }
};
struct EpiStoreBf16T {
    static constexpr bool PERM = true, AFTER_DRAIN = false;
    bf16_t* O; int ldc; const float* ss; const float* cv;
    __device__ __forceinline__ void operator()(const f32x4 (&acc)[2][2][4][2], const Unit& u, int wr, int wc, int fr, int fq) const {
        const int row0 = u.pm * BM + wr * 64 + fr; const int col0 = u.pn * BM + wc * 32 + 8 * fq;
        const float* cvp = cv + (size_t)((u.pn * BM) >> 11) * CVP;
        f32x4 rsv[2][2];
#pragma unroll
        for (int bj = 0; bj < 2; ++bj)
#pragma unroll
            for (int n = 0; n < 2; ++n) { const f32x4 s4 = *(const f32x4*)(ss + col0 + bj * HALF + 4 * n);
#pragma unroll
                for (int j = 0; j < 4; ++j) rsv[bj][n][j] = 1.0f / sqrtf(s4[j] * (1.0f / 1024.0f) + PG8_EPS); }
#pragma unroll
        for (int ai = 0; ai < 2; ++ai)
#pragma unroll
            for (int m = 0; m < 4; ++m) { const int r = row0 + ai * HALF + m * 16; bf16_t* rowp = O + (size_t)r * ldc + col0; const float c = cvp[r];
#pragma unroll
                for (int bj = 0; bj < 2; ++bj) { const f32x4 v0 = acc[ai][bj][m][0] * rsv[bj][0] + c, v1 = acc[ai][bj][m][1] * rsv[bj][1] + c;
                    u32x4 w; w.x = cvt_pk_bf16(v0[0], v0[1]); w.y = cvt_pk_bf16(v0[2], v0[3]); w.z = cvt_pk_bf16(v1[0], v1[1]); w.w = cvt_pk_bf16(v1[2], v1[3]);
                    *(u32x4*)(rowp + bj * HALF) = w; } }
    }
};
struct EpiResidN {
    static constexpr bool PERM = false, AFTER_DRAIN = false;
    const float* base; float* out; const float* gate; const float* scn; bf16_t* an; float* ss;
    __device__ __forceinline__ void operator()(const f32x4 (&acc)[2][2][4][2], const Unit& u, int wr, int wc, int fr, int fq) const {
        const int col0 = u.pn * BM + wc * 32 + 4 * fq; const size_t bo = (size_t)((u.pm * BM) >> 11) * 6144 + col0;
        f32x4 gv[2][2], sv[2][2];
#pragma unroll
        for (int bj = 0; bj < 2; ++bj)
#pragma unroll
            for (int n = 0; n < 2; ++n) { gv[bj][n] = *(const f32x4*)(gate + bo + bj * HALF + n * 16); sv[bj][n] = an ? *(const f32x4*)(scn + bo + bj * HALF + n * 16) + 1.0f : (f32x4){0.f, 0.f, 0.f, 0.f}; }
#pragma unroll
        for (int ai = 0; ai < 2; ++ai)
#pragma unroll
            for (int m = 0; m < 4; ++m) { const int r = u.pm * BM + ai * HALF + wr * 64 + m * 16 + fr; const size_t off = (size_t)r * 1024 + col0; float q = 0.f;
#pragma unroll
                for (int bj = 0; bj < 2; ++bj)
#pragma unroll
                    for (int n = 0; n < 2; ++n) { const f32x4 bs = *(const f32x4*)(base + off + bj * HALF + n * 16); const f32x4 o = bs + gv[bj][n] * acc[ai][bj][m][n];
                        *(f32x4*)(out + off + bj * HALF + n * 16) = o; q += (o[0] * o[0] + o[1] * o[1]) + (o[2] * o[2] + o[3] * o[3]);
                        if (an) { const f32x4 a = o * sv[bj][n]; typedef unsigned u32x2 __attribute__((ext_vector_type(2))); u32x2 w; w.x = cvt_pk_bf16(a[0], a[1]); w.y = cvt_pk_bf16(a[2], a[3]); *(u32x2*)(an + off + bj * HALF + n * 16) = w; } }
                q += __shfl_xor(q, 16); q += __shfl_xor(q, 32);
                if (fq == 0) atomicAdd(ss + r, q);
                if (m == 3) asm volatile("" ::: "memory"); }
    }
};
__device__ __forceinline__ float silu_f(float v) { return v * __builtin_amdgcn_rcpf(1.0f + __expf(-v)); }
struct EpiSwigluN {
    static constexpr bool PERM = true, AFTER_DRAIN = false;
    bf16_t* O; int ldc; const float* ss; const float* cv;
    __device__ __forceinline__ void operator()(const f32x4 (&acc)[2][2][4][2], const Unit& u, int wr, int wc, int fr, int fq) const {
        const int row0 = u.pm * BM + wr * 64 + fr; const int col0 = u.pn * HALF + wc * 32 + 8 * fq;
        const float* cvp = cv + (size_t)((u.pm * BM) >> 11) * CVP + u.pn * BM + wc * 32 + 8 * fq;
        f32x4 cg[2], cu[2];
#pragma unroll
        for (int n = 0; n < 2; ++n) { cg[n] = *(const f32x4*)(cvp + 4 * n); cu[n] = *(const f32x4*)(cvp + HALF + 4 * n); }
#pragma unroll
        for (int ai = 0; ai < 2; ++ai)
#pragma unroll
            for (int m = 0; m < 4; ++m) { const int r = row0 + ai * HALF + m * 16; bf16_t* rowp = O + (size_t)r * ldc + col0;
                const float rs = 1.0f / sqrtf(ss[r] * (1.0f / 1024.0f) + PG8_EPS);
                const f32x4 g0 = acc[ai][0][m][0] * rs + cg[0], g1 = acc[ai][0][m][1] * rs + cg[1], u0 = acc[ai][1][m][0] * rs + cu[0], u1 = acc[ai][1][m][1] * rs + cu[1];
                u32x4 w;
                w.x = cvt_pk_bf16(silu_f(g0[0]) * u0[0], silu_f(g0[1]) * u0[1]); w.y = cvt_pk_bf16(silu_f(g0[2]) * u0[2], silu_f(g0[3]) * u0[3]);
                w.z = cvt_pk_bf16(silu_f(g1[0]) * u1[0], silu_f(g1[1]) * u1[1]); w.w = cvt_pk_bf16(silu_f(g1[2]) * u1[2], silu_f(g1[3]) * u1[3]);
                *(u32x4*)rowp = w; }
    }
};


struct DualOrder {
    StaticOrder s1, s2; const bf16_t* A2; const bf16_t* Bt2;
    __host__ __device__ void init(int M1, int N1, int M2, int N2, int G_, int c_, const bf16_t* a2, const bf16_t* b2) { s1.init(M1, N1, G_, c_); s2.init(M2, N2, G_, c_); A2 = a2; Bt2 = b2; }
    __device__ __forceinline__ bool next(int i, Unit& u) const {
        const long L = (long)i * s1.G + s1.c;
        if (L < s1.nwg) return s1.next(i, u);
        const long L2 = L - s1.nwg; if (L2 >= s2.nwg) return false;
        StaticOrder t = s2; t.c = (int)(L2 % s2.G); const bool ok = t.next((int)(L2 / s2.G), u); u.kind = 1; return ok;
    }
    template <class G_> __device__ __forceinline__ const char* pa(const G_& g, const Unit& u, size_t tstep) const { return (const char*)(u.kind ? A2 : g.A) + (size_t)u.pm * tstep; }
    template <class G_> __device__ __forceinline__ const char* pb(const G_& g, const Unit& u, size_t tstep) const { return (const char*)(u.kind ? Bt2 : g.Bt) + (size_t)u.pn * tstep; }
    __device__ __forceinline__ void a_ready(const Unit&) const {}
    __device__ __forceinline__ void done(const Unit&) const {}
};
struct EpiDualIn {
    static constexpr bool PERM = true, AFTER_DRAIN = false;
    EpiStoreBf16N a; EpiStoreBf16T b;
    __device__ __forceinline__ void operator()(const f32x4 (&acc)[2][2][4][2], const Unit& u, int wr, int wc, int fr, int fq) const { if (u.kind) b(acc, u, wr, wc, fr, fq); else a(acc, u, wr, wc, fr, fq); }
};
template <class Epi, class Sched, bool ALIGN_EPI = false, bool SP2 = false>
__device__ __forceinline__ void gemm_phase(PG8_LAS unsigned char* lds, const Gemm g, const Sched& S, const Epi& E, const int wave0) {
    unsigned z_ = 0u; asm volatile("" : "+v"(z_)); const int lane_ = (int)__builtin_amdgcn_mbcnt_hi(~0u, __builtin_amdgcn_mbcnt_lo(~0u, z_));
    const int tid = (wave0 << 6) | lane_, wid = wave0, lane = lane_, wr = wid >> 2, wc = wid & 3, fr = lane & 15, fq = lane >> 4;
    const int K = g.K, nt = K / BK;
    unsigned voffA[2], voffB[2];
#pragma unroll
    for (int i = 0; i < 2; ++i) { int R, C; stage_rc(tid * 16 + i * 8192, R, C); const int Rb = Epi::PERM ? ((R & ~31) + perm32(R & 31)) : R;
        voffA[i] = (unsigned)(R * K + C) * 2u; voffB[i] = (unsigned)(Rb * K + C) * 2u; }
    const size_t kstep = (size_t)(BK * 2);
    const size_t hstep = (size_t)HALF * K * 2;
    const size_t tstep = 2 * hstep;
    const unsigned ldsw = (unsigned)wid * 1024u;
    const int aoff = lds_byte(wr * 64 + fr, fq * 8), boff = lds_byte(wc * 32 + fr, fq * 8);
#define PG8_SA(b, h) (((b) * 2 + (h)) * HTB)
#define PG8_SB(b, h) ((4 + (b) * 2 + (h)) * HTB)
#define PG8_STAGE(bufoff, gbase, voff) do { _Pragma("unroll") for (int _i = 0; _i < 2; ++_i) \
        __builtin_amdgcn_global_load_lds((const unsigned*)((const char*)(gbase) + (voff)[_i]), (PG8_LAS unsigned*)(lds + (bufoff) + ldsw + _i * 8192), 16, 0, 0); } while (0)
#define PG8_LDA(dst, b, h) do { _Pragma("unroll") for (int m = 0; m < 4; ++m) _Pragma("unroll") for (int k = 0; k < 2; ++k) dst[m][k] = *(const PG8_LAS bf16x8*)(lds + PG8_SA(b, h) + aoff + m * 2048 + k * 1024); } while (0)
#define PG8_LDB(dst, b, h) do { _Pragma("unroll") for (int n = 0; n < 2; ++n) _Pragma("unroll") for (int k = 0; k < 2; ++k) dst[n][k] = *(const PG8_LAS bf16x8*)(lds + PG8_SB(b, h) + boff + n * 2048 + k * 1024); } while (0)
#define PG8_MMA(ai, bj, At, Bt) do { __builtin_amdgcn_s_setprio(1); _Pragma("unroll") for (int m = 0; m < 4; ++m) _Pragma("unroll") for (int n = 0; n < 2; ++n) _Pragma("unroll") for (int k = 0; k < 2; ++k) \
        acc[ai][bj][m][n] = __builtin_amdgcn_mfma_f32_16x16x32_bf16(Bt[n][k], At[m][k], acc[ai][bj][m][n], 0, 0, 0); __builtin_amdgcn_s_setprio(0); } while (0)
#define PG8_WAIT_V(n) asm volatile("s_waitcnt vmcnt(" #n ")" ::: "memory")
#define PG8_WAIT_L(n) asm volatile("s_waitcnt lgkmcnt(" #n ")" ::: "memory")
#define PG8_BAR __builtin_amdgcn_s_barrier()
#define PG8_SCHED __builtin_amdgcn_sched_barrier(0)
    Unit cur, nxt; int ui = 0;
    if (!S.next(0, cur)) return;
    f32x4 acc[2][2][4][2];
#pragma unroll
    for (int a = 0; a < 2; ++a)
#pragma unroll
        for (int b = 0; b < 2; ++b)
#pragma unroll
            for (int m = 0; m < 4; ++m)
#pragma unroll
                for (int n = 0; n < 2; ++n) acc[a][b][m][n] = (f32x4){0.f, 0.f, 0.f, 0.f};
    bf16x8 At[4][2], B0[2][2], B1[2][2];
    const char* cA = S.pa(g, cur, tstep); const char* cB = S.pb(g, cur, tstep);
    S.a_ready(cur);
    if constexpr (SP2) {
        PG8_STAGE(PG8_SB(0, 0), cB, voffB); PG8_STAGE(PG8_SB(0, 1), cB + hstep, voffB); PG8_STAGE(PG8_SA(0, 0), cA, voffA); PG8_STAGE(PG8_SA(0, 1), cA + hstep, voffA);
        if (wr == 1) PG8_BAR;
        PG8_WAIT_V(2); PG8_BAR;
        PG8_STAGE(PG8_SB(1, 0), cB + kstep, voffB); PG8_STAGE(PG8_SA(1, 0), cA + kstep, voffA); PG8_STAGE(PG8_SB(1, 1), cB + hstep + kstep, voffB);
        PG8_WAIT_V(6); PG8_BAR;
    } else {
        PG8_STAGE(PG8_SB(0, 0), cB, voffB); PG8_STAGE(PG8_SA(0, 0), cA, voffA); PG8_STAGE(PG8_SB(0, 1), cB + hstep, voffB); PG8_STAGE(PG8_SA(0, 1), cA + hstep, voffA);
        if (wr == 1) PG8_BAR;
        PG8_WAIT_V(4); PG8_BAR;
        PG8_STAGE(PG8_SB(1, 0), cB + kstep, voffB); PG8_STAGE(PG8_SA(1, 0), cA + kstep, voffA); PG8_STAGE(PG8_SB(1, 1), cB + hstep + kstep, voffB);
        PG8_WAIT_V(6); PG8_BAR;
    }
    for (;;) {
        const bool has_next = S.next(ui + 1, nxt);
        const char* nA = has_next ? S.pa(g, nxt, tstep) : cA; const char* nB = has_next ? S.pb(g, nxt, tstep) : cB;
        for (int t = 0; t < nt; t += 2) {
            const bool last = (t == nt - 2);
            const char* a1 = cA + (size_t)(t + 1) * kstep;
            const char* a2 = last ? nA : cA + (size_t)(t + 2) * kstep; const char* b2 = last ? nB : cB + (size_t)(t + 2) * kstep;
            const char* a3 = a2 + kstep; const char* b3 = b2 + kstep;
            if (last && has_next) S.a_ready(nxt);
            if constexpr (SP2) {
            PG8_LDB(B0, 0, 0); PG8_LDB(B1, 0, 1); PG8_SCHED; PG8_LDA(At, 0, 0); PG8_STAGE(PG8_SA(1, 1), a1 + hstep, voffA);
            PG8_WAIT_V(8); PG8_WAIT_L(0); PG8_BAR; PG8_MMA(0, 0, At, B0); PG8_MMA(0, 1, At, B1); PG8_BAR; PG8_SCHED;
            PG8_LDA(At, 0, 1); PG8_STAGE(PG8_SB(0, 0), b2, voffB); PG8_STAGE(PG8_SB(0, 1), b2 + hstep, voffB); PG8_STAGE(PG8_SA(0, 0), a2, voffA);
            PG8_WAIT_V(8); PG8_WAIT_L(0); PG8_BAR; PG8_MMA(1, 0, At, B0); PG8_MMA(1, 1, At, B1); PG8_BAR; PG8_SCHED;
            PG8_LDB(B0, 1, 0); PG8_LDB(B1, 1, 1); PG8_SCHED; PG8_LDA(At, 1, 0); PG8_STAGE(PG8_SA(0, 1), a2 + hstep, voffA);
            PG8_WAIT_V(8); PG8_WAIT_L(0); PG8_BAR; PG8_MMA(0, 0, At, B0); PG8_MMA(0, 1, At, B1); PG8_BAR; PG8_SCHED;
            PG8_LDA(At, 1, 1); PG8_STAGE(PG8_SB(1, 0), b3, voffB); PG8_STAGE(PG8_SB(1, 1), b3 + hstep, voffB); PG8_STAGE(PG8_SA(1, 0), a3, voffA);
            PG8_WAIT_V(8); PG8_WAIT_L(0); PG8_BAR; PG8_MMA(1, 0, At, B0); PG8_MMA(1, 1, At, B1); PG8_BAR; PG8_SCHED;
            } else {
            PG8_LDB(B0, 0, 0); PG8_SCHED; PG8_LDA(At, 0, 0); PG8_STAGE(PG8_SA(1, 1), a1 + hstep, voffA);
            PG8_WAIT_L(8); PG8_BAR; PG8_WAIT_L(0); PG8_MMA(0, 0, At, B0); PG8_BAR; PG8_SCHED;
            PG8_LDB(B1, 0, 1); PG8_STAGE(PG8_SB(0, 0), b2, voffB);
            PG8_BAR; PG8_WAIT_L(0); PG8_MMA(0, 1, At, B1); PG8_BAR;
            PG8_LDA(At, 0, 1); PG8_STAGE(PG8_SA(0, 0), a2, voffA);
            PG8_BAR; PG8_WAIT_L(0); PG8_MMA(1, 0, At, B0); PG8_BAR; PG8_SCHED;
            PG8_STAGE(PG8_SB(0, 1), b2 + hstep, voffB);
            PG8_WAIT_V(6); PG8_BAR; PG8_MMA(1, 1, At, B1); PG8_BAR;
            PG8_LDB(B0, 1, 0); PG8_SCHED; PG8_LDA(At, 1, 0); PG8_STAGE(PG8_SA(0, 1), a2 + hstep, voffA);
            PG8_WAIT_L(8); PG8_BAR; PG8_WAIT_L(0); PG8_MMA(0, 0, At, B0); PG8_BAR; PG8_SCHED;
            PG8_LDB(B1, 1, 1); PG8_STAGE(PG8_SB(1, 0), b3, voffB);
            PG8_BAR; PG8_WAIT_L(0); PG8_MMA(0, 1, At, B1); PG8_BAR;
            PG8_LDA(At, 1, 1); PG8_STAGE(PG8_SA(1, 0), a3, voffA);
            PG8_BAR; PG8_WAIT_L(0); PG8_MMA(1, 0, At, B0); PG8_BAR; PG8_SCHED;
            PG8_STAGE(PG8_SB(1, 1), b3 + hstep, voffB);
            PG8_WAIT_V(6); PG8_BAR; PG8_MMA(1, 1, At, B1); PG8_BAR;
            }
        }
        if constexpr (ALIGN_EPI) { if (wr == 0) PG8_BAR; }
        if constexpr (!Epi::AFTER_DRAIN) { E(acc, cur, wr, wc, fr, fq); S.done(cur); }
        if (!has_next) break;
#pragma unroll
        for (int a = 0; a < 2; ++a)
#pragma unroll
            for (int b = 0; b < 2; ++b)
#pragma unroll
                for (int m = 0; m < 4; ++m)
#pragma unroll
                    for (int n = 0; n < 2; ++n) acc[a][b][m][n] = (f32x4){0.f, 0.f, 0.f, 0.f};
        cur = nxt; cA = nA; cB = nB; ++ui;
        if constexpr (ALIGN_EPI) { if (wr == 1) PG8_BAR; }
    }
    PG8_WAIT_V(0);
    if constexpr (!ALIGN_EPI) { if (wr == 0) PG8_BAR; }
    PG8_BAR;
    if constexpr (Epi::AFTER_DRAIN) { E.fused(acc, cur, wr, wc, fr, fq, lds, wid, lane); S.done(cur); }
#undef PG8_SA
#undef PG8_SB
#undef PG8_STAGE
#undef PG8_LDA
#undef PG8_LDB
#undef PG8_MMA
#undef PG8_WAIT_V
#undef PG8_WAIT_L
#undef PG8_BAR
#undef PG8_SCHED
}
}

constexpr int NB = 16, SEQ = 2048, DM = 1024, MTOK = NB * SEQ, DEPTH = 2;
constexpr int P_IN = 3608, FFH = 2816, UL = 2816, NTR = 1024;
constexpr int C_SZ = 0, C_SX = 256, C_SB = 512, C_SC = 768, C_NQ = 1024, C_NK = 1280, C_MQ = 1536, C_MK = 1792, C_MV = 2048, C_MO = 2304, C_G = 2560;
constexpr int TP = MTOK + 128;
constexpr int R_HY = 0, R_NV = 768;
constexpr float EPS = 1e-6f;
constexpr int NWAVES = 8, NTHR = 512;
constexpr size_t MiB = 1u << 20;
constexpr size_t WS_CTL = 0, WS_SS = 64 * 1024, CTL_ZERO_BYTES = 64 * 1024 + 5 * 131072;
constexpr size_t WS_MOD = 1 * MiB, WS_HID2 = 2 * MiB, WS_DT = 3 * MiB, WS_FILT = 4 * MiB, WS_W = 12 * MiB;
constexpr size_t W_IN_OFF = 0, W_HY_OFF = 5 * MiB + MiB / 2, W_OUT_OFF = 7 * MiB + MiB / 2, W_GU_OFF = 9 * MiB + MiB / 2, W_DN_OFF = 20 * MiB + MiB / 2, W_LAYER = 26 * MiB;
constexpr size_t WS_XN = 64 * MiB, WS_U = 128 * MiB, WS_UHT = 320 * MiB, WS_YS = 386 * MiB, WS_NAO = 418 * MiB, WS_MLH = 434 * MiB, WS_HYO = 466 * MiB, WS_CV = 484 * MiB, WS_END = 486 * MiB;
constexpr size_t WS_XN2 = WS_UHT;
constexpr int CVP = 9472;
constexpr int LDS_BYTES = 147456, MISC_OFF = 147456 - 128;

#define GAS __attribute__((address_space(1)))
#define LAS __attribute__((address_space(3)))
typedef unsigned short bf16;
typedef unsigned v4u __attribute__((ext_vector_type(4)));
typedef float f32x4 __attribute__((ext_vector_type(4)));
typedef __bf16 bf16v2 __attribute__((ext_vector_type(2)));
typedef float f32v2 __attribute__((ext_vector_type(2)));
__device__ __forceinline__ unsigned pk2(float lo, float hi) { const f32v2 v = {lo, hi}; return __builtin_bit_cast(unsigned, __builtin_convertvector(v, bf16v2)); }
__device__ __forceinline__ unsigned f2bf(float f) { return (unsigned)__builtin_bit_cast(unsigned short, (__bf16)f); }
__device__ __forceinline__ float bf2f(unsigned h) { return __builtin_bit_cast(float, h << 16); }
__device__ __forceinline__ float bflo(unsigned w) { return __builtin_bit_cast(float, w << 16); }
__device__ __forceinline__ float bfhi(unsigned w) { return __builtin_bit_cast(float, w & 0xffff0000u); }
__device__ __forceinline__ float wave_sum(float v) {
#pragma unroll
    for (int o = 1; o < 64; o <<= 1) v += __shfl_xor(v, o);
    return v;
}
__device__ __forceinline__ float wave_max(float v) {
#pragma unroll
    for (int o = 1; o < 64; o <<= 1) v = fmaxf(v, __shfl_xor(v, o));
    return v;
}
__device__ __forceinline__ float sigmoid_f(float v) { return 1.0f / (1.0f + __expf(-v)); }
__device__ __forceinline__ float silu_ff(float v) { return v / (1.0f + __expf(-v)); }
__device__ __forceinline__ float softplus_f(float v) { return v > 20.f ? v : log1pf(__expf(v)); }

__device__ __forceinline__ int fresh_tid(int wave0) { unsigned z = 0u; asm volatile("" : "+v"(z)); const int l = (int)__builtin_amdgcn_mbcnt_hi(~0u, __builtin_amdgcn_mbcnt_lo(~0u, z)); return (wave0 << 6) | l; }
typedef short bf16x8 __attribute__((ext_vector_type(8)));
#define MFMA16(a, b, c) __builtin_amdgcn_mfma_f32_16x16x32_bf16((a), (b), (c), 0, 0, 0)
struct Args { const float* in[31]; float* out; unsigned char* ws; int ph_lo, ph_hi; };

struct Ctx {
    LAS unsigned char* lds;
    int tid, lane, wave, bid, G, wave0;
    const Args* A; float* out; unsigned char* ws;
};
#define INP(i) (F.A->in[i])

__device__ __forceinline__ const float* wsrc(const Ctx& F, int which, int l, int j, int* ld) {
    if (which == 0) { *ld = P_IN; const float* w = INP(4) + (size_t)l * DM * P_IN;
        int o; if (j < 1024) o = j; else if (j < 1536) o = 1032 + (j - 1024); else if (j < 2560) o = 1800 + (j - 1536); else if (j < 2568) o = 1024 + (j - 2560); else if (j < 2584) o = 2824 + (j - 2568); else return nullptr;
        return w + o; }
    if (which == 1) { *ld = P_IN; return INP(4) + (size_t)l * DM * P_IN + (j < 768 ? 2840 + j : 1544 + (j - 768)); }
    if (which == 2) { *ld = DM; return INP(26) + (size_t)l * DM * DM + j; }
    if (which == 3) { *ld = FFH; const int t = j >> 8, w = j & 255; return (w < 128 ? INP(27) : INP(28)) + (size_t)l * DM * FFH + t * 128 + (w & 127); }
    *ld = DM; return INP(29) + (size_t)l * FFH * DM + j;
}
__device__ __forceinline__ void transpose_item(const Ctx& F, int which, int l, int K, bf16* WT, LAS float* scr, int item, int nblk) {
    const int lane = F.lane, kb = item / nblk, nb = item % nblk, k0 = 64 * kb, n0 = 32 * nb;
    int ld = 0; const float* cp = wsrc(F, which, l, n0 + (lane & 31), &ld);
    float tv[32];
#pragma unroll
    for (int i = 0; i < 32; ++i) { const int kk = 2 * i + (lane >> 5); tv[i] = cp ? cp[(size_t)(k0 + kk) * ld] : 0.f; }
#pragma unroll
    for (int i = 0; i < 32; ++i) { const int kk = 2 * i + (lane >> 5); scr[kk * 33 + (lane & 31)] = tv[i]; }
    asm volatile("s_waitcnt lgkmcnt(0)" ::: "memory");
    const int c = lane & 7;
#pragma unroll
    for (int j = 0; j < 4; ++j) { const int n = (lane >> 3) + 8 * j; const LAS float* s = scr + (8 * c) * 33 + n;
        v4u o; o.x = pk2(s[0 * 33], s[1 * 33]); o.y = pk2(s[2 * 33], s[3 * 33]); o.z = pk2(s[4 * 33], s[5 * 33]); o.w = pk2(s[6 * 33], s[7 * 33]);
        *(v4u*)(WT + (size_t)(n0 + n) * K + k0 + 8 * c) = o; }
    asm volatile("s_waitcnt lgkmcnt(0)" ::: "memory");
}
__device__ __forceinline__ void ph_prologue(Ctx& F) {
    const int gw = F.bid * NWAVES + F.wave, NGW = F.G * NWAVES, lane = F.lane;
    LAS float* scr = (LAS float*)(F.lds + F.wave * 16384);
    constexpr int I_IN = 16 * 88, I_HY = 16 * 32, I_OUT = 16 * 32, I_GU = 16 * 176, I_DN = 44 * 32, I_L = I_IN + I_HY + I_OUT + I_GU + I_DN;
    for (int it = gw; it < DEPTH * I_L; it += NGW) {
        const int l = it / I_L; int r = it % I_L; unsigned char* wb = F.ws + WS_W + (size_t)l * W_LAYER;
        if (r < I_IN) { transpose_item(F, 0, l, DM, (bf16*)(wb + W_IN_OFF), scr, r, 88); continue; } r -= I_IN;
        if (r < I_HY) { transpose_item(F, 1, l, DM, (bf16*)(wb + W_HY_OFF), scr, r, 32); continue; } r -= I_HY;
        if (r < I_OUT) { transpose_item(F, 2, l, DM, (bf16*)(wb + W_OUT_OFF), scr, r, 32); continue; } r -= I_OUT;
        if (r < I_GU) { transpose_item(F, 3, l, DM, (bf16*)(wb + W_GU_OFF), scr, r, 176); continue; } r -= I_GU;
        transpose_item(F, 4, l, FFH, (bf16*)(wb + W_DN_OFF), scr, r, 32);
    }
    for (int it = gw; it < DEPTH * SEQ; it += NGW) {
        const int l = it / SEQ, pos = it % SEQ;
        const float* w1 = INP(18) + l * 33 * 64; const float* b1 = INP(19) + l * 64; const float* w2 = INP(20) + l * 64 * 64; const float* b2 = INP(21) + l * 64; const float* fq = INP(23) + l * 128;
        const float t = (float)pos / 2047.0f;
        float z = b1[lane] + t * w1[lane];
        const float a = 6.283185307179586f * ((float)pos / 2048.0f);
#pragma unroll
        for (int i = 0; i < 16; ++i) { const float f = 1e-4f + (float)i * ((15.0f - 1e-4f) / 15.0f); const float ang = a * f;
            z += cosf(ang) * w1[(1 + i) * 64 + lane]; z -= sinf(ang) * w1[(17 + i) * 64 + lane]; }
        const float h1 = sinf(fq[lane] * z);
        float z2 = b2[lane];
        for (int i = 0; i < 64; ++i) z2 += __shfl(h1, i) * w2[i * 64 + lane];
        const float h2 = sinf(fq[64 + lane] * z2);
        ((float*)(F.ws + WS_HID2))[(size_t)it * 64 + lane] = h2;
    }
    __syncthreads();
    LAS float* cond = (LAS float*)F.lds; LAS float* part = (LAS float*)(F.lds + 65536);
    if (F.bid < 192) {
        for (int i = F.tid; i < NB * DM; i += NTHR) cond[i] = silu_ff(INP(1)[i]);
        __syncthreads();
        for (int it = F.bid; it < 192; it += F.G) {
            const int l = it / 96, n0 = (it % 96) * 64;
            const float* W = INP(2) + (size_t)l * DM * 6144 + n0 + lane;
            float acc[16];
#pragma unroll
            for (int b = 0; b < 16; ++b) acc[b] = 0.f;
            const int kb = F.wave * 128;
            for (int k8 = 0; k8 < 128; k8 += 16) { float wv[16];
#pragma unroll
                for (int j = 0; j < 16; ++j) wv[j] = W[(size_t)(kb + k8 + j) * 6144];
#pragma unroll
                for (int j = 0; j < 16; ++j)
#pragma unroll
                    for (int b = 0; b < 16; ++b) acc[b] += cond[b * DM + kb + k8 + j] * wv[j]; }
#pragma unroll
            for (int b = 0; b < 16; ++b) part[(F.wave * 16 + b) * 64 + lane] = acc[b];
            __syncthreads();
            for (int o = F.tid; o < 1024; o += NTHR) { const int b = o >> 6, cidx = o & 63; float s = INP(3)[l * 6144 + n0 + cidx];
#pragma unroll
                for (int w = 0; w < 8; ++w) s += part[(w * 16 + b) * 64 + cidx];
                ((float*)(F.ws + WS_MOD))[(size_t)(l * NB + b) * 6144 + n0 + cidx] = s; }
            __syncthreads();
        }
    }
}

__device__ __forceinline__ void ph_xn0(Ctx& F, const float* mod_l) {
    const int gw = F.bid * NWAVES + F.wave, NGW = F.G * NWAVES;
    bf16* XN = (bf16*)(F.ws + WS_XN); float* ss = (float*)(F.ws + WS_SS);
    for (int m0 = gw * 4; m0 < MTOK; m0 += NGW * 4) {
        f32x4 v[4][4], sc[4][4];
#pragma unroll
        for (int u = 0; u < 4; ++u) { const int m = m0 + u; const f32x4* xr = (const f32x4*)(INP(0) + (size_t)m * DM) + F.lane; const float* mb = mod_l + (size_t)(m >> 11) * 6144 + 1024;
#pragma unroll
            for (int j = 0; j < 4; ++j) { v[u][j] = xr[64 * j]; sc[u][j] = *((const f32x4*)mb + F.lane + 64 * j); } }
#pragma unroll
        for (int u = 0; u < 4; ++u) { const int m = m0 + u; float s = 0.f;
#pragma unroll
            for (int j = 0; j < 4; ++j) s += (v[u][j].x * v[u][j].x + v[u][j].y * v[u][j].y) + (v[u][j].z * v[u][j].z + v[u][j].w * v[u][j].w);
            s = wave_sum(s); if (F.lane == 0) ss[m] = s;
            unsigned long long* o8 = (unsigned long long*)(XN + (size_t)m * DM) + F.lane;
#pragma unroll
            for (int j = 0; j < 4; ++j) o8[64 * j] = (unsigned long long)pk2(v[u][j].x * (1.f + sc[u][j].x), v[u][j].y * (1.f + sc[u][j].y)) | ((unsigned long long)pk2(v[u][j].z * (1.f + sc[u][j].z), v[u][j].w * (1.f + sc[u][j].w)) << 32); }
    }
}
__device__ __forceinline__ void ph_final(Ctx& F) {
    const float* g = INP(30); const float* ss = (const float*)(F.ws + WS_SS) + 4 * MTOK;
    const int gt = F.bid * NTHR + F.tid, NT = F.G * NTHR;
    for (int i0 = gt; i0 < MTOK * (DM / 4); i0 += 8 * NT) { f32x4 xv[8]; float sv[8];
#pragma unroll
        for (int u = 0; u < 8; ++u) { const int i = i0 + u * NT; xv[u] = ((const f32x4*)F.out)[i]; sv[u] = ss[i >> 8]; }
#pragma unroll
        for (int u = 0; u < 8; ++u) { const int i = i0 + u * NT; ((f32x4*)F.out)[i] = xv[u] * (1.0f / sqrtf(sv[u] * (1.f / DM) + EPS)) * *((const f32x4*)g + (i & 255)); } }
}
__device__ __forceinline__ void ph_cvec(Ctx& F) {
    const int gw = F.bid * NWAVES + F.wave, NGW = F.G * NWAVES, lane = F.lane, fr = lane & 15, fg = lane >> 4;
    for (int it = gw; it < DEPTH * (CVP / 16); it += NGW) {
        const int l = it / (CVP / 16), n0 = (it % (CVP / 16)) * 16; unsigned char* wb = F.ws + WS_W + (size_t)l * W_LAYER;
        const bf16* wt = n0 < 2816 ? (const bf16*)(wb + W_IN_OFF) + (size_t)n0 * DM : n0 < 3840 ? (const bf16*)(wb + W_HY_OFF) + (size_t)(n0 - 2816) * DM : (const bf16*)(wb + W_GU_OFF) + (size_t)(n0 - 3840) * DM;
        const float* sh = (const float*)(F.ws + WS_MOD) + (size_t)(l * NB + fr) * 6144 + (n0 < 3840 ? 0 : 3072) + 8 * fg;
        const bf16* wp = wt + (size_t)fr * DM + 8 * fg;
        f32x4 acc = (f32x4){0.f, 0.f, 0.f, 0.f};
#pragma unroll 8
        for (int ks = 0; ks < 32; ++ks) { const f32x4 a0 = *(const f32x4*)(sh + 32 * ks), a1 = *(const f32x4*)(sh + 32 * ks + 4);
            v4u aw; aw[0] = pk2(a0[0], a0[1]); aw[1] = pk2(a0[2], a0[3]); aw[2] = pk2(a1[0], a1[1]); aw[3] = pk2(a1[2], a1[3]);
            acc = MFMA16(__builtin_bit_cast(bf16x8, aw), *(const bf16x8*)(wp + 32 * ks), acc); }
        float* cvo = (float*)(F.ws + WS_CV) + (size_t)l * NB * CVP + n0 + fr;
#pragma unroll
        for (int r = 0; r < 4; ++r) cvo[(size_t)(4 * fg + r) * CVP] = acc[r];
    }
}

__device__ __forceinline__ void ph_filters(Ctx& F) {
    const int lane = F.lane, fr = lane & 15, fg = lane >> 4, w = F.wave;
    for (int it = F.bid; it < DEPTH * 2 * 32; it += F.G) {
        const int l = it >> 6, o = (it >> 5) & 1, co = it & 31;
        const int dir = fr >> 3, ch = co * 8 + (fr & 7);
        const float* w3 = INP(22) + (size_t)l * 64 * 1024 + o * 512 + dir * 256 + ch;
        bf16x8 bw[2], bwl[2];
#pragma unroll
        for (int ks = 0; ks < 2; ++ks) { v4u pw, pl;
#pragma unroll
            for (int e = 0; e < 4; ++e) { const float x0 = w3[(size_t)(32 * ks + 8 * fg + 2 * e) * 1024], x1 = w3[(size_t)(32 * ks + 8 * fg + 2 * e + 1) * 1024];
                pw[e] = pk2(x0, x1); pl[e] = pk2(x0 - bflo(pw[e]), x1 - bfhi(pw[e])); }
            bw[ks] = __builtin_bit_cast(bf16x8, pw); bwl[ks] = __builtin_bit_cast(bf16x8, pl); }
        const float delta = 3.0701134573253945f + (float)ch * ((15.350567286626972f - 3.0701134573253945f) / 255.0f);
        const float* hid = (const float*)(F.ws + WS_HID2) + (size_t)l * SEQ * 64 + (size_t)(256 * w + fr) * 64 + 8 * fg;
        float ss = 0.f;
        LAS f32x4* vals = (LAS f32x4*)F.lds + (size_t)w * 16 * 64 + lane;
#pragma unroll 2
        for (int ii = 0; ii < 16; ++ii) { const float* hp = hid + (size_t)(16 * ii) * 64;
            const f32x4 h0 = *(const f32x4*)hp, h1 = *(const f32x4*)(hp + 4), h2 = *(const f32x4*)(hp + 32), h3 = *(const f32x4*)(hp + 36);
            v4u pa, pb, qa, qb;
#pragma unroll
            for (int e = 0; e < 2; ++e) { pa[e] = pk2(h0[2 * e], h0[2 * e + 1]); pa[2 + e] = pk2(h1[2 * e], h1[2 * e + 1]); pb[e] = pk2(h2[2 * e], h2[2 * e + 1]); pb[2 + e] = pk2(h3[2 * e], h3[2 * e + 1]);
                qa[e] = pk2(h0[2 * e] - bflo(pa[e]), h0[2 * e + 1] - bfhi(pa[e])); qa[2 + e] = pk2(h1[2 * e] - bflo(pa[2 + e]), h1[2 * e + 1] - bfhi(pa[2 + e]));
                qb[e] = pk2(h2[2 * e] - bflo(pb[e]), h2[2 * e + 1] - bfhi(pb[e])); qb[2 + e] = pk2(h3[2 * e] - bflo(pb[2 + e]), h3[2 * e + 1] - bfhi(pb[2 + e])); }
            f32x4 a = (f32x4){0.f, 0.f, 0.f, 0.f};
            a = MFMA16(__builtin_bit_cast(bf16x8, qa), bw[0], a); a = MFMA16(__builtin_bit_cast(bf16x8, qb), bw[1], a);
            a = MFMA16(__builtin_bit_cast(bf16x8, pa), bwl[0], a); a = MFMA16(__builtin_bit_cast(bf16x8, pb), bwl[1], a);
            a = MFMA16(__builtin_bit_cast(bf16x8, pa), bw[0], a); a = MFMA16(__builtin_bit_cast(bf16x8, pb), bw[1], a);
#pragma unroll
            for (int r = 0; r < 4; ++r) { const int p = 256 * w + 16 * ii + 4 * fg + r; a[r] *= __expf(-((float)p / 2047.0f) * delta); ss += a[r] * a[r]; }
            vals[ii * 64] = a; }
        ss += __shfl_xor(ss, 8); ss += __shfl_xor(ss, 16); ss += __shfl_xor(ss, 32);
        LAS float* red = (LAS float*)(F.lds + 131072);
        __syncthreads();
        if (lane < 8) red[w * 8 + lane] = ss;
        __syncthreads();
        float tot = 0.f;
#pragma unroll
        for (int q = 0; q < 8; ++q) tot += red[q * 8 + (fr & 7)];
        const float scale = 1.0f / sqrtf(tot + EPS);
        bf16* fo = (bf16*)(F.ws + WS_FILT) + ((size_t)((l * 2 + o) * 256 + ch)) * 4096 + 2048;
#pragma unroll 2
        for (int ii = 0; ii < 16; ++ii) { const f32x4 a = vals[ii * 64];
#pragma unroll
            for (int r = 0; r < 4; ++r) { const int p = 256 * w + 16 * ii + 4 * fg + r; const unsigned short v = (unsigned short)f2bf(a[r] * scale);
                const bool unused = dir == 1 && p == 0;
                fo[unused ? -2048 : (dir == 0 ? -p : p)] = unused ? (unsigned short)0 : v; } }
    }
}

__device__ __forceinline__ void ph_prepass(Ctx& F, int l) {
    const bf16* U = (const bf16*)(F.ws + WS_U); bf16* XBC = (bf16*)(F.ws + WS_XN); float* DT = (float*)(F.ws + WS_DT);
    const float* cw = INP(5) + l * 3 * 768; const float* cb = INP(6) + l * 768; const float* dtb = INP(7) + l * 8;
    const int gt = F.bid * NTHR + F.tid, NT = F.G * NTHR;
    for (int it0 = gt; it0 < MTOK * 96; it0 += 4 * NT) {
        v4u um[4], u0[4], upn[4];
#pragma unroll
        for (int u = 0; u < 4; ++u) { const int it = it0 + u * NT, tok = it / 96, cg = it % 96; const bf16* up = U + (size_t)tok * UL + C_SX + cg * 8;
            um[u] = *(const v4u*)(up - UL); u0[u] = *(const v4u*)up; upn[u] = *(const v4u*)(up + UL); }
#pragma unroll
        for (int u = 0; u < 4; ++u) { const int it = it0 + u * NT, tok = it / 96, cg = it % 96, t = tok & (SEQ - 1), c0 = cg * 8;
            const v4u z4 = {0u, 0u, 0u, 0u}; const v4u a = t > 0 ? um[u] : z4, b = u0[u], cc = t < SEQ - 1 ? upn[u] : z4;
            float r[8];
#pragma unroll
            for (int q = 0; q < 4; ++q) {
                const int c = c0 + 2 * q;
                const float a0 = cw[c] * bflo(a[q]) + cw[768 + c] * bflo(b[q]) + cw[1536 + c] * bflo(cc[q]) + cb[c];
                const float a1 = cw[c + 1] * bfhi(a[q]) + cw[768 + c + 1] * bfhi(b[q]) + cw[1536 + c + 1] * bfhi(cc[q]) + cb[c + 1];
                r[2 * q] = silu_ff(a0); r[2 * q + 1] = silu_ff(a1); }
            v4u o; o.x = pk2(r[0], r[1]); o.y = pk2(r[2], r[3]); o.z = pk2(r[4], r[5]); o.w = pk2(r[6], r[7]);
            *(v4u*)(XBC + (size_t)tok * 768 + c0) = o; }
    }
    for (int it = gt; it < MTOK * 8; it += NT) { const int tok = it >> 3, j = it & 7;
        DT[it] = softplus_f(bf2f(U[(size_t)tok * UL + C_G + j]) + dtb[j]); }
}

typedef short s16x4 __attribute__((ext_vector_type(4)));
typedef unsigned u2v __attribute__((ext_vector_type(2)));
__device__ __forceinline__ bf16x8 lds_b128(LAS unsigned char* p) { return *(LAS bf16x8*)p; }
__device__ __forceinline__ bf16x8 lds_tr8(LAS unsigned char* base, int pitch, int lane) {
    const int fg = lane >> 4, q = (lane & 15) >> 2, p = lane & 3;
    LAS unsigned char* a = base + (8 * fg + q) * pitch + 8 * p;
    const s16x4 lo = __builtin_amdgcn_ds_read_tr16_b64_v4i16((LAS s16x4*)a);
    const s16x4 hi = __builtin_amdgcn_ds_read_tr16_b64_v4i16((LAS s16x4*)(a + 4 * pitch));
    bf16x8 r; r[0] = lo[0]; r[1] = lo[1]; r[2] = lo[2]; r[3] = lo[3]; r[4] = hi[0]; r[5] = hi[1]; r[6] = hi[2]; r[7] = hi[3]; return r;
}
__device__ __forceinline__ float wave_incl_sum(float a, int lane) {
#pragma unroll
    for (int o = 1; o < 64; o <<= 1) { const float t = __shfl_up(a, o); if (lane >= o) a += t; }
    return a;
}
__device__ __forceinline__ float wave_incl_max(float a, int lane) {
#pragma unroll
    for (int o = 1; o < 64; o <<= 1) { const float t = __shfl_up(a, o); if (lane >= o) a = fmaxf(a, t); }
    return a;
}
constexpr int SP_C = 272, SP_X = 144;
constexpr int SB_CS = 0, SB_BS = 17408, SB_XD = 34816, SB_XW = 44032, SB_SIZE = 53248, S_SC = 106496, S_SBF = 115712;
__device__ __forceinline__ void ssd_item(Ctx& F, int l, int it) {
    const int b = it >> 3, dir = (it >> 2) & 1, h = it & 3, grp = h >> 1;
    const int tid = F.tid, lane = F.lane, w = F.wave, fr = lane & 15, fg = lane >> 4, tb = w >> 1, half = w & 1;
    const bf16* XBC = (const bf16*)(F.ws + WS_XN); const float* DT = (const float*)(F.ws + WS_DT);
    bf16* YS = (bf16*)(F.ws + WS_YS) + (size_t)dir * MTOK * 256;
    const float A = -__expf(INP(8)[l * 8 + dir * 4 + h]); const float Dk = dir == 0 ? INP(9)[l * 4 + h] : 0.f;
    LAS unsigned char* L = F.lds;
#define SSD_TOK(c, tau) ((size_t)b * SEQ + (dir ? SEQ - 1 - ((c) * 64 + (tau)) : (c) * 64 + (tau)))
    f32x4 sacc[4];
#pragma unroll
    for (int i = 0; i < 4; ++i) sacc[i] = (f32x4){0.f, 0.f, 0.f, 0.f};
    for (int i = tid; i < 17408 / 16; i += NTHR) *(LAS v4u*)(L + S_SBF + 16 * i) = (v4u){0u, 0u, 0u, 0u};
    v4u pc0[2], pbv0[2], px0, pc1[2], pbv1[2], px1; float pdt0, pdt1;
#define SSD_LOAD(c, S) do { \
        _Pragma("unroll") for (int k = 0; k < 2; ++k) { const int idx = tid + 512 * k, tau = idx >> 4, ch = idx & 15; const bf16* rp = XBC + SSD_TOK(c, tau) * 768 + grp * 128 + 8 * ch; \
            pbv##S[k] = *(const v4u*)(rp + 256); pc##S[k] = *(const v4u*)(rp + 512); } \
        { const int tau = tid >> 3, ch = tid & 7; px##S = *(const v4u*)(XBC + SSD_TOK(c, tau) * 768 + h * 64 + 8 * ch); } \
        pdt##S = DT[SSD_TOK(c, lane) * 8 + dir * 4 + h]; } while (0)
#define SSD_STAGE(bo, dtv, acum, alast, S) do { \
        _Pragma("unroll") for (int k = 0; k < 2; ++k) { const int idx = tid + 512 * k, tau = idx >> 4, ch = idx & 15; \
            *(LAS v4u*)(L + (bo) + SB_BS + tau * SP_C + ch * 16) = pbv##S[k]; *(LAS v4u*)(L + (bo) + SB_CS + tau * SP_C + ch * 16) = pc##S[k]; } \
        { const int tau = tid >> 3, ch = tid & 7; const float dts = __shfl(dtv, tau), es = __expf((alast) - __shfl(acum, tau)) * dts; v4u od, ow; \
          _Pragma("unroll") for (int e = 0; e < 4; ++e) { const float x0 = bflo(px##S[e]), x1 = bfhi(px##S[e]); od[e] = pk2(x0 * dts, x1 * dts); ow[e] = pk2(x0 * es, x1 * es); } \
          *(LAS v4u*)(L + (bo) + SB_XD + tau * SP_X + ch * 16) = od; *(LAS v4u*)(L + (bo) + SB_XW + tau * SP_X + ch * 16) = ow; } } while (0)
#define SSD_CHUNK(c, CS, NS) do { \
        const int bo = ((c) & 1) * SB_SIZE; \
        __syncthreads();                                                       \
        if ((c) + 2 < 32) SSD_LOAD((c) + 2, CS); \
        bf16x8 ca[4]; \
        _Pragma("unroll") for (int ks = 0; ks < 4; ++ks) ca[ks] = lds_b128(L + bo + SB_CS + (16 * tb + fr) * SP_C + (32 * ks + 8 * fg) * 2); \
        f32x4 yoff[2];                                                         \
        _Pragma("unroll") for (int pbi = 0; pbi < 2; ++pbi) { yoff[pbi] = (f32x4){0.f, 0.f, 0.f, 0.f}; \
            _Pragma("unroll") for (int ks = 0; ks < 4; ++ks) yoff[pbi] = MFMA16(lds_b128(L + S_SBF + (16 * (2 * half + pbi) + fr) * SP_C + (32 * ks + 8 * fg) * 2), ca[ks], yoff[pbi]); } \
        const int tlc = 16 * tb + fr; const float atc = __shfl(acum, tlc), dtc = __shfl(dtv, tlc); \
        _Pragma("unroll") for (int sbi = 0; sbi < 2; ++sbi) { const int sb = 2 * half + sbi; f32x4 g = (f32x4){0.f, 0.f, 0.f, 0.f};     \
            if (sb <= tb) { \
                _Pragma("unroll") for (int ks = 0; ks < 4; ++ks) g = MFMA16(lds_b128(L + bo + SB_BS + (16 * sb + fr) * SP_C + (32 * ks + 8 * fg) * 2), ca[ks], g); } \
            float sv[4]; \
            _Pragma("unroll") for (int r = 0; r < 4; ++r) { const int sl = 16 * sb + 4 * fg + r; const float as_ = __shfl(acum, sl); \
                float v = sl <= tlc ? g[r] * __expf(atc - as_) : 0.f; if (sl == tlc) v += Dk / dtc; sv[r] = v; } \
            u2v so; so.x = pk2(sv[0], sv[1]); so.y = pk2(sv[2], sv[3]); *(LAS u2v*)(L + S_SC + tlc * SP_X + (16 * sb + 4 * fg) * 2) = so; } \
        { const float dec = __expf(alast); \
          _Pragma("unroll") for (int i = 0; i < 4; ++i) sacc[i] *= dec; \
          _Pragma("unroll") for (int ks = 0; ks < 2; ++ks) { const bf16x8 af = lds_tr8(L + bo + SB_BS + (32 * ks) * SP_C + (16 * w) * 2, SP_C, lane); \
              _Pragma("unroll") for (int pb = 0; pb < 4; ++pb) sacc[pb] = MFMA16(af, lds_tr8(L + bo + SB_XW + (32 * ks) * SP_X + (16 * pb) * 2, SP_X, lane), sacc[pb]); } } \
        __syncthreads();                                                       \
        { const float eat = __expf(atc); \
        _Pragma("unroll") for (int pbi = 0; pbi < 2; ++pbi) { const int pb = 2 * half + pbi; f32x4 yd = (f32x4){0.f, 0.f, 0.f, 0.f}; \
            _Pragma("unroll") for (int ks = 0; ks < 2; ++ks) yd = MFMA16(lds_tr8(L + bo + SB_XD + (32 * ks) * SP_X + (16 * pb) * 2, SP_X, lane), lds_b128(L + S_SC + (16 * tb + fr) * SP_X + (32 * ks + 8 * fg) * 2), yd); \
            u2v yo; yo.x = pk2(yd[0] + eat * yoff[pbi][0], yd[1] + eat * yoff[pbi][1]); yo.y = pk2(yd[2] + eat * yoff[pbi][2], yd[3] + eat * yoff[pbi][3]); \
            *(u2v*)(YS + SSD_TOK(c, tlc) * 256 + h * 64 + 16 * pb + 4 * fg) = yo; } } \
        _Pragma("unroll") for (int pb = 0; pb < 4; ++pb) { u2v o; o.x = pk2(sacc[pb][0], sacc[pb][1]); o.y = pk2(sacc[pb][2], sacc[pb][3]); \
            *(LAS u2v*)(L + S_SBF + (16 * pb + fr) * SP_C + (16 * w + 4 * fg) * 2) = o; } \
        if ((c) + 1 < 32) { dtv = pdt##NS; acum = wave_incl_sum(pdt##NS * A, lane); alast = __shfl(acum, 63); SSD_STAGE((((c) + 1) & 1) * SB_SIZE, dtv, acum, alast, NS); } } while (0)
    SSD_LOAD(0, 0);
    float dtv = pdt0, acum = wave_incl_sum(pdt0 * A, lane), alast = __shfl(acum, 63);
    SSD_STAGE(0, dtv, acum, alast, 0);
    SSD_LOAD(1, 1);
    for (int c2 = 0; c2 < 32; c2 += 2) { SSD_CHUNK(c2, 0, 1); SSD_CHUNK(c2 + 1, 1, 0); }
    __syncthreads();
#undef SSD_CHUNK
#undef SSD_LOAD
#undef SSD_STAGE
#undef SSD_TOK
}
constexpr int MB_QS = 0, MB_KS = 9216, MB_KW = 18432, MB_VS = 27648, MB_SIZE = 36864, M_SC = 73728, M_CBF = 82944, M_NBF = 92160;
__device__ __forceinline__ void ml_item(Ctx& F, int l, int it) {
    const int b = it >> 3, dir = (it >> 2) & 1, h = it & 3;
    const int tid = F.tid, lane = F.lane, w = F.wave, fr = lane & 15, fg = lane >> 4, tb = w >> 1, half = w & 1;
    const bf16* U = (const bf16*)(F.ws + WS_U);
    bf16* MLH = (bf16*)(F.ws + WS_MLH) + (size_t)dir * MTOK * 256;
    const float ib = INP(13)[l * 8 + dir * 4 + h], fb = INP(14)[l * 8 + dir * 4 + h];
    LAS unsigned char* L = F.lds;
#define ML_TOK(c, tau) ((size_t)b * SEQ + (dir ? SEQ - 1 - ((c) * 64 + (tau)) : (c) * 64 + (tau)))
    f32x4 cacc[2], nacc = (f32x4){0.f, 0.f, 0.f, 0.f};
    cacc[0] = (f32x4){0.f, 0.f, 0.f, 0.f}; cacc[1] = (f32x4){0.f, 0.f, 0.f, 0.f};
    for (int i = tid; i < (M_NBF + 256 - M_CBF) / 16; i += NTHR) *(LAS v4u*)(L + M_CBF + 16 * i) = (v4u){0u, 0u, 0u, 0u};
    bf16x8 ones;
#pragma unroll
    for (int j = 0; j < 8; ++j) ones[j] = (short)0x3F80;
    v4u pq0, pk0, pv0, pq1, pk1, pv1; float pli0, plf0, pli1, plf1;
#define ML_LOAD(c, S) do { \
        { const int tau = tid >> 3, ch = tid & 7; const bf16* rp = U + ML_TOK(c, tau) * UL + h * 64 + 8 * ch; pq##S = *(const v4u*)(rp + C_MQ); pk##S = *(const v4u*)(rp + C_MK); pv##S = *(const v4u*)(rp + C_MV); } \
        { const bf16* gp = U + ML_TOK(c, lane) * UL + C_G + dir * 4 + h; pli##S = bf2f(gp[8]) + ib; plf##S = -softplus_f(-(bf2f(gp[16]) + fb)); } } while (0)
#define ML_STAGE(bo, av, Mlast, S) do { const int tau = tid >> 3, ch = tid & 7; const float ks = 0.125f * __expf(__shfl(av, tau) - (Mlast)); v4u ow; \
        _Pragma("unroll") for (int e = 0; e < 4; ++e) ow[e] = pk2(bflo(pk##S[e]) * ks, bfhi(pk##S[e]) * ks); \
        *(LAS v4u*)(L + (bo) + MB_QS + tau * SP_X + ch * 16) = pq##S; *(LAS v4u*)(L + (bo) + MB_KS + tau * SP_X + ch * 16) = pk##S; \
        *(LAS v4u*)(L + (bo) + MB_KW + tau * SP_X + ch * 16) = ow; *(LAS v4u*)(L + (bo) + MB_VS + tau * SP_X + ch * 16) = pv##S; } while (0)
#define ML_CHUNK(c, CS, NS) do { \
        const int bo = ((c) & 1) * MB_SIZE; \
        __syncthreads();                                                       \
        if ((c) + 2 < 32) ML_LOAD((c) + 2, CS); \
        bf16x8 qa[2]; \
        _Pragma("unroll") for (int ks = 0; ks < 2; ++ks) qa[ks] = lds_b128(L + bo + MB_QS + (16 * tb + fr) * SP_X + (32 * ks + 8 * fg) * 2); \
        f32x4 yint[2], dint = (f32x4){0.f, 0.f, 0.f, 0.f};                     \
        _Pragma("unroll") for (int ebi = 0; ebi < 2; ++ebi) { yint[ebi] = (f32x4){0.f, 0.f, 0.f, 0.f}; \
            _Pragma("unroll") for (int ks = 0; ks < 2; ++ks) yint[ebi] = MFMA16(lds_b128(L + M_CBF + (16 * (2 * half + ebi) + fr) * SP_X + (32 * ks + 8 * fg) * 2), qa[ks], yint[ebi]); } \
        _Pragma("unroll") for (int ks = 0; ks < 2; ++ks) dint = MFMA16(lds_b128(L + M_NBF + (32 * ks + 8 * fg) * 2), qa[ks], dint); \
        const int tlc = 16 * tb + fr; const float Mtc = __shfl(Mv, tlc), btc = __shfl(bcum, tlc); \
        _Pragma("unroll") for (int sbi = 0; sbi < 2; ++sbi) { const int sb = 2 * half + sbi; f32x4 g = (f32x4){0.f, 0.f, 0.f, 0.f}; \
            if (sb <= tb) { \
                _Pragma("unroll") for (int ks = 0; ks < 2; ++ks) g = MFMA16(lds_b128(L + bo + MB_KS + (16 * sb + fr) * SP_X + (32 * ks + 8 * fg) * 2), qa[ks], g); } \
            float sv[4]; \
            _Pragma("unroll") for (int r = 0; r < 4; ++r) { const int sl = 16 * sb + 4 * fg + r; const float as_ = __shfl(av, sl); \
                sv[r] = sl <= tlc ? g[r] * 0.125f * __expf(as_ - Mtc) : 0.f; } \
            u2v so; so.x = pk2(sv[0], sv[1]); so.y = pk2(sv[2], sv[3]); *(LAS u2v*)(L + M_SC + tlc * SP_X + (16 * sb + 4 * fg) * 2) = so; } \
        { const float dec = __expf(mprev - Mlast); \
          cacc[0] *= dec; cacc[1] *= dec; nacc *= dec; \
          _Pragma("unroll") for (int ks = 0; ks < 2; ++ks) { const bf16x8 af = lds_tr8(L + bo + MB_KW + (32 * ks) * SP_X + (16 * tb) * 2, SP_X, lane); \
              nacc = MFMA16(af, ones, nacc); \
              _Pragma("unroll") for (int ebi = 0; ebi < 2; ++ebi) cacc[ebi] = MFMA16(af, lds_tr8(L + bo + MB_VS + (32 * ks) * SP_X + (16 * (2 * half + ebi)) * 2, SP_X, lane), cacc[ebi]); } } \
        __syncthreads();                                                       \
        { f32x4 dintra = (f32x4){0.f, 0.f, 0.f, 0.f}; bf16x8 sa[2]; \
          _Pragma("unroll") for (int ks = 0; ks < 2; ++ks) { sa[ks] = lds_b128(L + M_SC + (16 * tb + fr) * SP_X + (32 * ks + 8 * fg) * 2); dintra = MFMA16(ones, sa[ks], dintra); } \
          const float wi = __expf(mprev - Mtc), den = wi * dint[0] + dintra[0], dn = 1.0f / fmaxf(fabsf(den), __expf(-(btc + Mtc))); \
          _Pragma("unroll") for (int ebi = 0; ebi < 2; ++ebi) { const int eb = 2 * half + ebi; f32x4 yd = (f32x4){0.f, 0.f, 0.f, 0.f}; \
              _Pragma("unroll") for (int ks = 0; ks < 2; ++ks) yd = MFMA16(lds_tr8(L + bo + MB_VS + (32 * ks) * SP_X + (16 * eb) * 2, SP_X, lane), sa[ks], yd); \
              u2v ho; ho.x = pk2((wi * yint[ebi][0] + yd[0]) * dn, (wi * yint[ebi][1] + yd[1]) * dn); ho.y = pk2((wi * yint[ebi][2] + yd[2]) * dn, (wi * yint[ebi][3] + yd[3]) * dn); \
              *(u2v*)(MLH + ML_TOK(c, tlc) * 256 + h * 64 + 16 * eb + 4 * fg) = ho; } } \
        _Pragma("unroll") for (int ebi = 0; ebi < 2; ++ebi) { u2v o; o.x = pk2(cacc[ebi][0], cacc[ebi][1]); o.y = pk2(cacc[ebi][2], cacc[ebi][3]); \
            *(LAS u2v*)(L + M_CBF + (16 * (2 * half + ebi) + fr) * SP_X + (16 * tb + 4 * fg) * 2) = o; } \
        if (half == 0 && fr == 0) { u2v o; o.x = pk2(nacc[0], nacc[1]); o.y = pk2(nacc[2], nacc[3]); *(LAS u2v*)(L + M_NBF + (16 * tb + 4 * fg) * 2) = o; } \
        mprev = blast + Mlast; \
        if ((c) + 1 < 32) { bcum = wave_incl_sum(plf##NS, lane); av = pli##NS - bcum; Mv = fmaxf(mprev, wave_incl_max(av, lane)); Mlast = __shfl(Mv, 63); blast = __shfl(bcum, 63); \
            ML_STAGE((((c) + 1) & 1) * MB_SIZE, av, Mlast, NS); } } while (0)
    float mprev = 0.f;
    ML_LOAD(0, 0);
    float bcum = wave_incl_sum(plf0, lane), av = pli0 - bcum, Mv = fmaxf(mprev, wave_incl_max(av, lane)), Mlast = __shfl(Mv, 63), blast = __shfl(bcum, 63);
    ML_STAGE(0, av, Mlast, 0);
    ML_LOAD(1, 1);
    for (int c2 = 0; c2 < 32; c2 += 2) { ML_CHUNK(c2, 0, 1); ML_CHUNK(c2 + 1, 1, 0); }
    __syncthreads();
#undef ML_CHUNK
#undef ML_LOAD
#undef ML_STAGE
#undef ML_TOK
}
constexpr int NA_K_OFF = 0, NA_V_OFF = 65536, NA_VP = 1040, NA_RPB_OFF = 65536 + 64 * 1040;
__device__ __forceinline__ int na_swz(int tk) { return (tk & 3) | (((tk >> 3) & 1) << 2); }
__device__ __forceinline__ void na_block_item(Ctx& F, int l, int it) {
    const int r = it & 31, h = (it >> 5) & 3, b = it >> 7;
    const int tid = fresh_tid(F.wave0), lane = tid & 63, w = F.wave0, fr = lane & 15, fg = lane >> 4;
    LAS unsigned char* L = F.lds;
    const bf16* U = (const bf16*)(F.ws + WS_U); const bf16* VT = (const bf16*)(F.ws + WS_UHT) + (size_t)(R_NV + h * 64) * TP; bf16* NAO = (bf16*)(F.ws + WS_NAO);
    const int rs = min(max(r - 4, 0), 24);
    const size_t tb0 = (size_t)b * SEQ;
    __syncthreads();
    { v4u kv[8], vv[8];
#pragma unroll
      for (int k = 0; k < 8; ++k) { const int id = tid + 512 * k, tk = id >> 3, ch = id & 7; kv[k] = *(const v4u*)(U + (tb0 + rs * 64 + tk) * UL + C_NK + h * 64 + 8 * ch); }
#pragma unroll
      for (int k = 0; k < 8; ++k) { const int id = tid + 512 * k, d = id >> 6, sg = id & 63; vv[k] = *(const v4u*)(VT + (size_t)d * TP + tb0 + rs * 64 + 8 * sg); }
#pragma unroll
      for (int k = 0; k < 8; ++k) { const int id = tid + 512 * k, tk = id >> 3, ch = id & 7; *(LAS v4u*)(L + NA_K_OFF + tk * 128 + ((ch ^ na_swz(tk)) << 4)) = kv[k]; }
#pragma unroll
      for (int k = 0; k < 8; ++k) { const int id = tid + 512 * k, d = id >> 6, sg = id & 63; *(LAS v4u*)(L + NA_V_OFF + d * NA_VP + sg * 16) = vv[k]; } }
    __syncthreads();
    if (w < 4) {
        const int jb = w;
        const LAS float* rpb = (const LAS float*)(L + NA_RPB_OFF) + h * 15 * 31;
        const int ks0 = min(max(16 * jb - 8, 0), 32);
        const int jq = 16 * jb + fr, cs = min(max(jq - 8, 0), 48);
        bf16x8 qb[2];
        { const bf16* qp = U + (tb0 + r * 64 + jq) * UL + C_NQ + h * 64 + 8 * fg; qb[0] = *(const bf16x8*)qp; qb[1] = *(const bf16x8*)(qp + 32); }
        const int kcl = ks0 + 8 * (fr >> 2) + (fr & 3);
        float sc[16][4];
#pragma unroll
        for (int T = 0; T < 16; ++T) { const int krow = rs + (T >> 1), tk = (T >> 1) * 64 + kcl + 4 * (T & 1), sw = na_swz(tk);
            const bf16x8 k0 = lds_b128(L + NA_K_OFF + tk * 128 + ((fg ^ sw) << 4)), k1 = lds_b128(L + NA_K_OFF + tk * 128 + (((4 + fg) ^ sw) << 4));
            f32x4 s = (f32x4){0.f, 0.f, 0.f, 0.f}; s = MFMA16(k0, qb[0], s); s = MFMA16(k1, qb[1], s);
#pragma unroll
            for (int e = 0; e < 4; ++e) { const int kc = ks0 + 8 * fg + 4 * (T & 1) + e; const bool valid = kc >= cs && kc < cs + 16;
                const int dc = min(max(kc - jq + 15, 0), 30);
                sc[T][e] = valid ? s[e] * 0.125f + rpb[(krow - r + 7) * 31 + dc] : -1e30f; } }
        float mx = -1e30f;
#pragma unroll
        for (int T = 0; T < 16; ++T)
#pragma unroll
            for (int e = 0; e < 4; ++e) mx = fmaxf(mx, sc[T][e]);
        mx = fmaxf(mx, __shfl_xor(mx, 16)); mx = fmaxf(mx, __shfl_xor(mx, 32));
        float sum = 0.f;
#pragma unroll
        for (int T = 0; T < 16; ++T)
#pragma unroll
            for (int e = 0; e < 4; ++e) { sc[T][e] = __expf(sc[T][e] - mx); sum += sc[T][e]; }
        sum += __shfl_xor(sum, 16); sum += __shfl_xor(sum, 32);
        f32x4 oacc[4];
#pragma unroll
        for (int d = 0; d < 4; ++d) oacc[d] = (f32x4){0.f, 0.f, 0.f, 0.f};
#pragma unroll
        for (int ks = 0; ks < 8; ++ks) {
            bf16x8 pa; { v4u pw; pw[0] = pk2(sc[2 * ks][0], sc[2 * ks][1]); pw[1] = pk2(sc[2 * ks][2], sc[2 * ks][3]); pw[2] = pk2(sc[2 * ks + 1][0], sc[2 * ks + 1][1]); pw[3] = pk2(sc[2 * ks + 1][2], sc[2 * ks + 1][3]); pa = __builtin_bit_cast(bf16x8, pw); }
#pragma unroll
            for (int d = 0; d < 4; ++d) oacc[d] = MFMA16(pa, lds_b128(L + NA_V_OFF + (16 * d + fr) * NA_VP + (ks * 64 + ks0 + 8 * fg) * 2), oacc[d]); }
#pragma unroll
        for (int e = 0; e < 4; ++e) { const int q = 4 * fg + e; const float inv = 1.0f / __shfl(sum, q);
            bf16* op = NAO + (tb0 + r * 64 + 16 * jb + q) * 256 + h * 64 + fr;
#pragma unroll
            for (int d = 0; d < 4; ++d) op[16 * d] = (bf16)f2bf(oacc[d][e] * inv); }
    }
}
constexpr int HY_CP = 8224, HY_ZP = 4112, HY_ZB = 8 * HY_CP;
__device__ __forceinline__ void hy_load_row(const bf16* R, int tid, v4u& cur, v4u& prev) {
    cur = *(const v4u*)(R + 8 * tid); prev = *(const v4u*)(R + 8 * tid - 8);
}
__device__ __forceinline__ void hy_write_copies(LAS unsigned char* L, int tid, const v4u cur, v4u prev) {
    if (tid == 0) prev = (v4u){0u, 0u, 0u, 0u};
    unsigned wd[9] = {prev[0], prev[1], prev[2], prev[3], cur[0], cur[1], cur[2], cur[3], 0u};
#pragma unroll
    for (int rho = 0; rho < 8; ++rho) { const int wo = (8 - rho) >> 1; v4u o;
        if ((rho & 1) == 0) { o[0] = wd[wo]; o[1] = wd[wo + 1]; o[2] = wd[wo + 2]; o[3] = wd[wo + 3]; }
        else {
#pragma unroll
            for (int j = 0; j < 4; ++j) o[j] = (wd[wo + j] >> 16) | (wd[wo + j + 1] << 16); }
        *(LAS v4u*)(L + rho * HY_CP + 16 * tid) = o; }
}
__device__ __forceinline__ float hy_gate4(const bf16* grow, int tok, int t, float w0, float w1, float w2, float bias, float* out4) {
    const u2v c4 = *(const u2v*)(grow + tok); const float lf = t > 0 ? bf2f(grow[tok - 1]) : 0.f, rt = t + 4 < SEQ ? bf2f(grow[tok + 4]) : 0.f;
    const float v0 = bflo(c4.x), v1 = bfhi(c4.x), v2 = bflo(c4.y), v3 = bfhi(c4.y);
    out4[0] = w0 * lf + w1 * v0 + w2 * v1 + bias; out4[1] = w0 * v0 + w1 * v1 + w2 * v2 + bias; out4[2] = w0 * v1 + w1 * v2 + w2 * v3 + bias; out4[3] = w0 * v2 + w1 * v3 + w2 * rt + bias;
    return 0.f;
}
__device__ __forceinline__ void hy_item(Ctx& F, int l, int c) {
    LAS unsigned char* L = F.lds;
    const bf16* UHT = (const bf16*)(F.ws + WS_UHT); bf16* HYO = (bf16*)(F.ws + WS_HYO);
    const float* cw = INP(16) + l * 3 * 768; const float* cb = INP(17) + l * 768; const float* skip = INP(24) + l * 512;
    const int tid = fresh_tid(F.wave0), lane = tid & 63, w = F.wave0, fr = lane & 15, fg = lane >> 4;
    const bf16* FR = (const bf16*)(F.ws + WS_FILT) + (size_t)(l * 2 * 256 + c) * 4096;
    { v4u fc, fp; hy_load_row(FR, tid, fc, fp); hy_write_copies(L, tid, fc, fp); }
    { const float w0 = cw[c], w1 = cw[768 + c], w2 = cw[1536 + c], bias = cb[c]; const bf16* row = UHT + (size_t)c * TP;
      v4u cv[8]; unsigned nb[8];
#pragma unroll
      for (int k = 0; k < 8; ++k) { const int u = tid + 512 * k, b = u >> 8, t0 = (u & 255) * 8, tok = b * SEQ + t0;
          cv[k] = *(const v4u*)(row + tok); nb[k] = (unsigned)row[tok - 1] | ((unsigned)row[tok + 8] << 16); }
#pragma unroll
      for (int k = 0; k < 8; ++k) asm volatile("" : "+v"(nb[k]));
#pragma unroll
      for (int k = 0; k < 8; ++k) { const int u = tid + 512 * k, b = u >> 8, t0 = (u & 255) * 8;
          const float lf = t0 > 0 ? bflo(nb[k]) : 0.f, rt = t0 + 8 < SEQ ? bfhi(nb[k]) : 0.f;
          float x[10]; x[0] = lf; x[9] = rt;
#pragma unroll
          for (int e = 0; e < 4; ++e) { x[1 + 2 * e] = bflo(cv[k][e]); x[2 + 2 * e] = bfhi(cv[k][e]); }
          v4u o;
#pragma unroll
          for (int e = 0; e < 4; ++e) o[e] = pk2(w0 * x[2 * e] + w1 * x[2 * e + 1] + w2 * x[2 * e + 2] + bias, w0 * x[2 * e + 1] + w1 * x[2 * e + 2] + w2 * x[2 * e + 3] + bias);
          *(LAS v4u*)(L + HY_ZB + b * HY_ZP + t0 * 2) = o; } }
    __syncthreads();
    const int abase = (fr & 7) * HY_CP + 4096 + 16 * (fg - (fr >> 3)) - 32 * 16 * w;
    const int bbase = HY_ZB + fr * HY_ZP + 16 * fg;
    for (int o = 0; o < 2; ++o) {
        const int gc = 256 * (o + 1) + c; const bf16* grow = UHT + (size_t)gc * TP;
        u2v gcv[16]; v4u fc, fp;
#pragma unroll
        for (int ii = 0; ii < 8; ++ii) { const int t = 16 * (16 * w + ii) + 4 * fg, tok = fr * SEQ + t; gcv[ii] = *(const u2v*)(grow + tok); }
        const unsigned edgeL = grow[fr * SEQ + 256 * w - 1], edgeR = grow[fr * SEQ + 256 * w + 256];
        f32x4 acc[16];
#pragma unroll
        for (int i = 0; i < 16; ++i) acc[i] = (f32x4){0.f, 0.f, 0.f, 0.f};
        bf16x8 af[16];
#pragma unroll
        for (int m = 2; m <= 15; ++m) af[(16 - m) & 15] = lds_b128(L + abase - 32 * m);
        for (int j0 = 0; j0 < 64; j0 += 8) {
#pragma unroll
            for (int jj = 0; jj < 8; ++jj) { const int j = j0 + jj;
                af[(2 * jj) & 15] = lds_b128(L + abase + 64 * j); af[(2 * jj + 15) & 15] = lds_b128(L + abase + 64 * j - 32);
                const bf16x8 bfr = lds_b128(L + bbase + 64 * j);
#pragma unroll
                for (int ii = 0; ii < 16; ++ii) acc[ii] = MFMA16(af[(2 * jj - ii + 16) & 15], bfr, acc[ii]); }
        }
        __syncthreads();
        if (o == 0) hy_load_row(FR + (size_t)256 * 4096, tid, fc, fp);
        const float w0 = cw[gc], w1 = cw[768 + gc], w2 = cw[1536 + gc], bias = cb[gc];
        const float sk = skip[o * 256 + c];
#pragma unroll
        for (int ii = 8; ii < 16; ++ii) { const int t = 16 * (16 * w + ii) + 4 * fg, tok = fr * SEQ + t; gcv[ii] = *(const u2v*)(grow + tok); }
        unsigned gnb[16];
        { const int srcL = fg > 0 ? lane - 16 : lane + 48, srcR = fg < 3 ? lane + 16 : lane - 48;
#pragma unroll
          for (int ii = 0; ii < 16; ++ii) {
              const unsigned sendL = (fg == 3 && ii > 0) ? gcv[ii > 0 ? ii - 1 : 0].y : gcv[ii].y;
              const unsigned sendR = (fg == 0 && ii < 15) ? gcv[ii < 15 ? ii + 1 : 15].x : gcv[ii].x;
              unsigned gl = (unsigned)__shfl((int)sendL, srcL) >> 16, gr = (unsigned)__shfl((int)sendR, srcR) & 0xffffu;
              if (ii == 0 && fg == 0) gl = edgeL; if (ii == 15 && fg == 3) gr = edgeR;
              gnb[ii] = gl | (gr << 16); } }
        if (o == 0) hy_write_copies(L, tid, fc, fp);
#pragma unroll
        for (int ii = 0; ii < 16; ++ii) { const int t = 16 * (16 * w + ii) + 4 * fg, tok = fr * SEQ + t;
            const float lf = t > 0 ? bflo(gnb[ii]) : 0.f, rt = t + 4 < SEQ ? bfhi(gnb[ii]) : 0.f, v0 = bflo(gcv[ii].x), v1 = bfhi(gcv[ii].x), v2 = bflo(gcv[ii].y), v3 = bfhi(gcv[ii].y);
            const float xg0 = w0 * lf + w1 * v0 + w2 * v1 + bias, xg1 = w0 * v0 + w1 * v1 + w2 * v2 + bias, xg2 = w0 * v1 + w1 * v2 + w2 * v3 + bias, xg3 = w0 * v2 + w1 * v3 + w2 * rt + bias;
            LAS u2v* zp = (LAS u2v*)(L + HY_ZB + fr * HY_ZP + t * 2); const u2v zo = *zp;
            const float z0 = xg0 * (acc[ii][0] + sk * bflo(zo.x)), z1 = xg1 * (acc[ii][1] + sk * bfhi(zo.x)), z2 = xg2 * (acc[ii][2] + sk * bflo(zo.y)), z3 = xg3 * (acc[ii][3] + sk * bfhi(zo.y));
            u2v zn; zn.x = pk2(z0, z1); zn.y = pk2(z2, z3);
            if (o == 0) *zp = zn; else *(u2v*)(HYO + (size_t)c * TP + tok) = zn; }
        __syncthreads();
    }
}
#ifndef MIXREP
#define MIXREP 0
#endif
__device__ __forceinline__ void ph_mixers(Ctx& F, int l, int rep) {
    for (int q_ = 0; q_ < ((MIXREP & 1) ? 2 : 1); ++q_)
    for (int it = F.bid; it < 256; it += F.G) { if (it < 128) ssd_item(F, l, it); else ml_item(F, l, it - 128); }
    F.tid = fresh_tid(F.wave0); F.lane = F.tid & 63; F.wave = F.wave0;
    for (int i = F.tid; i < 4 * 15 * 31; i += NTHR) ((LAS float*)(F.lds + NA_RPB_OFF))[i] = INP(11)[(size_t)l * 4 * 15 * 31 + i];
    volatile LAS int* slot = (volatile LAS int*)(F.lds + MISC_OFF);
    unsigned* ctr = (unsigned*)(F.ws + WS_CTL) + 64 * (1 + l + 2 * rep);
    for (;;) {
        __syncthreads();
        if (F.tid == 0) slot[0] = (int)atomicAdd(ctr, 1u);
        __syncthreads();
        const int it = slot[0];
        if (it >= 256 + 2048) break;
        if (it < 256) { hy_item(F, l, it); if (MIXREP & 2) hy_item(F, l, it); }
        else na_block_item(F, l, it - 256);
    }
}

__device__ __forceinline__ void ph_finalize(Ctx& F, int l) {
    const int lane = F.lane, c0 = lane * 4, tid = F.tid;
    const bf16* U = (const bf16*)(F.ws + WS_U); const bf16* YS = (const bf16*)(F.ws + WS_YS); const bf16* NAO = (const bf16*)(F.ws + WS_NAO);
    const bf16* MLH = (const bf16*)(F.ws + WS_MLH); const bf16* HYO = (const bf16*)(F.ws + WS_HYO); bf16* YM = (bf16*)(F.ws + WS_XN);
    const f32x4 gs = *(const f32x4*)(INP(10) + l * 256 + c0), gn = *(const f32x4*)(INP(12) + l * 256 + c0), gm = *(const f32x4*)(INP(15) + l * 256 + c0), gh = *(const f32x4*)(INP(25) + l * 256 + c0);
    constexpr int HP = 144;
    for (int it = F.bid; it < MTOK / 64; it += F.G) {
        const int tok0 = it * 64;
        __syncthreads();
#pragma unroll
        for (int k = 0; k < 4; ++k) { const int u = tid + 512 * k, c = u >> 3, ch = u & 7; *(LAS v4u*)(F.lds + c * HP + ch * 16) = *(const v4u*)(HYO + (size_t)c * TP + tok0 + ch * 8); }
        __syncthreads();
        typedef unsigned u2 __attribute__((ext_vector_type(2)));
#pragma unroll 1
        for (int q0 = 0; q0 < 8; q0 += 8) {
            u2 ys0[8], ys1[8], zz[8], na[8], m0[8], m1[8], og[8]; float hv[8][4];
#pragma unroll
            for (int j = 0; j < 8; ++j) { const int tl = F.wave * 8 + q0 + j; const size_t tok = (size_t)(tok0 + tl);
                ys0[j] = *(const u2*)(YS + tok * 256 + c0); ys1[j] = *(const u2*)(YS + (MTOK + tok) * 256 + c0); zz[j] = *(const u2*)(U + tok * UL + C_SZ + c0);
                na[j] = *(const u2*)(NAO + tok * 256 + c0); m0[j] = *(const u2*)(MLH + tok * 256 + c0); m1[j] = *(const u2*)(MLH + (MTOK + tok) * 256 + c0); og[j] = *(const u2*)(U + tok * UL + C_MO + c0);
                const LAS bf16* hp = (const LAS bf16*)(F.lds + c0 * HP + tl * 2); hv[j][0] = bf2f(hp[0]); hv[j][1] = bf2f(hp[HP / 2]); hv[j][2] = bf2f(hp[HP]); hv[j][3] = bf2f(hp[3 * HP / 2]); }
#pragma unroll
            for (int j = 0; j < 8; ++j) { const size_t tok = (size_t)(tok0 + F.wave * 8 + q0 + j); bf16* yo = YM + tok * DM + c0;
                { const float v0 = (bflo(ys0[j].x) + bflo(ys1[j].x)) * silu_ff(bflo(zz[j].x)), v1 = (bfhi(ys0[j].x) + bfhi(ys1[j].x)) * silu_ff(bfhi(zz[j].x)), v2 = (bflo(ys0[j].y) + bflo(ys1[j].y)) * silu_ff(bflo(zz[j].y)), v3 = (bfhi(ys0[j].y) + bfhi(ys1[j].y)) * silu_ff(bfhi(zz[j].y));
                  const float rs = 1.0f / sqrtf(wave_sum(v0 * v0 + v1 * v1 + v2 * v2 + v3 * v3) * (1.f / 256.f) + EPS);
                  u2 o; o.x = pk2(v0 * rs * gs.x, v1 * rs * gs.y); o.y = pk2(v2 * rs * gs.z, v3 * rs * gs.w); *(u2*)yo = o; }
                { const float v0 = bflo(na[j].x), v1 = bfhi(na[j].x), v2 = bflo(na[j].y), v3 = bfhi(na[j].y);
                  const float rs = 1.0f / sqrtf(wave_sum(v0 * v0 + v1 * v1 + v2 * v2 + v3 * v3) * (1.f / 256.f) + EPS);
                  u2 o; o.x = pk2(v0 * rs * gn.x, v1 * rs * gn.y); o.y = pk2(v2 * rs * gn.z, v3 * rs * gn.w); *(u2*)(yo + 256) = o; }
                { const float v0 = bflo(m0[j].x) + bflo(m1[j].x), v1 = bfhi(m0[j].x) + bfhi(m1[j].x), v2 = bflo(m0[j].y) + bflo(m1[j].y), v3 = bfhi(m0[j].y) + bfhi(m1[j].y);
                  float ss = v0 * v0 + v1 * v1 + v2 * v2 + v3 * v3;
                  ss += __shfl_xor(ss, 1); ss += __shfl_xor(ss, 2); ss += __shfl_xor(ss, 4); ss += __shfl_xor(ss, 8);
                  const float rs = 1.0f / sqrtf(ss * (1.f / 64.f) + EPS);
                  u2 o; o.x = pk2(v0 * rs * gm.x * sigmoid_f(bflo(og[j].x)), v1 * rs * gm.y * sigmoid_f(bfhi(og[j].x))); o.y = pk2(v2 * rs * gm.z * sigmoid_f(bflo(og[j].y)), v3 * rs * gm.w * sigmoid_f(bfhi(og[j].y)));
                  *(u2*)(yo + 512) = o; }
                { const float v0 = hv[j][0], v1 = hv[j][1], v2 = hv[j][2], v3 = hv[j][3];
                  const float rs = 1.0f / sqrtf(wave_sum(v0 * v0 + v1 * v1 + v2 * v2 + v3 * v3) * (1.f / 256.f) + EPS);
                  u2 o; o.x = pk2(v0 * rs * gh.x, v1 * rs * gh.y); o.y = pk2(v2 * rs * gh.z, v3 * rs * gh.w); *(u2*)(yo + 768) = o; }
            }
        }
    }
}

#define XB_TMO      128
#define XB_XCNT(j)  (256  + 64 * (j))
#define XB_XSUB(j)  (1280 + 64 * (j))
#define XB_XGEN(j)  (2304 + 64 * (j))
#define XB_TOP      3328
#define XB_TOPGEN   3392
#define XCD_BAR_WORDS 3456
#define XB_SPIN_CAP (1u << 18)

__device__ __forceinline__ unsigned xb_ld(unsigned* p)              { return __hip_atomic_load(p, __ATOMIC_RELAXED, __HIP_MEMORY_SCOPE_AGENT); }
__device__ __forceinline__ unsigned xb_add(unsigned* p, unsigned v) { return __hip_atomic_fetch_add(p, v, __ATOMIC_RELAXED, __HIP_MEMORY_SCOPE_AGENT); }
__device__ __forceinline__ unsigned xb_xcc_id() { return (unsigned)__builtin_amdgcn_s_getreg((3 << 11) | 20) & 0xFu; }
#define XB_SPIN(cond, bar) do { unsigned _sp = 0; while (cond) { __builtin_amdgcn_s_sleep(1); \
    if ((++_sp & 255u) == 0u) { if (xb_ld(&(bar)[XB_TMO])) break; if (_sp > XB_SPIN_CAP) { atomicAdd(&(bar)[XB_TMO], 1u); break; } } } } while (0)

struct XcdBarrier {
    unsigned* bar; unsigned x;
    volatile LAS unsigned* st;
};

__device__ __forceinline__ XcdBarrier xcd_barrier_post(unsigned* bar, volatile LAS unsigned* st) {
    XcdBarrier b; b.bar = bar; b.x = xb_xcc_id(); b.st = st;
    if (threadIdx.x == 0) (void)xb_add(&bar[XB_XCNT(b.x)], 1u);
    return b;
}
__device__ __forceinline__ void xcd_barrier_complete(unsigned* bar, unsigned x, unsigned& nloc, unsigned& nx) {
    const unsigned G = gridDim.x * gridDim.y * gridDim.z;
    unsigned sum, cnt, mine, sp = 0u;
    for (;;) {
        sum = 0u; cnt = 0u; mine = 0u;
#pragma unroll
        for (unsigned j = 0; j < 16; ++j) { const unsigned c = xb_ld(&bar[XB_XCNT(j)]); sum += c; cnt += (c > 0u) ? 1u : 0u; mine = (j == x) ? c : mine; }
        if (sum == G) break;
        __builtin_amdgcn_s_sleep(1);
        if ((++sp & 255u) == 0u) { if (xb_ld(&bar[XB_TMO])) break; if (sp > XB_SPIN_CAP) { atomicAdd(&bar[XB_TMO], 1u); break; } }
    }
    nloc = mine > 0u ? mine : 1u; nx = cnt > 0u ? cnt : 1u;
}

__device__ __forceinline__ void xcd_barrier(const XcdBarrier& b, const bool leader) {
    asm volatile("s_waitcnt vmcnt(0)" ::: "memory");
    __syncthreads();
    if (leader) {
        unsigned* bar = b.bar;
        __builtin_amdgcn_s_waitcnt(0);
        unsigned nloc = b.st[0], nx = b.st[1];
        if (nloc == 0u) { xcd_barrier_complete(bar, b.x, nloc, nx); b.st[0] = nloc; b.st[1] = nx; }
        const unsigned old = xb_add(&bar[XB_XSUB(b.x)], 1u);
        const unsigned gen = old / nloc;
        if (old + 1u == (gen + 1u) * nloc) {
            __builtin_amdgcn_fence(__ATOMIC_RELEASE, "agent");
            asm volatile("s_waitcnt vmcnt(0)" ::: "memory");
            const unsigned og = xb_add(&bar[XB_TOP], 1u);
            const unsigned tg = og / nx;
            if (og + 1u == (tg + 1u) * nx) xb_add(&bar[XB_TOPGEN], 1u);
            else XB_SPIN(xb_ld(&bar[XB_TOPGEN]) == tg, bar);
            __builtin_amdgcn_fence(__ATOMIC_ACQUIRE, "agent");
            xb_add(&bar[XB_XGEN(b.x)], 1u);
            asm volatile("s_waitcnt vmcnt(0)" ::: "memory");
        } else {
            XB_SPIN(xb_ld(&bar[XB_XGEN(b.x)]) == gen, bar);
            __builtin_amdgcn_fence(__ATOMIC_ACQUIRE, "agent");
            asm volatile("s_waitcnt vmcnt(0)" ::: "memory");
        }
    }
    __syncthreads();
}

constexpr int N_PHASES = 2 + 9 * DEPTH;
#ifndef MK_MULTI
#define MK_MULTI 1
#endif
__global__ void __launch_bounds__(NTHR, 2) hybrid_fwd(Args args) {
    extern __shared__ __attribute__((aligned(16))) unsigned char lds_raw[];
    Ctx F;
    F.lds = (LAS unsigned char*)lds_raw; F.tid = threadIdx.x; F.lane = F.tid & 63; F.wave = __builtin_amdgcn_readfirstlane(F.tid >> 6); F.wave0 = F.wave;
    F.bid = blockIdx.x; F.G = gridDim.x; F.out = args.out; F.ws = args.ws; F.A = &args;
#if MK_MULTI
    const int lo = args.ph_lo, hi = args.ph_hi;
#else
    constexpr int lo = 0, hi = N_PHASES;
#endif
#if MK_MULTI
#define SEAM(k) do { } while (0)
#else
    for (int u = F.tid; u < 32; u += NTHR) ((LAS unsigned*)(F.lds + MISC_OFF))[u] = 0u;
    __syncthreads();
    XcdBarrier bar = xcd_barrier_post((unsigned*)(F.ws + WS_CTL) + 4096, (volatile LAS unsigned*)(F.lds + MISC_OFF) + 8);
#define SEAM(k) do { if ((k) + 1 < hi) { XcdBarrier b2_ = bar; asm volatile("" : "+s"(b2_.x)); xcd_barrier(b2_, fresh_tid(F.wave0) == 0); } } while (0)
#endif
#ifndef PHMASK
#define PHMASK 0xFFFFF
#endif
#define FRESH() do { F.tid = fresh_tid(F.wave0); F.lane = F.tid & 63; F.wave = F.wave0; } while (0)
#define IN(k) (((PHMASK >> (k)) & 1) && lo <= (k) && (k) < hi)
#define INL(j) (((PHMASK >> (2 + (j))) & 1) && lo <= (pb + (j)) && (pb + (j)) < hi)
#ifndef REPMASK
#define REPMASK 0
#endif
#define REPS(k) for (int rep_ = 0; rep_ < ((((REPMASK) >> (k)) & 1) ? 2 : 1); ++rep_)
    const float* MOD = (const float*)(F.ws + WS_MOD); float* SS = (float*)(F.ws + WS_SS); const float* CV = (const float*)(F.ws + WS_CV);
    if (IN(0)) { REPS(0) { FRESH(); ph_prologue(F); __syncthreads(); } SEAM(0); }
    if (IN(1)) { REPS(1) { FRESH(); ph_filters(F); FRESH(); ph_cvec(F); FRESH(); ph_xn0(F, MOD); __syncthreads(); } SEAM(1); }
#pragma unroll 1
    for (int l = 0; l < DEPTH; ++l) {
        const int pb = 2 + 9 * l; unsigned char* wb = F.ws + WS_W + (size_t)l * W_LAYER; const float* mod_l = MOD + (size_t)l * NB * 6144; const float* cv_l = CV + (size_t)l * NB * CVP;
        float* ss_in = SS + (size_t)(2 * l) * MTOK; float* ss_ff = SS + (size_t)(2 * l + 1) * MTOK; float* ss_nx = SS + (size_t)(2 * l + 2) * MTOK;
        if (INL(0)) { REPS(2) { FRESH();
            pg8::Gemm g{(const pg8::bf16_t*)(F.ws + WS_XN), (const pg8::bf16_t*)(wb + W_IN_OFF), MTOK, UL, DM};
            pg8::DualOrder S; S.init(MTOK, UL, NTR, MTOK, F.G, F.bid, (const pg8::bf16_t*)(wb + W_HY_OFF), (const pg8::bf16_t*)(F.ws + WS_XN));
            pg8::EpiDualIn E{{(pg8::bf16_t*)(F.ws + WS_U), UL, ss_in, cv_l}, {(pg8::bf16_t*)(F.ws + WS_UHT), TP, ss_in, cv_l + 2816}};
            pg8::gemm_phase<pg8::EpiDualIn, pg8::DualOrder, true, true>(F.lds, g, S, E, F.wave0);
            __syncthreads(); }
            SEAM(pb + 0);
        }
        if (INL(1)) { REPS(3) { FRESH(); ph_prepass(F, l); } SEAM(pb + 1); }
        if (INL(2)) { REPS(4) { FRESH(); ph_mixers(F, l, rep_); } SEAM(pb + 2); }
        if (INL(3)) { REPS(5) { FRESH(); ph_finalize(F, l); } SEAM(pb + 3); }
        if (INL(4)) { FRESH();
            pg8::Gemm g{(const pg8::bf16_t*)(F.ws + WS_XN), (const pg8::bf16_t*)(wb + W_OUT_OFF), MTOK, DM, DM}; pg8::StaticOrder S; S.init(MTOK, DM, F.G, F.bid);
            pg8::EpiResidN E{l == 0 ? INP(0) : (const float*)F.out, F.out, mod_l + 2048, mod_l + 4096, (pg8::bf16_t*)(F.ws + WS_XN2), ss_ff};
            pg8::gemm_phase<pg8::EpiResidN, pg8::StaticOrder, true, true>(F.lds, g, S, E, F.wave0);
            SEAM(pb + 4);
        }
        if (INL(6)) { REPS(8) { FRESH();
            pg8::Gemm g{(const pg8::bf16_t*)(F.ws + WS_XN2), (const pg8::bf16_t*)(wb + W_GU_OFF), MTOK, 2 * FFH, DM}; pg8::StaticOrder S; S.init(MTOK, 2 * FFH, F.G, F.bid);
            pg8::EpiSwigluN E{(pg8::bf16_t*)(F.ws + WS_U), FFH, ss_ff, cv_l + 3840}; pg8::gemm_phase<pg8::EpiSwigluN, pg8::StaticOrder, true, true>(F.lds, g, S, E, F.wave0); __syncthreads(); }
            SEAM(pb + 6);
        }
        if (INL(7)) { FRESH();
            pg8::Gemm g{(const pg8::bf16_t*)(F.ws + WS_U), (const pg8::bf16_t*)(wb + W_DN_OFF), MTOK, DM, FFH}; pg8::StaticOrder S; S.init(MTOK, DM, F.G, F.bid);
            pg8::EpiResidN E{(const float*)F.out, F.out, mod_l + 5120, mod_l + (size_t)NB * 6144 + 1024, l + 1 < DEPTH ? (pg8::bf16_t*)(F.ws + WS_XN) : nullptr, ss_nx};
            pg8::gemm_phase<pg8::EpiResidN, pg8::StaticOrder, true, true>(F.lds, g, S, E, F.wave0);
            SEAM(pb + 7);
        }
        if (INL(8)) { if (l + 1 == DEPTH) { FRESH(); ph_final(F); } }
    }
#undef IN
#undef INL
#undef SEAM
}

extern "C" void kernel_launch(void* const* d_in, const int* in_sizes, int n_in, void* d_out, int out_size, void* d_ws, size_t ws_size, hipStream_t stream) {
    static int grid = 0;
    if (grid == 0) {
        if (n_in != 31 || out_size != MTOK * DM || ws_size < WS_END) { fprintf(stderr, "kernel_launch: unexpected problem shape (n_in %d out %d ws %zu)\n", n_in, out_size, ws_size); grid = -1; return; }
        int dev = 0, cus = 0, per_cu = 0;
        hipGetDevice(&dev); hipDeviceGetAttribute(&cus, hipDeviceAttributeMultiprocessorCount, dev);
        if (hipFuncSetAttribute((const void*)hybrid_fwd, hipFuncAttributeMaxDynamicSharedMemorySize, LDS_BYTES) != hipSuccess) { fprintf(stderr, "kernel_launch: hipFuncSetAttribute failed\n"); grid = -1; return; }
        if (hipOccupancyMaxActiveBlocksPerMultiprocessor(&per_cu, (const void*)hybrid_fwd, NTHR, LDS_BYTES) != hipSuccess || per_cu < 1) { fprintf(stderr, "kernel_launch: occupancy query says %d blocks per CU\n", per_cu); grid = -1; (void)hipGetLastError(); return; }
        grid = cus;
    }
    if (grid < 0) return;
    hipMemsetAsync((char*)d_ws + WS_CTL, 0, CTL_ZERO_BYTES, stream);
    Args a{};
    for (int i = 0; i < 31; ++i) a.in[i] = (const float*)d_in[i];
    a.out = (float*)d_out; a.ws = (unsigned char*)d_ws;
#if MK_MULTI
    for (int p = 0; p < N_PHASES; ++p) { a.ph_lo = p; a.ph_hi = p + 1; hipLaunchKernelGGL(hybrid_fwd, dim3(grid), dim3(NTHR), LDS_BYTES, stream, a); }
#else
    a.ph_lo = 0; a.ph_hi = N_PHASES;
    hipLaunchKernelGGL(hybrid_fwd, dim3(grid), dim3(NTHR), LDS_BYTES, stream, a);
#endif
}
```

```cpp
#include <hip/hip_runtime.h>
#include <hip/hip_cooperative_groups.h>
#include <cstdio>
#include <cstdint>
namespace cg = cooperative_groups;
#define MK_MULTI 0
namespace pg8 {
#define PG8_LAS __attribute__((address_space(3)))
typedef unsigned short bf16_t;
typedef short bf16x8 __attribute__((ext_vector_type(8)));
typedef float f32x4 __attribute__((ext_vector_type(4)));
typedef unsigned u32x4 __attribute__((ext_vector_type(4)));
constexpr int BM = 256, BK = 64, HALF = 128, HTB = HALF * BK * 2  , STAGE_BYTES = 8 * HTB, NXCD = 8, WGM = 8;

__host__ __device__ __forceinline__ int lds_byte(int r, int c) { const int st = (r >> 4) * 2 + (c >> 5), rr = r & 15, cc = c & 31, ob = rr * 64 + cc * 2; return st * 1024 + (ob ^ (((ob >> 9) & 1) << 5)); }
__host__ __device__ __forceinline__ void stage_rc(int b, int& R, int& C) { const int st = b / 1024, sb = b % 1024, swz = sb ^ (((sb >> 9) & 1) << 5); R = (st >> 1) * 16 + swz / 64; C = (st & 1) * 32 + (swz % 64) / 2; }
__host__ __device__ __forceinline__ int perm32(int rho) { const int n = rho >> 4, i = rho & 15; return 8 * (i >> 2) + 4 * n + (i & 3); }

struct Unit { int pm, pn, kind; };
struct Gemm { const bf16_t* A; const bf16_t* Bt; int M, N, K; };

struct StaticOrder {
    int nM, nN, nwg, G, c;
    __host__ __device__ void init(int M, int N, int G_, int c_) { nM = M / BM; nN = N / BM; nwg = nM * nN; G = G_; c = c_; }
    __host__ __device__ bool next(int i, Unit& u) const {
        const long L = (long)i * G + c; if (L >= nwg) return false;
        int wgid = (int)L; { const int q = nwg / NXCD, r = nwg % NXCD, xcd = wgid % NXCD, off = wgid / NXCD; wgid = (xcd < r ? xcd * (q + 1) : r * (q + 1) + (xcd - r) * q) + off; }
        const int nig = WGM * nN, gid = wgid / nig, fm = gid * WGM, gsz = (nM - fm) < WGM ? (nM - fm) : WGM;
        u.pm = fm + ((wgid % nig) % gsz); u.pn = (wgid % nig) / gsz; u.kind = 0; return true;
    }
    template <class G_> __device__ __forceinline__ const char* pa(const G_& g, const Unit& u, size_t tstep) const { return (const char*)g.A + (size_t)u.pm * tstep; }
    template <class G_> __device__ __forceinline__ const char* pb(const G_& g, const Unit& u, size_t tstep) const { return (const char*)g.Bt + (size_t)u.pn * tstep; }
    __device__ __forceinline__ void a_ready(const Unit&) const {}
    __device__ __forceinline__ void done(const Unit&) const {}
};

__device__ __forceinline__ unsigned cvt_pk_bf16(float lo, float hi) { unsigned r; asm volatile("v_cvt_pk_bf16_f32 %0, %1, %2" : "=v"(r) : "v"(lo), "v"(hi)); return r; }
constexpr float PG8_EPS = 1e-6f;
constexpr int CVP = 9472;
struct EpiStoreBf16N {
    static constexpr bool PERM = true, AFTER_DRAIN = false;
    bf16_t* O; int ldc; const float* ss; const float* cv;
    __device__ __forceinline__ void operator()(const f32x4 (&acc)[2][2][4][2], const Unit& u, int wr, int wc, int fr, int fq) const {
        const int row0 = u.pm * BM + wr * 64 + fr; const int col0 = u.pn * BM + wc * 32 + 8 * fq;
        const float* cvp = cv + (size_t)((u.pm * BM) >> 11) * CVP + col0;
        f32x4 cvv[2][2];
#pragma unroll
        for (int bj = 0; bj < 2; ++bj)
#pragma unroll
            for (int n = 0; n < 2; ++n) cvv[bj][n] = *(const f32x4*)(cvp + bj * HALF + 4 * n);
#pragma unroll
        for (int ai = 0; ai < 2; ++ai)
#pragma unroll
            for (int m = 0; m < 4; ++m) { const int r = row0 + ai * HALF + m * 16; bf16_t* rowp = O + (size_t)r * ldc + col0;
                const float rs = __builtin_amdgcn_rsqf(ss[r] * (1.0f / 1024.0f) + PG8_EPS);
#pragma unroll
                for (int bj = 0; bj < 2; ++bj) { const f32x4 v0 = acc[ai][bj][m][0] * rs + cvv[bj][0], v1 = acc[ai][bj][m][1] * rs + cvv[bj][1];
                    u32x4 w; w.x = cvt_pk_bf16(v0[0], v0[1]); w.y = cvt_pk_bf16(v0[2], v0[3]); w.z = cvt_pk_bf16(v1[0], v1[1]); w.w = cvt_pk_bf16(v1[2], v1[3]);
                    *(u32x4*)(rowp + bj * HALF) = w; } }
    }
};
struct EpiStoreBf16T {
    static constexpr bool PERM = true, AFTER_DRAIN = false;
    bf16_t* O; int ldc; const float* ss; const float* cv;
    __device__ __forceinline__ void operator()(const f32x4 (&acc)[2][2][4][2], const Unit& u, int wr, int wc, int fr, int fq) const {
        const int row0 = u.pm * BM + wr * 64 + fr; const int col0 = u.pn * BM + wc * 32 + 8 * fq;
        const float* cvp = cv + (size_t)((u.pn * BM) >> 11) * CVP;
        f32x4 rsv[2][2];
#pragma unroll
        for (int bj = 0; bj < 2; ++bj)
#pragma unroll
            for (int n = 0; n < 2; ++n) { const f32x4 s4 = *(const f32x4*)(ss + col0 + bj * HALF + 4 * n);
#pragma unroll
                for (int j = 0; j < 4; ++j) rsv[bj][n][j] = __builtin_amdgcn_rsqf(s4[j] * (1.0f / 1024.0f) + PG8_EPS); }
#pragma unroll
        for (int ai = 0; ai < 2; ++ai)
#pragma unroll
            for (int m = 0; m < 4; ++m) { const int r = row0 + ai * HALF + m * 16; bf16_t* rowp = O + (size_t)r * ldc + col0; const float c = cvp[r];
#pragma unroll
                for (int bj = 0; bj < 2; ++bj) { const f32x4 v0 = acc[ai][bj][m][0] * rsv[bj][0] + c, v1 = acc[ai][bj][m][1] * rsv[bj][1] + c;
                    u32x4 w; w.x = cvt_pk_bf16(v0[0], v0[1]); w.y = cvt_pk_bf16(v0[2], v0[3]); w.z = cvt_pk_bf16(v1[0], v1[1]); w.w = cvt_pk_bf16(v1[2], v1[3]);
                    *(u32x4*)(rowp + bj * HALF) = w; } }
    }
};
struct EpiResidN {
    static constexpr bool PERM = false, AFTER_DRAIN = false;
    const float* base; float* out; const float* gate; const float* scn; bf16_t* an; float* ss;
    __device__ __forceinline__ void operator()(const f32x4 (&acc)[2][2][4][2], const Unit& u, int wr, int wc, int fr, int fq) const {
        const int col0 = u.pn * BM + wc * 32 + 4 * fq; const size_t bo = (size_t)((u.pm * BM) >> 11) * 6144 + col0;
        f32x4 gv[2][2], sv[2][2];
#pragma unroll
        for (int bj = 0; bj < 2; ++bj)
#pragma unroll
            for (int n = 0; n < 2; ++n) { gv[bj][n] = *(const f32x4*)(gate + bo + bj * HALF + n * 16); sv[bj][n] = an ? *(const f32x4*)(scn + bo + bj * HALF + n * 16) + 1.0f : (f32x4){0.f, 0.f, 0.f, 0.f}; }
#pragma unroll
        for (int ai = 0; ai < 2; ++ai)
#pragma unroll
            for (int m = 0; m < 4; ++m) { const int r = u.pm * BM + ai * HALF + wr * 64 + m * 16 + fr; const size_t off = (size_t)r * 1024 + col0; float q = 0.f;
#pragma unroll
                for (int bj = 0; bj < 2; ++bj)
#pragma unroll
                    for (int n = 0; n < 2; ++n) { const f32x4 bs = *(const f32x4*)(base + off + bj * HALF + n * 16); const f32x4 o = bs + gv[bj][n] * acc[ai][bj][m][n];
                        *(f32x4*)(out + off + bj * HALF + n * 16) = o; q += (o[0] * o[0] + o[1] * o[1]) + (o[2] * o[2] + o[3] * o[3]);
                        if (an) { const f32x4 a = o * sv[bj][n]; typedef unsigned u32x2 __attribute__((ext_vector_type(2))); u32x2 w; w.x = cvt_pk_bf16(a[0], a[1]); w.y = cvt_pk_bf16(a[2], a[3]); *(u32x2*)(an + off + bj * HALF + n * 16) = w; } }
                q += __shfl_xor(q, 16); q += __shfl_xor(q, 32);
                if (fq == 0) atomicAdd(ss + r, q);
                if (m == 3) asm volatile("" ::: "memory"); }
    }
};
__device__ __forceinline__ float silu_f(float v) { return v * __builtin_amdgcn_rcpf(1.0f + __expf(-v)); }
struct EpiSwigluN {
    static constexpr bool PERM = true, AFTER_DRAIN = false;
    bf16_t* O; int ldc; const float* ss; const float* cv;
    __device__ __forceinline__ void operator()(const f32x4 (&acc)[2][2][4][2], const Unit& u, int wr, int wc, int fr, int fq) const {
        const int row0 = u.pm * BM + wr * 64 + fr; const int col0 = u.pn * HALF + wc * 32 + 8 * fq;
        const float* cvp = cv + (size_t)((u.pm * BM) >> 11) * CVP + u.pn * BM + wc * 32 + 8 * fq;
        f32x4 cg[2], cu[2];
#pragma unroll
        for (int n = 0; n < 2; ++n) { cg[n] = *(const f32x4*)(cvp + 4 * n); cu[n] = *(const f32x4*)(cvp + HALF + 4 * n); }
#pragma unroll
        for (int ai = 0; ai < 2; ++ai)
#pragma unroll
            for (int m = 0; m < 4; ++m) { const int r = row0 + ai * HALF + m * 16; bf16_t* rowp = O + (size_t)r * ldc + col0;
                const float rs = __builtin_amdgcn_rsqf(ss[r] * (1.0f / 1024.0f) + PG8_EPS);
                const f32x4 g0 = acc[ai][0][m][0] * rs + cg[0], g1 = acc[ai][0][m][1] * rs + cg[1], u0 = acc[ai][1][m][0] * rs + cu[0], u1 = acc[ai][1][m][1] * rs + cu[1];
                u32x4 w;
                w.x = cvt_pk_bf16(silu_f(g0[0]) * u0[0], silu_f(g0[1]) * u0[1]); w.y = cvt_pk_bf16(silu_f(g0[2]) * u0[2], silu_f(g0[3]) * u0[3]);
                w.z = cvt_pk_bf16(silu_f(g1[0]) * u1[0], silu_f(g1[1]) * u1[1]); w.w = cvt_pk_bf16(silu_f(g1[2]) * u1[2], silu_f(g1[3]) * u1[3]);
                *(u32x4*)rowp = w; }
    }
};


struct DualOrder {
    StaticOrder s1, s2; const bf16_t* A2; const bf16_t* Bt2;
    __host__ __device__ void init(int M1, int N1, int M2, int N2, int G_, int c_, const bf16_t* a2, const bf16_t* b2) { s1.init(M1, N1, G_, c_); s2.init(M2, N2, G_, c_); A2 = a2; Bt2 = b2; }
    __device__ __forceinline__ bool next(int i, Unit& u) const {
        const long L = (long)i * s1.G + s1.c;
        if (L < s1.nwg) return s1.next(i, u);
        const long L2 = L - s1.nwg; if (L2 >= s2.nwg) return false;
        StaticOrder t = s2; t.c = (int)(L2 % s2.G); const bool ok = t.next((int)(L2 / s2.G), u); u.kind = 1; return ok;
    }
    template <class G_> __device__ __forceinline__ const char* pa(const G_& g, const Unit& u, size_t tstep) const { return (const char*)(u.kind ? A2 : g.A) + (size_t)u.pm * tstep; }
    template <class G_> __device__ __forceinline__ const char* pb(const G_& g, const Unit& u, size_t tstep) const { return (const char*)(u.kind ? Bt2 : g.Bt) + (size_t)u.pn * tstep; }
    __device__ __forceinline__ void a_ready(const Unit&) const {}
    __device__ __forceinline__ void done(const Unit&) const {}
};
struct EpiDualIn {
    static constexpr bool PERM = true, AFTER_DRAIN = false;
    EpiStoreBf16N a; EpiStoreBf16T b;
    __device__ __forceinline__ void operator()(const f32x4 (&acc)[2][2][4][2], const Unit& u, int wr, int wc, int fr, int fq) const { if (u.kind) b(acc, u, wr, wc, fr, fq); else a(acc, u, wr, wc, fr, fq); }
};
template <class Epi, class Sched, bool ALIGN_EPI = false, bool SP2 = false>
__device__ __forceinline__ void gemm_phase(PG8_LAS unsigned char* lds, const Gemm g, const Sched& S, const Epi& E, const int wave0) {
    unsigned z_ = 0u; asm volatile("" : "+v"(z_)); const int lane_ = (int)__builtin_amdgcn_mbcnt_hi(~0u, __builtin_amdgcn_mbcnt_lo(~0u, z_));
    const int tid = (wave0 << 6) | lane_, wid = wave0, lane = lane_, wr = wid >> 2, wc = wid & 3, fr = lane & 15, fq = lane >> 4;
    const int K = g.K, nt = K / BK;
    unsigned voffA[2], voffB[2];
#pragma unroll
    for (int i = 0; i < 2; ++i) { int R, C; stage_rc(tid * 16 + i * 8192, R, C); const int Rb = Epi::PERM ? ((R & ~31) + perm32(R & 31)) : R;
        voffA[i] = (unsigned)(R * K + C) * 2u; voffB[i] = (unsigned)(Rb * K + C) * 2u; }
    const size_t kstep = (size_t)(BK * 2);
    const size_t hstep = (size_t)HALF * K * 2;
    const size_t tstep = 2 * hstep;
    const unsigned ldsw = (unsigned)wid * 1024u;
    const int aoff = lds_byte(wr * 64 + fr, fq * 8), boff = lds_byte(wc * 32 + fr, fq * 8);
#define PG8_SA(b, h) (((b) * 2 + (h)) * HTB)
#define PG8_SB(b, h) ((4 + (b) * 2 + (h)) * HTB)
#define PG8_STAGE(bufoff, gbase, voff) do { _Pragma("unroll") for (int _i = 0; _i < 2; ++_i) \
        __builtin_amdgcn_global_load_lds((const unsigned*)((const char*)(gbase) + (voff)[_i]), (PG8_LAS unsigned*)(lds + (bufoff) + ldsw + _i * 8192), 16, 0, 0); } while (0)
#define PG8_LDA(dst, b, h) do { _Pragma("unroll") for (int m = 0; m < 4; ++m) _Pragma("unroll") for (int k = 0; k < 2; ++k) dst[m][k] = *(const PG8_LAS bf16x8*)(lds + PG8_SA(b, h) + aoff + m * 2048 + k * 1024); } while (0)
#define PG8_LDB(dst, b, h) do { _Pragma("unroll") for (int n = 0; n < 2; ++n) _Pragma("unroll") for (int k = 0; k < 2; ++k) dst[n][k] = *(const PG8_LAS bf16x8*)(lds + PG8_SB(b, h) + boff + n * 2048 + k * 1024); } while (0)
#define PG8_MMA(ai, bj, At, Bt) do { __builtin_amdgcn_s_setprio(1); _Pragma("unroll") for (int m = 0; m < 4; ++m) _Pragma("unroll") for (int n = 0; n < 2; ++n) _Pragma("unroll") for (int k = 0; k < 2; ++k) \
        acc[ai][bj][m][n] = __builtin_amdgcn_mfma_f32_16x16x32_bf16(Bt[n][k], At[m][k], acc[ai][bj][m][n], 0, 0, 0); __builtin_amdgcn_s_setprio(0); } while (0)
#define PG8_WAIT_V(n) asm volatile("s_waitcnt vmcnt(" #n ")" ::: "memory")
#define PG8_WAIT_L(n) asm volatile("s_waitcnt lgkmcnt(" #n ")" ::: "memory")
#define PG8_BAR __builtin_amdgcn_s_barrier()
#define PG8_SCHED __builtin_amdgcn_sched_barrier(0)
    Unit cur, nxt; int ui = 0;
    if (!S.next(0, cur)) return;
    f32x4 acc[2][2][4][2];
#pragma unroll
    for (int a = 0; a < 2; ++a)
#pragma unroll
        for (int b = 0; b < 2; ++b)
#pragma unroll
            for (int m = 0; m < 4; ++m)
#pragma unroll
                for (int n = 0; n < 2; ++n) acc[a][b][m][n] = (f32x4){0.f, 0.f, 0.f, 0.f};
    bf16x8 At[4][2], B0[2][2], B1[2][2];
    const char* cA = S.pa(g, cur, tstep); const char* cB = S.pb(g, cur, tstep);
    S.a_ready(cur);
    if constexpr (SP2) {
        PG8_STAGE(PG8_SB(0, 0), cB, voffB); PG8_STAGE(PG8_SB(0, 1), cB + hstep, voffB); PG8_STAGE(PG8_SA(0, 0), cA, voffA); PG8_STAGE(PG8_SA(0, 1), cA + hstep, voffA);
        if (wr == 1) PG8_BAR;
        PG8_WAIT_V(2); PG8_BAR;
        PG8_STAGE(PG8_SB(1, 0), cB + kstep, voffB); PG8_STAGE(PG8_SA(1, 0), cA + kstep, voffA); PG8_STAGE(PG8_SB(1, 1), cB + hstep + kstep, voffB);
        PG8_WAIT_V(6); PG8_BAR;
    } else {
        PG8_STAGE(PG8_SB(0, 0), cB, voffB); PG8_STAGE(PG8_SA(0, 0), cA, voffA); PG8_STAGE(PG8_SB(0, 1), cB + hstep, voffB); PG8_STAGE(PG8_SA(0, 1), cA + hstep, voffA);
        if (wr == 1) PG8_BAR;
        PG8_WAIT_V(4); PG8_BAR;
        PG8_STAGE(PG8_SB(1, 0), cB + kstep, voffB); PG8_STAGE(PG8_SA(1, 0), cA + kstep, voffA); PG8_STAGE(PG8_SB(1, 1), cB + hstep + kstep, voffB);
        PG8_WAIT_V(6); PG8_BAR;
    }
    for (;;) {
        const bool has_next = S.next(ui + 1, nxt);
        const char* nA = has_next ? S.pa(g, nxt, tstep) : cA; const char* nB = has_next ? S.pb(g, nxt, tstep) : cB;
        for (int t = 0; t < nt; t += 2) {
            const bool last = (t == nt - 2);
            const char* a1 = cA + (size_t)(t + 1) * kstep;
            const char* a2 = last ? nA : cA + (size_t)(t + 2) * kstep; const char* b2 = last ? nB : cB + (size_t)(t + 2) * kstep;
            const char* a3 = a2 + kstep; const char* b3 = b2 + kstep;
            if (last && has_next) S.a_ready(nxt);
            if constexpr (SP2) {
            PG8_LDB(B0, 0, 0); PG8_LDB(B1, 0, 1); PG8_SCHED; PG8_LDA(At, 0, 0); PG8_STAGE(PG8_SA(1, 1), a1 + hstep, voffA);
            PG8_WAIT_V(8); PG8_WAIT_L(0); PG8_BAR; PG8_MMA(0, 0, At, B0); PG8_MMA(0, 1, At, B1); PG8_BAR; PG8_SCHED;
            PG8_LDA(At, 0, 1); PG8_STAGE(PG8_SB(0, 0), b2, voffB); PG8_STAGE(PG8_SB(0, 1), b2 + hstep, voffB); PG8_STAGE(PG8_SA(0, 0), a2, voffA);
            PG8_WAIT_V(8); PG8_WAIT_L(0); PG8_BAR; PG8_MMA(1, 0, At, B0); PG8_MMA(1, 1, At, B1); PG8_BAR; PG8_SCHED;
            PG8_LDB(B0, 1, 0); PG8_LDB(B1, 1, 1); PG8_SCHED; PG8_LDA(At, 1, 0); PG8_STAGE(PG8_SA(0, 1), a2 + hstep, voffA);
            PG8_WAIT_V(8); PG8_WAIT_L(0); PG8_BAR; PG8_MMA(0, 0, At, B0); PG8_MMA(0, 1, At, B1); PG8_BAR; PG8_SCHED;
            PG8_LDA(At, 1, 1); PG8_STAGE(PG8_SB(1, 0), b3, voffB); PG8_STAGE(PG8_SB(1, 1), b3 + hstep, voffB); PG8_STAGE(PG8_SA(1, 0), a3, voffA);
            PG8_WAIT_V(8); PG8_WAIT_L(0); PG8_BAR; PG8_MMA(1, 0, At, B0); PG8_MMA(1, 1, At, B1); PG8_BAR; PG8_SCHED;
            } else {
            PG8_LDB(B0, 0, 0); PG8_SCHED; PG8_LDA(At, 0, 0); PG8_STAGE(PG8_SA(1, 1), a1 + hstep, voffA);
            PG8_WAIT_L(8); PG8_BAR; PG8_WAIT_L(0); PG8_MMA(0, 0, At, B0); PG8_BAR; PG8_SCHED;
            PG8_LDB(B1, 0, 1); PG8_STAGE(PG8_SB(0, 0), b2, voffB);
            PG8_BAR; PG8_WAIT_L(0); PG8_MMA(0, 1, At, B1); PG8_BAR;
            PG8_LDA(At, 0, 1); PG8_STAGE(PG8_SA(0, 0), a2, voffA);
            PG8_BAR; PG8_WAIT_L(0); PG8_MMA(1, 0, At, B0); PG8_BAR; PG8_SCHED;
            PG8_STAGE(PG8_SB(0, 1), b2 + hstep, voffB);
            PG8_WAIT_V(6); PG8_BAR; PG8_MMA(1, 1, At, B1); PG8_BAR;
            PG8_LDB(B0, 1, 0); PG8_SCHED; PG8_LDA(At, 1, 0); PG8_STAGE(PG8_SA(0, 1), a2 + hstep, voffA);
            PG8_WAIT_L(8); PG8_BAR; PG8_WAIT_L(0); PG8_MMA(0, 0, At, B0); PG8_BAR; PG8_SCHED;
            PG8_LDB(B1, 1, 1); PG8_STAGE(PG8_SB(1, 0), b3, voffB);
            PG8_BAR; PG8_WAIT_L(0); PG8_MMA(0, 1, At, B1); PG8_BAR;
            PG8_LDA(At, 1, 1); PG8_STAGE(PG8_SA(1, 0), a3, voffA);
            PG8_BAR; PG8_WAIT_L(0); PG8_MMA(1, 0, At, B0); PG8_BAR; PG8_SCHED;
            PG8_STAGE(PG8_SB(1, 1), b3 + hstep, voffB);
            PG8_WAIT_V(6); PG8_BAR; PG8_MMA(1, 1, At, B1); PG8_BAR;
            }
        }
        if constexpr (ALIGN_EPI) { if (wr == 0) PG8_BAR; }
        if constexpr (!Epi::AFTER_DRAIN) { E(acc, cur, wr, wc, fr, fq); S.done(cur); }
        if (!has_next) break;
#pragma unroll
        for (int a = 0; a < 2; ++a)
#pragma unroll
            for (int b = 0; b < 2; ++b)
#pragma unroll
                for (int m = 0; m < 4; ++m)
#pragma unroll
                    for (int n = 0; n < 2; ++n) acc[a][b][m][n] = (f32x4){0.f, 0.f, 0.f, 0.f};
        cur = nxt; cA = nA; cB = nB; ++ui;
        if constexpr (ALIGN_EPI) { if (wr == 1) PG8_BAR; }
    }
    PG8_WAIT_V(0);
    if constexpr (!ALIGN_EPI) { if (wr == 0) PG8_BAR; }
    PG8_BAR;
    if constexpr (Epi::AFTER_DRAIN) { E.fused(acc, cur, wr, wc, fr, fq, lds, wid, lane); S.done(cur); }
#undef PG8_SA
#undef PG8_SB
#undef PG8_STAGE
#undef PG8_LDA
#undef PG8_LDB
#undef PG8_MMA
#undef PG8_WAIT_V
#undef PG8_WAIT_L
#undef PG8_BAR
#undef PG8_SCHED
}
}

constexpr int NB = 16, SEQ = 2048, DM = 1024, MTOK = NB * SEQ, DEPTH = 2;
constexpr int P_IN = 3608, FFH = 2816, UL = 2816, NTR = 1024;
constexpr int C_SZ = 0, C_SX = 256, C_SB = 512, C_SC = 768, C_NQ = 1024, C_NK = 1280, C_MQ = 1536, C_MK = 1792, C_MV = 2048, C_MO = 2304, C_G = 2560;
constexpr int TP = MTOK + 128;
constexpr int R_HY = 0, R_NV = 768;
constexpr float EPS = 1e-6f;
constexpr int NWAVES = 8, NTHR = 512;
constexpr size_t MiB = 1u << 20;
constexpr size_t WS_CTL = 0, WS_SS = 64 * 1024, CTL_ZERO_BYTES = 64 * 1024 + 5 * 131072;
constexpr size_t WS_MOD = 1 * MiB, WS_HID2 = 2 * MiB, WS_DT = 3 * MiB, WS_FILT = 4 * MiB, WS_W = 12 * MiB;
constexpr size_t W_IN_OFF = 0, W_HY_OFF = 5 * MiB + MiB / 2, W_OUT_OFF = 7 * MiB + MiB / 2, W_GU_OFF = 9 * MiB + MiB / 2, W_DN_OFF = 20 * MiB + MiB / 2, W_LAYER = 26 * MiB;
constexpr size_t WS_XN = 64 * MiB, WS_U = 128 * MiB, WS_UHT = 320 * MiB, WS_YS = 386 * MiB, WS_NAO = 418 * MiB, WS_MLH = 434 * MiB, WS_HYO = 466 * MiB, WS_CV = 484 * MiB, WS_END = 486 * MiB;
constexpr size_t WS_XN2 = WS_UHT;
constexpr int CVP = 9472;
constexpr int LDS_BYTES = 147456, MISC_OFF = 147456 - 128;

#define GAS __attribute__((address_space(1)))
#define LAS __attribute__((address_space(3)))
typedef unsigned short bf16;
typedef unsigned v4u __attribute__((ext_vector_type(4)));
typedef float f32x4 __attribute__((ext_vector_type(4)));
typedef __bf16 bf16v2 __attribute__((ext_vector_type(2)));
typedef float f32v2 __attribute__((ext_vector_type(2)));
__device__ __forceinline__ unsigned pk2(float lo, float hi) { const f32v2 v = {lo, hi}; return __builtin_bit_cast(unsigned, __builtin_convertvector(v, bf16v2)); }
__device__ __forceinline__ unsigned f2bf(float f) { return (unsigned)__builtin_bit_cast(unsigned short, (__bf16)f); }
__device__ __forceinline__ float bf2f(unsigned h) { return __builtin_bit_cast(float, h << 16); }
__device__ __forceinline__ float bflo(unsigned w) { return __builtin_bit_cast(float, w << 16); }
__device__ __forceinline__ float bfhi(unsigned w) { return __builtin_bit_cast(float, w & 0xffff0000u); }
template <int CTRL> __device__ __forceinline__ float dpp_f(float v, float fill) { return __builtin_bit_cast(float, __builtin_amdgcn_update_dpp(__builtin_bit_cast(int, fill), __builtin_bit_cast(int, v), CTRL, 0xf, 0xf, false)); }
__device__ __forceinline__ float rdlane_f(float v, int l) { return __builtin_bit_cast(float, __builtin_amdgcn_readlane(__builtin_bit_cast(int, v), l)); }
__device__ __forceinline__ float row_sum16(float v) { v += dpp_f<0xB1>(v, 0.f); v += dpp_f<0x4E>(v, 0.f); v += dpp_f<0x141>(v, 0.f); v += dpp_f<0x140>(v, 0.f); return v; }
__device__ __forceinline__ float wave_sum(float v) { v = row_sum16(v); return (rdlane_f(v, 0) + rdlane_f(v, 16)) + (rdlane_f(v, 32) + rdlane_f(v, 48)); }
__device__ __forceinline__ float wave_max(float v) {
    v = fmaxf(v, dpp_f<0xB1>(v, v)); v = fmaxf(v, dpp_f<0x4E>(v, v)); v = fmaxf(v, dpp_f<0x141>(v, v)); v = fmaxf(v, dpp_f<0x140>(v, v));
    return fmaxf(fmaxf(rdlane_f(v, 0), rdlane_f(v, 16)), fmaxf(rdlane_f(v, 32), rdlane_f(v, 48)));
}
__device__ __forceinline__ float sigmoid_f(float v) { return __builtin_amdgcn_rcpf(1.0f + __expf(-v)); }
__device__ __forceinline__ float silu_ff(float v) { return v * __builtin_amdgcn_rcpf(1.0f + __expf(-v)); }
__device__ __forceinline__ float softplus_f(float v) { return v > 20.f ? v : log1pf(__expf(v)); }

__device__ __forceinline__ int fresh_tid(int wave0) { unsigned z = 0u; asm volatile("" : "+v"(z)); const int l = (int)__builtin_amdgcn_mbcnt_hi(~0u, __builtin_amdgcn_mbcnt_lo(~0u, z)); return (wave0 << 6) | l; }
typedef short bf16x8 __attribute__((ext_vector_type(8)));
#define MFMA16(a, b, c) __builtin_amdgcn_mfma_f32_16x16x32_bf16((a), (b), (c), 0, 0, 0)
struct Args { const float* in[31]; float* out; unsigned char* ws; int ph_lo, ph_hi; };

struct Ctx {
    LAS unsigned char* lds;
    int tid, lane, wave, bid, G, wave0;
    const Args* A; float* out; unsigned char* ws;
};
#define INP(i) (F.A->in[i])

__device__ __forceinline__ const float* wsrc(const Ctx& F, int which, int l, int j, int* ld) {
    if (which == 0) { *ld = P_IN; const float* w = INP(4) + (size_t)l * DM * P_IN;
        int o; if (j < 1024) o = j; else if (j < 1536) o = 1032 + (j - 1024); else if (j < 2560) o = 1800 + (j - 1536); else if (j < 2568) o = 1024 + (j - 2560); else if (j < 2584) o = 2824 + (j - 2568); else return nullptr;
        return w + o; }
    if (which == 1) { *ld = P_IN; return INP(4) + (size_t)l * DM * P_IN + (j < 768 ? 2840 + j : 1544 + (j - 768)); }
    if (which == 2) { *ld = DM; return INP(26) + (size_t)l * DM * DM + j; }
    if (which == 3) { *ld = FFH; const int t = j >> 8, w = j & 255; return (w < 128 ? INP(27) : INP(28)) + (size_t)l * DM * FFH + t * 128 + (w & 127); }
    *ld = DM; return INP(29) + (size_t)l * FFH * DM + j;
}
__device__ __forceinline__ void transpose_item(const Ctx& F, int which, int l, int K, bf16* WT, LAS float* scr, int item, int nblk) {
    const int lane = F.lane, kb = item / nblk, nb = item % nblk, k0 = 64 * kb, n0 = 32 * nb;
    int ld = 0; const float* cp = wsrc(F, which, l, n0 + (lane & 31), &ld);
    float tv[32];
#pragma unroll
    for (int i = 0; i < 32; ++i) { const int kk = 2 * i + (lane >> 5); tv[i] = cp ? cp[(size_t)(k0 + kk) * ld] : 0.f; }
#pragma unroll
    for (int i = 0; i < 32; ++i) { const int kk = 2 * i + (lane >> 5); scr[kk * 33 + (lane & 31)] = tv[i]; }
    asm volatile("s_waitcnt lgkmcnt(0)" ::: "memory");
    const int c = lane & 7;
#pragma unroll
    for (int j = 0; j < 4; ++j) { const int n = (lane >> 3) + 8 * j; const LAS float* s = scr + (8 * c) * 33 + n;
        v4u o; o.x = pk2(s[0 * 33], s[1 * 33]); o.y = pk2(s[2 * 33], s[3 * 33]); o.z = pk2(s[4 * 33], s[5 * 33]); o.w = pk2(s[6 * 33], s[7 * 33]);
        *(v4u*)(WT + (size_t)(n0 + n) * K + k0 + 8 * c) = o; }
    asm volatile("s_waitcnt lgkmcnt(0)" ::: "memory");
}
__device__ __forceinline__ void ph_prologue(Ctx& F) {
    const int gw = F.bid * NWAVES + F.wave, NGW = F.G * NWAVES, lane = F.lane;
    LAS float* scr = (LAS float*)(F.lds + F.wave * 16384);
    constexpr int I_IN = 16 * 88, I_HY = 16 * 32, I_OUT = 16 * 32, I_GU = 16 * 176, I_DN = 44 * 32, I_L = I_IN + I_HY + I_OUT + I_GU + I_DN;
    for (int it = gw; it < DEPTH * I_L; it += NGW) {
        const int l = it / I_L; int r = it % I_L; unsigned char* wb = F.ws + WS_W + (size_t)l * W_LAYER;
        if (r < I_IN) { transpose_item(F, 0, l, DM, (bf16*)(wb + W_IN_OFF), scr, r, 88); continue; } r -= I_IN;
        if (r < I_HY) { transpose_item(F, 1, l, DM, (bf16*)(wb + W_HY_OFF), scr, r, 32); continue; } r -= I_HY;
        if (r < I_OUT) { transpose_item(F, 2, l, DM, (bf16*)(wb + W_OUT_OFF), scr, r, 32); continue; } r -= I_OUT;
        if (r < I_GU) { transpose_item(F, 3, l, DM, (bf16*)(wb + W_GU_OFF), scr, r, 176); continue; } r -= I_GU;
        transpose_item(F, 4, l, FFH, (bf16*)(wb + W_DN_OFF), scr, r, 32);
    }
    for (int it = gw; it < DEPTH * SEQ; it += NGW) {
        const int l = it / SEQ, pos = it % SEQ;
        const float* w1 = INP(18) + l * 33 * 64; const float* b1 = INP(19) + l * 64; const float* w2 = INP(20) + l * 64 * 64; const float* b2 = INP(21) + l * 64; const float* fq = INP(23) + l * 128;
        const float t = (float)pos / 2047.0f;
        float z = b1[lane] + t * w1[lane];
        const float rev = (float)pos / 2048.0f;
#pragma unroll
        for (int i = 0; i < 16; ++i) { const float f = 1e-4f + (float)i * ((15.0f - 1e-4f) / 15.0f); float a = rev * f; a -= floorf(a);
            z += __builtin_amdgcn_cosf(a) * w1[(1 + i) * 64 + lane]; z -= __builtin_amdgcn_sinf(a) * w1[(17 + i) * 64 + lane]; }
        float y1 = fq[lane] * z * 0.15915494309189535f; y1 -= floorf(y1);
        const float h1 = __builtin_amdgcn_sinf(y1);
        float z2 = b2[lane];
        for (int i = 0; i < 64; ++i) z2 += __shfl(h1, i) * w2[i * 64 + lane];
        float y2 = fq[64 + lane] * z2 * 0.15915494309189535f; y2 -= floorf(y2);
        const float h2 = __builtin_amdgcn_sinf(y2);
        ((float*)(F.ws + WS_HID2))[(size_t)it * 64 + lane] = h2;
    }
    __syncthreads();
    LAS float* cond = (LAS float*)F.lds; LAS float* part = (LAS float*)(F.lds + 65536);
    if (F.bid < 192) {
        for (int i = F.tid; i < NB * DM; i += NTHR) cond[i] = silu_ff(INP(1)[i]);
        __syncthreads();
        for (int it = F.bid; it < 192; it += F.G) {
            const int l = it / 96, n0 = (it % 96) * 64;
            const float* W = INP(2) + (size_t)l * DM * 6144 + n0 + lane;
            float acc[16];
#pragma unroll
            for (int b = 0; b < 16; ++b) acc[b] = 0.f;
            const int kb = F.wave * 128;
            for (int k8 = 0; k8 < 128; k8 += 16) { float wv[16];
#pragma unroll
                for (int j = 0; j < 16; ++j) wv[j] = W[(size_t)(kb + k8 + j) * 6144];
#pragma unroll
                for (int j = 0; j < 16; ++j)
#pragma unroll
                    for (int b = 0; b < 16; ++b) acc[b] += cond[b * DM + kb + k8 + j] * wv[j]; }
#pragma unroll
            for (int b = 0; b < 16; ++b) part[(F.wave * 16 + b) * 64 + lane] = acc[b];
            __syncthreads();
            for (int o = F.tid; o < 1024; o += NTHR) { const int b = o >> 6, cidx = o & 63; float s = INP(3)[l * 6144 + n0 + cidx];
#pragma unroll
                for (int w = 0; w < 8; ++w) s += part[(w * 16 + b) * 64 + cidx];
                ((float*)(F.ws + WS_MOD))[(size_t)(l * NB + b) * 6144 + n0 + cidx] = s; }
            __syncthreads();
        }
    }
}

__device__ __forceinline__ void ph_xn0(Ctx& F, const float* mod_l) {
    const int gw = F.bid * NWAVES + F.wave, NGW = F.G * NWAVES;
    bf16* XN = (bf16*)(F.ws + WS_XN); float* ss = (float*)(F.ws + WS_SS);
    for (int m0 = gw * 4; m0 < MTOK; m0 += NGW * 4) {
        f32x4 v[4][4], sc[4][4];
#pragma unroll
        for (int u = 0; u < 4; ++u) { const int m = m0 + u; const f32x4* xr = (const f32x4*)(INP(0) + (size_t)m * DM) + F.lane; const float* mb = mod_l + (size_t)(m >> 11) * 6144 + 1024;
#pragma unroll
            for (int j = 0; j < 4; ++j) { v[u][j] = xr[64 * j]; sc[u][j] = *((const f32x4*)mb + F.lane + 64 * j); } }
#pragma unroll
        for (int u = 0; u < 4; ++u) { const int m = m0 + u; float s = 0.f;
#pragma unroll
            for (int j = 0; j < 4; ++j) s += (v[u][j].x * v[u][j].x + v[u][j].y * v[u][j].y) + (v[u][j].z * v[u][j].z + v[u][j].w * v[u][j].w);
            s = wave_sum(s); if (F.lane == 0) ss[m] = s;
            unsigned long long* o8 = (unsigned long long*)(XN + (size_t)m * DM) + F.lane;
#pragma unroll
            for (int j = 0; j < 4; ++j) o8[64 * j] = (unsigned long long)pk2(v[u][j].x * (1.f + sc[u][j].x), v[u][j].y * (1.f + sc[u][j].y)) | ((unsigned long long)pk2(v[u][j].z * (1.f + sc[u][j].z), v[u][j].w * (1.f + sc[u][j].w)) << 32); }
    }
}
__device__ __forceinline__ void ph_final(Ctx& F) {
    const float* g = INP(30); const float* ss = (const float*)(F.ws + WS_SS) + 4 * MTOK;
    const int gt = F.bid * NTHR + F.tid, NT = F.G * NTHR;
    for (int i0 = gt; i0 < MTOK * (DM / 4); i0 += 8 * NT) { f32x4 xv[8]; float sv[8];
#pragma unroll
        for (int u = 0; u < 8; ++u) { const int i = i0 + u * NT; xv[u] = ((const f32x4*)F.out)[i]; sv[u] = ss[i >> 8]; }
#pragma unroll
        for (int u = 0; u < 8; ++u) { const int i = i0 + u * NT; ((f32x4*)F.out)[i] = xv[u] * __builtin_amdgcn_rsqf(sv[u] * (1.f / DM) + EPS) * *((const f32x4*)g + (i & 255)); } }
}
__device__ __forceinline__ void ph_cvec(Ctx& F) {
    const int gw = F.bid * NWAVES + F.wave, NGW = F.G * NWAVES, lane = F.lane, fr = lane & 15, fg = lane >> 4;
    for (int it = gw; it < DEPTH * (CVP / 16); it += NGW) {
        const int l = it / (CVP / 16), n0 = (it % (CVP / 16)) * 16; unsigned char* wb = F.ws + WS_W + (size_t)l * W_LAYER;
        const bf16* wt = n0 < 2816 ? (const bf16*)(wb + W_IN_OFF) + (size_t)n0 * DM : n0 < 3840 ? (const bf16*)(wb + W_HY_OFF) + (size_t)(n0 - 2816) * DM : (const bf16*)(wb + W_GU_OFF) + (size_t)(n0 - 3840) * DM;
        const float* sh = (const float*)(F.ws + WS_MOD) + (size_t)(l * NB + fr) * 6144 + (n0 < 3840 ? 0 : 3072) + 8 * fg;
        const bf16* wp = wt + (size_t)fr * DM + 8 * fg;
        f32x4 acc = (f32x4){0.f, 0.f, 0.f, 0.f};
#pragma unroll 8
        for (int ks = 0; ks < 32; ++ks) { const f32x4 a0 = *(const f32x4*)(sh + 32 * ks), a1 = *(const f32x4*)(sh + 32 * ks + 4);
            v4u aw; aw[0] = pk2(a0[0], a0[1]); aw[1] = pk2(a0[2], a0[3]); aw[2] = pk2(a1[0], a1[1]); aw[3] = pk2(a1[2], a1[3]);
            acc = MFMA16(__builtin_bit_cast(bf16x8, aw), *(const bf16x8*)(wp + 32 * ks), acc); }
        float* cvo = (float*)(F.ws + WS_CV) + (size_t)l * NB * CVP + n0 + fr;
#pragma unroll
        for (int r = 0; r < 4; ++r) cvo[(size_t)(4 * fg + r) * CVP] = acc[r];
    }
}

__device__ __forceinline__ void ph_filters(Ctx& F) {
    const int lane = F.lane, fr = lane & 15, fg = lane >> 4, w = F.wave;
    for (int it = F.bid; it < DEPTH * 2 * 32; it += F.G) {
        const int l = it >> 6, o = (it >> 5) & 1, co = it & 31;
        const int dir = fr >> 3, ch = co * 8 + (fr & 7);
        const float* w3 = INP(22) + (size_t)l * 64 * 1024 + o * 512 + dir * 256 + ch;
        bf16x8 bw[2], bwl[2];
#pragma unroll
        for (int ks = 0; ks < 2; ++ks) { v4u pw, pl;
#pragma unroll
            for (int e = 0; e < 4; ++e) { const float x0 = w3[(size_t)(32 * ks + 8 * fg + 2 * e) * 1024], x1 = w3[(size_t)(32 * ks + 8 * fg + 2 * e + 1) * 1024];
                pw[e] = pk2(x0, x1); pl[e] = pk2(x0 - bflo(pw[e]), x1 - bfhi(pw[e])); }
            bw[ks] = __builtin_bit_cast(bf16x8, pw); bwl[ks] = __builtin_bit_cast(bf16x8, pl); }
        const float delta = 3.0701134573253945f + (float)ch * ((15.350567286626972f - 3.0701134573253945f) / 255.0f);
        const float* hid = (const float*)(F.ws + WS_HID2) + (size_t)l * SEQ * 64 + (size_t)(256 * w + fr) * 64 + 8 * fg;
        float ss = 0.f;
        LAS f32x4* vals = (LAS f32x4*)F.lds + (size_t)w * 16 * 64 + lane;
#pragma unroll 2
        for (int ii = 0; ii < 16; ++ii) { const float* hp = hid + (size_t)(16 * ii) * 64;
            const f32x4 h0 = *(const f32x4*)hp, h1 = *(const f32x4*)(hp + 4), h2 = *(const f32x4*)(hp + 32), h3 = *(const f32x4*)(hp + 36);
            v4u pa, pb, qa, qb;
#pragma unroll
            for (int e = 0; e < 2; ++e) { pa[e] = pk2(h0[2 * e], h0[2 * e + 1]); pa[2 + e] = pk2(h1[2 * e], h1[2 * e + 1]); pb[e] = pk2(h2[2 * e], h2[2 * e + 1]); pb[2 + e] = pk2(h3[2 * e], h3[2 * e + 1]);
                qa[e] = pk2(h0[2 * e] - bflo(pa[e]), h0[2 * e + 1] - bfhi(pa[e])); qa[2 + e] = pk2(h1[2 * e] - bflo(pa[2 + e]), h1[2 * e + 1] - bfhi(pa[2 + e]));
                qb[e] = pk2(h2[2 * e] - bflo(pb[e]), h2[2 * e + 1] - bfhi(pb[e])); qb[2 + e] = pk2(h3[2 * e] - bflo(pb[2 + e]), h3[2 * e + 1] - bfhi(pb[2 + e])); }
            f32x4 a = (f32x4){0.f, 0.f, 0.f, 0.f};
            a = MFMA16(__builtin_bit_cast(bf16x8, qa), bw[0], a); a = MFMA16(__builtin_bit_cast(bf16x8, qb), bw[1], a);
            a = MFMA16(__builtin_bit_cast(bf16x8, pa), bwl[0], a); a = MFMA16(__builtin_bit_cast(bf16x8, pb), bwl[1], a);
            a = MFMA16(__builtin_bit_cast(bf16x8, pa), bw[0], a); a = MFMA16(__builtin_bit_cast(bf16x8, pb), bw[1], a);
#pragma unroll
            for (int r = 0; r < 4; ++r) { const int p = 256 * w + 16 * ii + 4 * fg + r; a[r] *= __expf(-((float)p / 2047.0f) * delta); ss += a[r] * a[r]; }
            vals[ii * 64] = a; }
        ss += __shfl_xor(ss, 8); ss += __shfl_xor(ss, 16); ss += __shfl_xor(ss, 32);
        LAS float* red = (LAS float*)(F.lds + 131072);
        __syncthreads();
        if (lane < 8) red[w * 8 + lane] = ss;
        __syncthreads();
        float tot = 0.f;
#pragma unroll
        for (int q = 0; q < 8; ++q) tot += red[q * 8 + (fr & 7)];
        const float scale = 1.0f / sqrtf(tot + EPS);
        bf16* fo = (bf16*)(F.ws + WS_FILT) + ((size_t)((l * 2 + o) * 256 + ch)) * 4096 + 2048;
#pragma unroll 2
        for (int ii = 0; ii < 16; ++ii) { const f32x4 a = vals[ii * 64];
#pragma unroll
            for (int r = 0; r < 4; ++r) { const int p = 256 * w + 16 * ii + 4 * fg + r; const unsigned short v = (unsigned short)f2bf(a[r] * scale);
                const bool unused = dir == 1 && p == 0;
                fo[unused ? -2048 : (dir == 0 ? -p : p)] = unused ? (unsigned short)0 : v; } }
    }
}

__device__ __forceinline__ void ph_prepass(Ctx& F, int l) {
    const bf16* U = (const bf16*)(F.ws + WS_U); bf16* XBC = (bf16*)(F.ws + WS_XN); float* DT = (float*)(F.ws + WS_DT);
    const float* cw = INP(5) + l * 3 * 768; const float* cb = INP(6) + l * 768; const float* dtb = INP(7) + l * 8;
    const int gt = F.bid * NTHR + F.tid, NT = F.G * NTHR;
    for (int it0 = gt; it0 < MTOK * 96; it0 += 4 * NT) {
        v4u um[4], u0[4], upn[4];
#pragma unroll
        for (int u = 0; u < 4; ++u) { const int it = it0 + u * NT, tok = it / 96, cg = it % 96; const bf16* up = U + (size_t)tok * UL + C_SX + cg * 8;
            um[u] = *(const v4u*)(up - UL); u0[u] = *(const v4u*)up; upn[u] = *(const v4u*)(up + UL); }
#pragma unroll
        for (int u = 0; u < 4; ++u) { const int it = it0 + u * NT, tok = it / 96, cg = it % 96, t = tok & (SEQ - 1), c0 = cg * 8;
            const v4u z4 = {0u, 0u, 0u, 0u}; const v4u a = t > 0 ? um[u] : z4, b = u0[u], cc = t < SEQ - 1 ? upn[u] : z4;
            float r[8];
#pragma unroll
            for (int q = 0; q < 4; ++q) {
                const int c = c0 + 2 * q;
                const float a0 = cw[c] * bflo(a[q]) + cw[768 + c] * bflo(b[q]) + cw[1536 + c] * bflo(cc[q]) + cb[c];
                const float a1 = cw[c + 1] * bfhi(a[q]) + cw[768 + c + 1] * bfhi(b[q]) + cw[1536 + c + 1] * bfhi(cc[q]) + cb[c + 1];
                r[2 * q] = silu_ff(a0); r[2 * q + 1] = silu_ff(a1); }
            v4u o; o.x = pk2(r[0], r[1]); o.y = pk2(r[2], r[3]); o.z = pk2(r[4], r[5]); o.w = pk2(r[6], r[7]);
            *(v4u*)(XBC + (size_t)tok * 768 + c0) = o; }
    }
    for (int it = gt; it < MTOK * 8; it += NT) { const int tok = it >> 3, j = it & 7;
        DT[it] = softplus_f(bf2f(U[(size_t)tok * UL + C_G + j]) + dtb[j]); }
}

typedef short s16x4 __attribute__((ext_vector_type(4)));
typedef unsigned u2v __attribute__((ext_vector_type(2)));
__device__ __forceinline__ bf16x8 lds_b128(LAS unsigned char* p) { return *(LAS bf16x8*)p; }
__device__ __forceinline__ bf16x8 lds_tr8(LAS unsigned char* base, int pitch, int lane) {
    const int fg = lane >> 4, q = (lane & 15) >> 2, p = lane & 3;
    LAS unsigned char* a = base + (8 * fg + q) * pitch + 8 * p;
    const s16x4 lo = __builtin_amdgcn_ds_read_tr16_b64_v4i16((LAS s16x4*)a);
    const s16x4 hi = __builtin_amdgcn_ds_read_tr16_b64_v4i16((LAS s16x4*)(a + 4 * pitch));
    bf16x8 r; r[0] = lo[0]; r[1] = lo[1]; r[2] = lo[2]; r[3] = lo[3]; r[4] = hi[0]; r[5] = hi[1]; r[6] = hi[2]; r[7] = hi[3]; return r;
}
__device__ __forceinline__ float wave_incl_sum(float a, int lane) {
    a += dpp_f<0x111>(a, 0.f); a += dpp_f<0x112>(a, 0.f); a += dpp_f<0x114>(a, 0.f); a += dpp_f<0x118>(a, 0.f);
    const float t0 = rdlane_f(a, 15), t1 = rdlane_f(a, 31), t2 = rdlane_f(a, 47); const int row = lane >> 4;
    return a + (row == 0 ? 0.f : row == 1 ? t0 : row == 2 ? t0 + t1 : (t0 + t1) + t2);
}
__device__ __forceinline__ float wave_incl_max(float a, int lane) {
    a = fmaxf(a, dpp_f<0x111>(a, a)); a = fmaxf(a, dpp_f<0x112>(a, a)); a = fmaxf(a, dpp_f<0x114>(a, a)); a = fmaxf(a, dpp_f<0x118>(a, a));
    const float t0 = rdlane_f(a, 15), t1 = rdlane_f(a, 31), t2 = rdlane_f(a, 47); const int row = lane >> 4;
    return row == 0 ? a : fmaxf(a, row == 1 ? t0 : row == 2 ? fmaxf(t0, t1) : fmaxf(fmaxf(t0, t1), t2));
}
constexpr int SP_C = 272, SP_X = 144;
constexpr int SB_CS = 0, SB_BS = 17408, SB_XD = 34816, SB_XW = 44032, SB_SIZE = 53248, S_SC = 106496, S_SBF = 115712;
__device__ __forceinline__ void ssd_item(Ctx& F, int l, int it) {
    const int b = it >> 3, dir = (it >> 2) & 1, h = it & 3, grp = h >> 1;
    const int tid = F.tid, lane = F.lane, w = F.wave, fr = lane & 15, fg = lane >> 4, tb = w >> 1, half = w & 1;
    const bf16* XBC = (const bf16*)(F.ws + WS_XN); const float* DT = (const float*)(F.ws + WS_DT);
    bf16* YS = (bf16*)(F.ws + WS_YS) + (size_t)dir * MTOK * 256;
    const float A = -__expf(INP(8)[l * 8 + dir * 4 + h]); const float Dk = dir == 0 ? INP(9)[l * 4 + h] : 0.f;
    LAS unsigned char* L = F.lds;
#define SSD_TOK(c, tau) ((size_t)b * SEQ + (dir ? SEQ - 1 - ((c) * 64 + (tau)) : (c) * 64 + (tau)))
    f32x4 sacc[4];
#pragma unroll
    for (int i = 0; i < 4; ++i) sacc[i] = (f32x4){0.f, 0.f, 0.f, 0.f};
    for (int i = tid; i < 17408 / 16; i += NTHR) *(LAS v4u*)(L + S_SBF + 16 * i) = (v4u){0u, 0u, 0u, 0u};
    v4u pc0[2], pbv0[2], px0, pc1[2], pbv1[2], px1; float pdt0, pdt1;
#define SSD_LOAD(c, S) do { \
        _Pragma("unroll") for (int k = 0; k < 2; ++k) { const int idx = tid + 512 * k, tau = idx >> 4, ch = idx & 15; const bf16* rp = XBC + SSD_TOK(c, tau) * 768 + grp * 128 + 8 * ch; \
            pbv##S[k] = *(const v4u*)(rp + 256); pc##S[k] = *(const v4u*)(rp + 512); } \
        { const int tau = tid >> 3, ch = tid & 7; px##S = *(const v4u*)(XBC + SSD_TOK(c, tau) * 768 + h * 64 + 8 * ch); } \
        pdt##S = DT[SSD_TOK(c, lane) * 8 + dir * 4 + h]; } while (0)
#define SSD_STAGE(bo, dtv, acum, alast, S) do { \
        _Pragma("unroll") for (int k = 0; k < 2; ++k) { const int idx = tid + 512 * k, tau = idx >> 4, ch = idx & 15; \
            *(LAS v4u*)(L + (bo) + SB_BS + tau * SP_C + ch * 16) = pbv##S[k]; *(LAS v4u*)(L + (bo) + SB_CS + tau * SP_C + ch * 16) = pc##S[k]; } \
        { const int tau = tid >> 3, ch = tid & 7; const float dts = __shfl(dtv, tau), es = __expf((alast) - __shfl(acum, tau)) * dts; v4u od, ow; \
          _Pragma("unroll") for (int e = 0; e < 4; ++e) { const float x0 = bflo(px##S[e]), x1 = bfhi(px##S[e]); od[e] = pk2(x0 * dts, x1 * dts); ow[e] = pk2(x0 * es, x1 * es); } \
          *(LAS v4u*)(L + (bo) + SB_XD + tau * SP_X + ch * 16) = od; *(LAS v4u*)(L + (bo) + SB_XW + tau * SP_X + ch * 16) = ow; } } while (0)
#define SSD_CHUNK(c, CS, NS) do { \
        const int bo = ((c) & 1) * SB_SIZE; \
        __syncthreads();                                                       \
        if ((c) + 2 < 32) SSD_LOAD((c) + 2, CS); \
        bf16x8 ca[4]; \
        _Pragma("unroll") for (int ks = 0; ks < 4; ++ks) ca[ks] = lds_b128(L + bo + SB_CS + (16 * tb + fr) * SP_C + (32 * ks + 8 * fg) * 2); \
        f32x4 yoff[2];                                                         \
        _Pragma("unroll") for (int pbi = 0; pbi < 2; ++pbi) { yoff[pbi] = (f32x4){0.f, 0.f, 0.f, 0.f}; \
            _Pragma("unroll") for (int ks = 0; ks < 4; ++ks) yoff[pbi] = MFMA16(lds_b128(L + S_SBF + (16 * (2 * half + pbi) + fr) * SP_C + (32 * ks + 8 * fg) * 2), ca[ks], yoff[pbi]); } \
        const int tlc = 16 * tb + fr; const float atc = __shfl(acum, tlc), dtc = __shfl(dtv, tlc); \
        _Pragma("unroll") for (int sbi = 0; sbi < 2; ++sbi) { const int sb = 2 * half + sbi; f32x4 g = (f32x4){0.f, 0.f, 0.f, 0.f};     \
            if (sb <= tb) { \
                _Pragma("unroll") for (int ks = 0; ks < 4; ++ks) g = MFMA16(lds_b128(L + bo + SB_BS + (16 * sb + fr) * SP_C + (32 * ks + 8 * fg) * 2), ca[ks], g); } \
            float sv[4]; \
            _Pragma("unroll") for (int r = 0; r < 4; ++r) { const int sl = 16 * sb + 4 * fg + r; const float as_ = __shfl(acum, sl); \
                float v = sl <= tlc ? g[r] * __expf(atc - as_) : 0.f; if (sl == tlc) v += Dk * __builtin_amdgcn_rcpf(dtc); sv[r] = v; } \
            u2v so; so.x = pk2(sv[0], sv[1]); so.y = pk2(sv[2], sv[3]); *(LAS u2v*)(L + S_SC + tlc * SP_X + (16 * sb + 4 * fg) * 2) = so; } \
        { const float dec = __expf(alast); \
          _Pragma("unroll") for (int i = 0; i < 4; ++i) sacc[i] *= dec; \
          _Pragma("unroll") for (int ks = 0; ks < 2; ++ks) { const bf16x8 af = lds_tr8(L + bo + SB_BS + (32 * ks) * SP_C + (16 * w) * 2, SP_C, lane); \
              _Pragma("unroll") for (int pb = 0; pb < 4; ++pb) sacc[pb] = MFMA16(af, lds_tr8(L + bo + SB_XW + (32 * ks) * SP_X + (16 * pb) * 2, SP_X, lane), sacc[pb]); } } \
        __syncthreads();                                                       \
        { const float eat = __expf(atc); \
        _Pragma("unroll") for (int pbi = 0; pbi < 2; ++pbi) { const int pb = 2 * half + pbi; f32x4 yd = (f32x4){0.f, 0.f, 0.f, 0.f}; \
            _Pragma("unroll") for (int ks = 0; ks < 2; ++ks) yd = MFMA16(lds_tr8(L + bo + SB_XD + (32 * ks) * SP_X + (16 * pb) * 2, SP_X, lane), lds_b128(L + S_SC + (16 * tb + fr) * SP_X + (32 * ks + 8 * fg) * 2), yd); \
            u2v yo; yo.x = pk2(yd[0] + eat * yoff[pbi][0], yd[1] + eat * yoff[pbi][1]); yo.y = pk2(yd[2] + eat * yoff[pbi][2], yd[3] + eat * yoff[pbi][3]); \
            *(u2v*)(YS + SSD_TOK(c, tlc) * 256 + h * 64 + 16 * pb + 4 * fg) = yo; } } \
        _Pragma("unroll") for (int pb = 0; pb < 4; ++pb) { u2v o; o.x = pk2(sacc[pb][0], sacc[pb][1]); o.y = pk2(sacc[pb][2], sacc[pb][3]); \
            *(LAS u2v*)(L + S_SBF + (16 * pb + fr) * SP_C + (16 * w + 4 * fg) * 2) = o; } \
        if ((c) + 1 < 32) { dtv = pdt##NS; acum = wave_incl_sum(pdt##NS * A, lane); alast = __shfl(acum, 63); SSD_STAGE((((c) + 1) & 1) * SB_SIZE, dtv, acum, alast, NS); } } while (0)
    SSD_LOAD(0, 0);
    float dtv = pdt0, acum = wave_incl_sum(pdt0 * A, lane), alast = __shfl(acum, 63);
    SSD_STAGE(0, dtv, acum, alast, 0);
    SSD_LOAD(1, 1);
    for (int c2 = 0; c2 < 32; c2 += 2) { SSD_CHUNK(c2, 0, 1); SSD_CHUNK(c2 + 1, 1, 0); }
    __syncthreads();
#undef SSD_CHUNK
#undef SSD_LOAD
#undef SSD_STAGE
#undef SSD_TOK
}
constexpr int MB_QS = 0, MB_KS = 9216, MB_KW = 18432, MB_VS = 27648, MB_SIZE = 36864, M_SC = 73728, M_CBF = 82944, M_NBF = 92160;
__device__ __forceinline__ void ml_item(Ctx& F, int l, int it) {
    const int b = it >> 3, dir = (it >> 2) & 1, h = it & 3;
    const int tid = F.tid, lane = F.lane, w = F.wave, fr = lane & 15, fg = lane >> 4, tb = w >> 1, half = w & 1;
    const bf16* U = (const bf16*)(F.ws + WS_U);
    bf16* MLH = (bf16*)(F.ws + WS_MLH) + (size_t)dir * MTOK * 256;
    const float ib = INP(13)[l * 8 + dir * 4 + h], fb = INP(14)[l * 8 + dir * 4 + h];
    LAS unsigned char* L = F.lds;
#define ML_TOK(c, tau) ((size_t)b * SEQ + (dir ? SEQ - 1 - ((c) * 64 + (tau)) : (c) * 64 + (tau)))
    f32x4 cacc[2], nacc = (f32x4){0.f, 0.f, 0.f, 0.f};
    cacc[0] = (f32x4){0.f, 0.f, 0.f, 0.f}; cacc[1] = (f32x4){0.f, 0.f, 0.f, 0.f};
    for (int i = tid; i < (M_NBF + 256 - M_CBF) / 16; i += NTHR) *(LAS v4u*)(L + M_CBF + 16 * i) = (v4u){0u, 0u, 0u, 0u};
    bf16x8 ones;
#pragma unroll
    for (int j = 0; j < 8; ++j) ones[j] = (short)0x3F80;
    v4u pq0, pk0, pv0, pq1, pk1, pv1; float pli0, plf0, pli1, plf1;
#define ML_LOAD(c, S) do { \
        { const int tau = tid >> 3, ch = tid & 7; const bf16* rp = U + ML_TOK(c, tau) * UL + h * 64 + 8 * ch; pq##S = *(const v4u*)(rp + C_MQ); pk##S = *(const v4u*)(rp + C_MK); pv##S = *(const v4u*)(rp + C_MV); } \
        { const bf16* gp = U + ML_TOK(c, lane) * UL + C_G + dir * 4 + h; pli##S = bf2f(gp[8]) + ib; plf##S = -softplus_f(-(bf2f(gp[16]) + fb)); } } while (0)
#define ML_STAGE(bo, av, Mlast, S) do { const int tau = tid >> 3, ch = tid & 7; const float ks = 0.125f * __expf(__shfl(av, tau) - (Mlast)); v4u ow; \
        _Pragma("unroll") for (int e = 0; e < 4; ++e) ow[e] = pk2(bflo(pk##S[e]) * ks, bfhi(pk##S[e]) * ks); \
        *(LAS v4u*)(L + (bo) + MB_QS + tau * SP_X + ch * 16) = pq##S; *(LAS v4u*)(L + (bo) + MB_KS + tau * SP_X + ch * 16) = pk##S; \
        *(LAS v4u*)(L + (bo) + MB_KW + tau * SP_X + ch * 16) = ow; *(LAS v4u*)(L + (bo) + MB_VS + tau * SP_X + ch * 16) = pv##S; } while (0)
#define ML_CHUNK(c, CS, NS) do { \
        const int bo = ((c) & 1) * MB_SIZE; \
        __syncthreads();                                                       \
        if ((c) + 2 < 32) ML_LOAD((c) + 2, CS); \
        bf16x8 qa[2]; \
        _Pragma("unroll") for (int ks = 0; ks < 2; ++ks) qa[ks] = lds_b128(L + bo + MB_QS + (16 * tb + fr) * SP_X + (32 * ks + 8 * fg) * 2); \
        f32x4 yint[2], dint = (f32x4){0.f, 0.f, 0.f, 0.f};                     \
        _Pragma("unroll") for (int ebi = 0; ebi < 2; ++ebi) { yint[ebi] = (f32x4){0.f, 0.f, 0.f, 0.f}; \
            _Pragma("unroll") for (int ks = 0; ks < 2; ++ks) yint[ebi] = MFMA16(lds_b128(L + M_CBF + (16 * (2 * half + ebi) + fr) * SP_X + (32 * ks + 8 * fg) * 2), qa[ks], yint[ebi]); } \
        _Pragma("unroll") for (int ks = 0; ks < 2; ++ks) dint = MFMA16(lds_b128(L + M_NBF + (32 * ks + 8 * fg) * 2), qa[ks], dint); \
        const int tlc = 16 * tb + fr; const float Mtc = __shfl(Mv, tlc), btc = __shfl(bcum, tlc); \
        _Pragma("unroll") for (int sbi = 0; sbi < 2; ++sbi) { const int sb = 2 * half + sbi; f32x4 g = (f32x4){0.f, 0.f, 0.f, 0.f}; \
            if (sb <= tb) { \
                _Pragma("unroll") for (int ks = 0; ks < 2; ++ks) g = MFMA16(lds_b128(L + bo + MB_KS + (16 * sb + fr) * SP_X + (32 * ks + 8 * fg) * 2), qa[ks], g); } \
            float sv[4]; \
            _Pragma("unroll") for (int r = 0; r < 4; ++r) { const int sl = 16 * sb + 4 * fg + r; const float as_ = __shfl(av, sl); \
                sv[r] = sl <= tlc ? g[r] * 0.125f * __expf(as_ - Mtc) : 0.f; } \
            u2v so; so.x = pk2(sv[0], sv[1]); so.y = pk2(sv[2], sv[3]); *(LAS u2v*)(L + M_SC + tlc * SP_X + (16 * sb + 4 * fg) * 2) = so; } \
        { const float dec = __expf(mprev - Mlast); \
          cacc[0] *= dec; cacc[1] *= dec; nacc *= dec; \
          _Pragma("unroll") for (int ks = 0; ks < 2; ++ks) { const bf16x8 af = lds_tr8(L + bo + MB_KW + (32 * ks) * SP_X + (16 * tb) * 2, SP_X, lane); \
              nacc = MFMA16(af, ones, nacc); \
              _Pragma("unroll") for (int ebi = 0; ebi < 2; ++ebi) cacc[ebi] = MFMA16(af, lds_tr8(L + bo + MB_VS + (32 * ks) * SP_X + (16 * (2 * half + ebi)) * 2, SP_X, lane), cacc[ebi]); } } \
        __syncthreads();                                                       \
        { f32x4 dintra = (f32x4){0.f, 0.f, 0.f, 0.f}; bf16x8 sa[2]; \
          _Pragma("unroll") for (int ks = 0; ks < 2; ++ks) { sa[ks] = lds_b128(L + M_SC + (16 * tb + fr) * SP_X + (32 * ks + 8 * fg) * 2); dintra = MFMA16(ones, sa[ks], dintra); } \
          const float wi = __expf(mprev - Mtc), den = wi * dint[0] + dintra[0], dn = __builtin_amdgcn_rcpf(fmaxf(fabsf(den), __expf(-(btc + Mtc)))); \
          _Pragma("unroll") for (int ebi = 0; ebi < 2; ++ebi) { const int eb = 2 * half + ebi; f32x4 yd = (f32x4){0.f, 0.f, 0.f, 0.f}; \
              _Pragma("unroll") for (int ks = 0; ks < 2; ++ks) yd = MFMA16(lds_tr8(L + bo + MB_VS + (32 * ks) * SP_X + (16 * eb) * 2, SP_X, lane), sa[ks], yd); \
              u2v ho; ho.x = pk2((wi * yint[ebi][0] + yd[0]) * dn, (wi * yint[ebi][1] + yd[1]) * dn); ho.y = pk2((wi * yint[ebi][2] + yd[2]) * dn, (wi * yint[ebi][3] + yd[3]) * dn); \
              *(u2v*)(MLH + ML_TOK(c, tlc) * 256 + h * 64 + 16 * eb + 4 * fg) = ho; } } \
        _Pragma("unroll") for (int ebi = 0; ebi < 2; ++ebi) { u2v o; o.x = pk2(cacc[ebi][0], cacc[ebi][1]); o.y = pk2(cacc[ebi][2], cacc[ebi][3]); \
            *(LAS u2v*)(L + M_CBF + (16 * (2 * half + ebi) + fr) * SP_X + (16 * tb + 4 * fg) * 2) = o; } \
        if (half == 0 && fr == 0) { u2v o; o.x = pk2(nacc[0], nacc[1]); o.y = pk2(nacc[2], nacc[3]); *(LAS u2v*)(L + M_NBF + (16 * tb + 4 * fg) * 2) = o; } \
        mprev = blast + Mlast; \
        if ((c) + 1 < 32) { bcum = wave_incl_sum(plf##NS, lane); av = pli##NS - bcum; Mv = fmaxf(mprev, wave_incl_max(av, lane)); Mlast = __shfl(Mv, 63); blast = __shfl(bcum, 63); \
            ML_STAGE((((c) + 1) & 1) * MB_SIZE, av, Mlast, NS); } } while (0)
    float mprev = 0.f;
    ML_LOAD(0, 0);
    float bcum = wave_incl_sum(plf0, lane), av = pli0 - bcum, Mv = fmaxf(mprev, wave_incl_max(av, lane)), Mlast = __shfl(Mv, 63), blast = __shfl(bcum, 63);
    ML_STAGE(0, av, Mlast, 0);
    ML_LOAD(1, 1);
    for (int c2 = 0; c2 < 32; c2 += 2) { ML_CHUNK(c2, 0, 1); ML_CHUNK(c2 + 1, 1, 0); }
    __syncthreads();
#undef ML_CHUNK
#undef ML_LOAD
#undef ML_STAGE
#undef ML_TOK
}
constexpr int NA_K_OFF = 0, NA_V_OFF = 65536, NA_VP = 1040, NA_RPB_OFF = 65536 + 64 * 1040;
__device__ __forceinline__ int na_swz(int tk) { return (tk & 3) | (((tk >> 3) & 1) << 2); }
__device__ __forceinline__ void na_block_item(Ctx& F, int l, int it) {
    const int r = it & 31, h = (it >> 5) & 3, b = it >> 7;
    const int tid = fresh_tid(F.wave0), lane = tid & 63, w = F.wave0, fr = lane & 15, fg = lane >> 4;
    LAS unsigned char* L = F.lds;
    const bf16* U = (const bf16*)(F.ws + WS_U); const bf16* VT = (const bf16*)(F.ws + WS_UHT) + (size_t)(R_NV + h * 64) * TP; bf16* NAO = (bf16*)(F.ws + WS_NAO);
    const int rs = min(max(r - 4, 0), 24);
    const size_t tb0 = (size_t)b * SEQ;
    __syncthreads();
    { v4u kv[8], vv[8];
#pragma unroll
      for (int k = 0; k < 8; ++k) { const int id = tid + 512 * k, tk = id >> 3, ch = id & 7; kv[k] = *(const v4u*)(U + (tb0 + rs * 64 + tk) * UL + C_NK + h * 64 + 8 * ch); }
#pragma unroll
      for (int k = 0; k < 8; ++k) { const int id = tid + 512 * k, d = id >> 6, sg = id & 63; vv[k] = *(const v4u*)(VT + (size_t)d * TP + tb0 + rs * 64 + 8 * sg); }
#pragma unroll
      for (int k = 0; k < 8; ++k) { const int id = tid + 512 * k, tk = id >> 3, ch = id & 7; *(LAS v4u*)(L + NA_K_OFF + tk * 128 + ((ch ^ na_swz(tk)) << 4)) = kv[k]; }
#pragma unroll
      for (int k = 0; k < 8; ++k) { const int id = tid + 512 * k, d = id >> 6, sg = id & 63; *(LAS v4u*)(L + NA_V_OFF + d * NA_VP + sg * 16) = vv[k]; } }
    __syncthreads();
    if (w < 4) {
        const int jb = w;
        const LAS float* rpb = (const LAS float*)(L + NA_RPB_OFF) + h * 15 * 31;
        const int ks0 = min(max(16 * jb - 8, 0), 32);
        const int jq = 16 * jb + fr, cs = min(max(jq - 8, 0), 48);
        bf16x8 qb[2];
        { const bf16* qp = U + (tb0 + r * 64 + jq) * UL + C_NQ + h * 64 + 8 * fg; qb[0] = *(const bf16x8*)qp; qb[1] = *(const bf16x8*)(qp + 32); }
        const int kcl = ks0 + 8 * (fr >> 2) + (fr & 3);
        float sc[16][4];
#pragma unroll
        for (int T = 0; T < 16; ++T) { const int krow = rs + (T >> 1), tk = (T >> 1) * 64 + kcl + 4 * (T & 1), sw = na_swz(tk);
            const bf16x8 k0 = lds_b128(L + NA_K_OFF + tk * 128 + ((fg ^ sw) << 4)), k1 = lds_b128(L + NA_K_OFF + tk * 128 + (((4 + fg) ^ sw) << 4));
            f32x4 s = (f32x4){0.f, 0.f, 0.f, 0.f}; s = MFMA16(k0, qb[0], s); s = MFMA16(k1, qb[1], s);
#pragma unroll
            for (int e = 0; e < 4; ++e) { const int kc = ks0 + 8 * fg + 4 * (T & 1) + e; const bool valid = kc >= cs && kc < cs + 16;
                const int dc = min(max(kc - jq + 15, 0), 30);
                sc[T][e] = valid ? s[e] * 0.125f + rpb[(krow - r + 7) * 31 + dc] : -1e30f; } }
        float mx = -1e30f;
#pragma unroll
        for (int T = 0; T < 16; ++T)
#pragma unroll
            for (int e = 0; e < 4; ++e) mx = fmaxf(mx, sc[T][e]);
        mx = fmaxf(mx, __shfl_xor(mx, 16)); mx = fmaxf(mx, __shfl_xor(mx, 32));
        float sum = 0.f;
#pragma unroll
        for (int T = 0; T < 16; ++T)
#pragma unroll
            for (int e = 0; e < 4; ++e) { sc[T][e] = __expf(sc[T][e] - mx); sum += sc[T][e]; }
        sum += __shfl_xor(sum, 16); sum += __shfl_xor(sum, 32);
        f32x4 oacc[4];
#pragma unroll
        for (int d = 0; d < 4; ++d) oacc[d] = (f32x4){0.f, 0.f, 0.f, 0.f};
#pragma unroll
        for (int ks = 0; ks < 8; ++ks) {
            bf16x8 pa; { v4u pw; pw[0] = pk2(sc[2 * ks][0], sc[2 * ks][1]); pw[1] = pk2(sc[2 * ks][2], sc[2 * ks][3]); pw[2] = pk2(sc[2 * ks + 1][0], sc[2 * ks + 1][1]); pw[3] = pk2(sc[2 * ks + 1][2], sc[2 * ks + 1][3]); pa = __builtin_bit_cast(bf16x8, pw); }
#pragma unroll
            for (int d = 0; d < 4; ++d) oacc[d] = MFMA16(pa, lds_b128(L + NA_V_OFF + (16 * d + fr) * NA_VP + (ks * 64 + ks0 + 8 * fg) * 2), oacc[d]); }
#pragma unroll
        for (int e = 0; e < 4; ++e) { const int q = 4 * fg + e; const float inv = __builtin_amdgcn_rcpf(__shfl(sum, q));
            bf16* op = NAO + (tb0 + r * 64 + 16 * jb + q) * 256 + h * 64 + fr;
#pragma unroll
            for (int d = 0; d < 4; ++d) op[16 * d] = (bf16)f2bf(oacc[d][e] * inv); }
    }
}
constexpr int HY_CP = 8224, HY_ZP = 4112, HY_ZB = 8 * HY_CP;
__device__ __forceinline__ void hy_load_row(const bf16* R, int tid, v4u& cur, v4u& prev) {
    cur = *(const v4u*)(R + 8 * tid); prev = *(const v4u*)(R + 8 * tid - 8);
}
__device__ __forceinline__ void hy_write_copies(LAS unsigned char* L, int tid, const v4u cur, v4u prev) {
    if (tid == 0) prev = (v4u){0u, 0u, 0u, 0u};
    unsigned wd[9] = {prev[0], prev[1], prev[2], prev[3], cur[0], cur[1], cur[2], cur[3], 0u};
#pragma unroll
    for (int rho = 0; rho < 8; ++rho) { const int wo = (8 - rho) >> 1; v4u o;
        if ((rho & 1) == 0) { o[0] = wd[wo]; o[1] = wd[wo + 1]; o[2] = wd[wo + 2]; o[3] = wd[wo + 3]; }
        else {
#pragma unroll
            for (int j = 0; j < 4; ++j) o[j] = (wd[wo + j] >> 16) | (wd[wo + j + 1] << 16); }
        *(LAS v4u*)(L + rho * HY_CP + 16 * tid) = o; }
}
__device__ __forceinline__ float hy_gate4(const bf16* grow, int tok, int t, float w0, float w1, float w2, float bias, float* out4) {
    const u2v c4 = *(const u2v*)(grow + tok); const float lf = t > 0 ? bf2f(grow[tok - 1]) : 0.f, rt = t + 4 < SEQ ? bf2f(grow[tok + 4]) : 0.f;
    const float v0 = bflo(c4.x), v1 = bfhi(c4.x), v2 = bflo(c4.y), v3 = bfhi(c4.y);
    out4[0] = w0 * lf + w1 * v0 + w2 * v1 + bias; out4[1] = w0 * v0 + w1 * v1 + w2 * v2 + bias; out4[2] = w0 * v1 + w1 * v2 + w2 * v3 + bias; out4[3] = w0 * v2 + w1 * v3 + w2 * rt + bias;
    return 0.f;
}
__device__ __forceinline__ void hy_item(Ctx& F, int l, int c) {
    LAS unsigned char* L = F.lds;
    const bf16* UHT = (const bf16*)(F.ws + WS_UHT); bf16* HYO = (bf16*)(F.ws + WS_HYO);
    const float* cw = INP(16) + l * 3 * 768; const float* cb = INP(17) + l * 768; const float* skip = INP(24) + l * 512;
    const int tid = fresh_tid(F.wave0), lane = tid & 63, w = F.wave0, fr = lane & 15, fg = lane >> 4;
    const bf16* FR = (const bf16*)(F.ws + WS_FILT) + (size_t)(l * 2 * 256 + c) * 4096;
    { v4u fc, fp; hy_load_row(FR, tid, fc, fp); hy_write_copies(L, tid, fc, fp); }
    { const float w0 = cw[c], w1 = cw[768 + c], w2 = cw[1536 + c], bias = cb[c]; const bf16* row = UHT + (size_t)c * TP;
      v4u cv[8]; unsigned nb[8];
#pragma unroll
      for (int k = 0; k < 8; ++k) { const int u = tid + 512 * k, b = u >> 8, t0 = (u & 255) * 8, tok = b * SEQ + t0;
          cv[k] = *(const v4u*)(row + tok); nb[k] = (unsigned)row[tok - 1] | ((unsigned)row[tok + 8] << 16); }
#pragma unroll
      for (int k = 0; k < 8; ++k) asm volatile("" : "+v"(nb[k]));
#pragma unroll
      for (int k = 0; k < 8; ++k) { const int u = tid + 512 * k, b = u >> 8, t0 = (u & 255) * 8;
          const float lf = t0 > 0 ? bflo(nb[k]) : 0.f, rt = t0 + 8 < SEQ ? bfhi(nb[k]) : 0.f;
          float x[10]; x[0] = lf; x[9] = rt;
#pragma unroll
          for (int e = 0; e < 4; ++e) { x[1 + 2 * e] = bflo(cv[k][e]); x[2 + 2 * e] = bfhi(cv[k][e]); }
          v4u o;
#pragma unroll
          for (int e = 0; e < 4; ++e) o[e] = pk2(w0 * x[2 * e] + w1 * x[2 * e + 1] + w2 * x[2 * e + 2] + bias, w0 * x[2 * e + 1] + w1 * x[2 * e + 2] + w2 * x[2 * e + 3] + bias);
          *(LAS v4u*)(L + HY_ZB + b * HY_ZP + t0 * 2) = o; } }
    __syncthreads();
    const int abase = (fr & 7) * HY_CP + 4096 + 16 * (fg - (fr >> 3)) - 32 * 16 * w;
    const int bbase = HY_ZB + fr * HY_ZP + 16 * fg;
    for (int o = 0; o < 2; ++o) {
        const int gc = 256 * (o + 1) + c; const bf16* grow = UHT + (size_t)gc * TP;
        u2v gcv[16]; v4u fc, fp;
#pragma unroll
        for (int ii = 0; ii < 8; ++ii) { const int t = 16 * (16 * w + ii) + 4 * fg, tok = fr * SEQ + t; gcv[ii] = *(const u2v*)(grow + tok); }
        const unsigned edgeL = grow[fr * SEQ + 256 * w - 1], edgeR = grow[fr * SEQ + 256 * w + 256];
        f32x4 acc[16];
#pragma unroll
        for (int i = 0; i < 16; ++i) acc[i] = (f32x4){0.f, 0.f, 0.f, 0.f};
        bf16x8 af[16];
#pragma unroll
        for (int m = 2; m <= 15; ++m) af[(16 - m) & 15] = lds_b128(L + abase - 32 * m);
        for (int j0 = 0; j0 < 64; j0 += 8) {
#pragma unroll
            for (int jj = 0; jj < 8; ++jj) { const int j = j0 + jj;
                af[(2 * jj) & 15] = lds_b128(L + abase + 64 * j); af[(2 * jj + 15) & 15] = lds_b128(L + abase + 64 * j - 32);
                const bf16x8 bfr = lds_b128(L + bbase + 64 * j);
#pragma unroll
                for (int ii = 0; ii < 16; ++ii) acc[ii] = MFMA16(af[(2 * jj - ii + 16) & 15], bfr, acc[ii]); }
        }
        __syncthreads();
        if (o == 0) hy_load_row(FR + (size_t)256 * 4096, tid, fc, fp);
        const float w0 = cw[gc], w1 = cw[768 + gc], w2 = cw[1536 + gc], bias = cb[gc];
        const float sk = skip[o * 256 + c];
#pragma unroll
        for (int ii = 8; ii < 16; ++ii) { const int t = 16 * (16 * w + ii) + 4 * fg, tok = fr * SEQ + t; gcv[ii] = *(const u2v*)(grow + tok); }
        unsigned gnb[16];
        { const int srcL = fg > 0 ? lane - 16 : lane + 48, srcR = fg < 3 ? lane + 16 : lane - 48;
#pragma unroll
          for (int ii = 0; ii < 16; ++ii) {
              const unsigned sendL = (fg == 3 && ii > 0) ? gcv[ii > 0 ? ii - 1 : 0].y : gcv[ii].y;
              const unsigned sendR = (fg == 0 && ii < 15) ? gcv[ii < 15 ? ii + 1 : 15].x : gcv[ii].x;
              unsigned gl = (unsigned)__shfl((int)sendL, srcL) >> 16, gr = (unsigned)__shfl((int)sendR, srcR) & 0xffffu;
              if (ii == 0 && fg == 0) gl = edgeL; if (ii == 15 && fg == 3) gr = edgeR;
              gnb[ii] = gl | (gr << 16); } }
        if (o == 0) hy_write_copies(L, tid, fc, fp);
#pragma unroll
        for (int ii = 0; ii < 16; ++ii) { const int t = 16 * (16 * w + ii) + 4 * fg, tok = fr * SEQ + t;
            const float lf = t > 0 ? bflo(gnb[ii]) : 0.f, rt = t + 4 < SEQ ? bfhi(gnb[ii]) : 0.f, v0 = bflo(gcv[ii].x), v1 = bfhi(gcv[ii].x), v2 = bflo(gcv[ii].y), v3 = bfhi(gcv[ii].y);
            const float xg0 = w0 * lf + w1 * v0 + w2 * v1 + bias, xg1 = w0 * v0 + w1 * v1 + w2 * v2 + bias, xg2 = w0 * v1 + w1 * v2 + w2 * v3 + bias, xg3 = w0 * v2 + w1 * v3 + w2 * rt + bias;
            LAS u2v* zp = (LAS u2v*)(L + HY_ZB + fr * HY_ZP + t * 2); const u2v zo = *zp;
            const float z0 = xg0 * (acc[ii][0] + sk * bflo(zo.x)), z1 = xg1 * (acc[ii][1] + sk * bfhi(zo.x)), z2 = xg2 * (acc[ii][2] + sk * bflo(zo.y)), z3 = xg3 * (acc[ii][3] + sk * bfhi(zo.y));
            u2v zn; zn.x = pk2(z0, z1); zn.y = pk2(z2, z3);
            if (o == 0) *zp = zn; else *(u2v*)(HYO + (size_t)c * TP + tok) = zn; }
        __syncthreads();
    }
}
#ifndef MIXREP
#define MIXREP 0
#endif
__device__ __forceinline__ void ph_mixers(Ctx& F, int l, int rep) {
    for (int q_ = 0; q_ < ((MIXREP & 1) ? 2 : 1); ++q_)
    for (int it = F.bid; it < 256; it += F.G) { if (it < 128) ssd_item(F, l, it); else ml_item(F, l, it - 128); }
    F.tid = fresh_tid(F.wave0); F.lane = F.tid & 63; F.wave = F.wave0;
    for (int i = F.tid; i < 4 * 15 * 31; i += NTHR) ((LAS float*)(F.lds + NA_RPB_OFF))[i] = INP(11)[(size_t)l * 4 * 15 * 31 + i];
    volatile LAS int* slot = (volatile LAS int*)(F.lds + MISC_OFF);
    unsigned* ctr = (unsigned*)(F.ws + WS_CTL) + 64 * (1 + l + 2 * rep);
    for (;;) {
        __syncthreads();
        if (F.tid == 0) slot[0] = (int)atomicAdd(ctr, 1u);
        __syncthreads();
        const int it = slot[0];
        if (it >= 256 + 2048) break;
        if (it < 256) { hy_item(F, l, it); if (MIXREP & 2) hy_item(F, l, it); }
        else na_block_item(F, l, it - 256);
    }
}

__device__ __forceinline__ void ph_finalize(Ctx& F, int l) {
    const int lane = F.lane, c0 = lane * 4, tid = F.tid;
    const bf16* U = (const bf16*)(F.ws + WS_U); const bf16* YS = (const bf16*)(F.ws + WS_YS); const bf16* NAO = (const bf16*)(F.ws + WS_NAO);
    const bf16* MLH = (const bf16*)(F.ws + WS_MLH); const bf16* HYO = (const bf16*)(F.ws + WS_HYO); bf16* YM = (bf16*)(F.ws + WS_XN);
    const f32x4 gs = *(const f32x4*)(INP(10) + l * 256 + c0), gn = *(const f32x4*)(INP(12) + l * 256 + c0), gm = *(const f32x4*)(INP(15) + l * 256 + c0), gh = *(const f32x4*)(INP(25) + l * 256 + c0);
    constexpr int HP = 144;
    for (int it = F.bid; it < MTOK / 64; it += F.G) {
        const int tok0 = it * 64;
        __syncthreads();
#pragma unroll
        for (int k = 0; k < 4; ++k) { const int u = tid + 512 * k, c = u >> 3, ch = u & 7; *(LAS v4u*)(F.lds + c * HP + ch * 16) = *(const v4u*)(HYO + (size_t)c * TP + tok0 + ch * 8); }
        __syncthreads();
        typedef unsigned u2 __attribute__((ext_vector_type(2)));
#pragma unroll 1
        for (int q0 = 0; q0 < 8; q0 += 8) {
            u2 ys0[8], ys1[8], zz[8], na[8], m0[8], m1[8], og[8]; float hv[8][4];
#pragma unroll
            for (int j = 0; j < 8; ++j) { const int tl = F.wave * 8 + q0 + j; const size_t tok = (size_t)(tok0 + tl);
                ys0[j] = *(const u2*)(YS + tok * 256 + c0); ys1[j] = *(const u2*)(YS + (MTOK + tok) * 256 + c0); zz[j] = *(const u2*)(U + tok * UL + C_SZ + c0);
                na[j] = *(const u2*)(NAO + tok * 256 + c0); m0[j] = *(const u2*)(MLH + tok * 256 + c0); m1[j] = *(const u2*)(MLH + (MTOK + tok) * 256 + c0); og[j] = *(const u2*)(U + tok * UL + C_MO + c0);
                const LAS bf16* hp = (const LAS bf16*)(F.lds + c0 * HP + tl * 2); hv[j][0] = bf2f(hp[0]); hv[j][1] = bf2f(hp[HP / 2]); hv[j][2] = bf2f(hp[HP]); hv[j][3] = bf2f(hp[3 * HP / 2]); }
#pragma unroll
            for (int j = 0; j < 8; ++j) { const size_t tok = (size_t)(tok0 + F.wave * 8 + q0 + j); bf16* yo = YM + tok * DM + c0;
                { const float v0 = (bflo(ys0[j].x) + bflo(ys1[j].x)) * silu_ff(bflo(zz[j].x)), v1 = (bfhi(ys0[j].x) + bfhi(ys1[j].x)) * silu_ff(bfhi(zz[j].x)), v2 = (bflo(ys0[j].y) + bflo(ys1[j].y)) * silu_ff(bflo(zz[j].y)), v3 = (bfhi(ys0[j].y) + bfhi(ys1[j].y)) * silu_ff(bfhi(zz[j].y));
                  const float rs = __builtin_amdgcn_rsqf(wave_sum(v0 * v0 + v1 * v1 + v2 * v2 + v3 * v3) * (1.f / 256.f) + EPS);
                  u2 o; o.x = pk2(v0 * rs * gs.x, v1 * rs * gs.y); o.y = pk2(v2 * rs * gs.z, v3 * rs * gs.w); *(u2*)yo = o; }
                { const float v0 = bflo(na[j].x), v1 = bfhi(na[j].x), v2 = bflo(na[j].y), v3 = bfhi(na[j].y);
                  const float rs = __builtin_amdgcn_rsqf(wave_sum(v0 * v0 + v1 * v1 + v2 * v2 + v3 * v3) * (1.f / 256.f) + EPS);
                  u2 o; o.x = pk2(v0 * rs * gn.x, v1 * rs * gn.y); o.y = pk2(v2 * rs * gn.z, v3 * rs * gn.w); *(u2*)(yo + 256) = o; }
                { const float v0 = bflo(m0[j].x) + bflo(m1[j].x), v1 = bfhi(m0[j].x) + bfhi(m1[j].x), v2 = bflo(m0[j].y) + bflo(m1[j].y), v3 = bfhi(m0[j].y) + bfhi(m1[j].y);
                  float ss = v0 * v0 + v1 * v1 + v2 * v2 + v3 * v3;
                  ss = row_sum16(ss);
                  const float rs = __builtin_amdgcn_rsqf(ss * (1.f / 64.f) + EPS);
                  u2 o; o.x = pk2(v0 * rs * gm.x * sigmoid_f(bflo(og[j].x)), v1 * rs * gm.y * sigmoid_f(bfhi(og[j].x))); o.y = pk2(v2 * rs * gm.z * sigmoid_f(bflo(og[j].y)), v3 * rs * gm.w * sigmoid_f(bfhi(og[j].y)));
                  *(u2*)(yo + 512) = o; }
                { const float v0 = hv[j][0], v1 = hv[j][1], v2 = hv[j][2], v3 = hv[j][3];
                  const float rs = __builtin_amdgcn_rsqf(wave_sum(v0 * v0 + v1 * v1 + v2 * v2 + v3 * v3) * (1.f / 256.f) + EPS);
                  u2 o; o.x = pk2(v0 * rs * gh.x, v1 * rs * gh.y); o.y = pk2(v2 * rs * gh.z, v3 * rs * gh.w); *(u2*)(yo + 768) = o; }
            }
        }
    }
}

#define XB_TMO      128
#define XB_XCNT(j)  (256  + 64 * (j))
#define XB_XSUB(j)  (1280 + 64 * (j))
#define XB_XGEN(j)  (2304 + 64 * (j))
#define XB_TOP      3328
#define XB_TOPGEN   3392
#define XCD_BAR_WORDS 3456
#define XB_SPIN_CAP (1u << 18)

__device__ __forceinline__ unsigned xb_ld(unsigned* p)              { return __hip_atomic_load(p, __ATOMIC_RELAXED, __HIP_MEMORY_SCOPE_AGENT); }
__device__ __forceinline__ unsigned xb_add(unsigned* p, unsigned v) { return __hip_atomic_fetch_add(p, v, __ATOMIC_RELAXED, __HIP_MEMORY_SCOPE_AGENT); }
__device__ __forceinline__ unsigned xb_xcc_id() { return (unsigned)__builtin_amdgcn_s_getreg((3 << 11) | 20) & 0xFu; }
#define XB_SPIN(cond, bar) do { unsigned _sp = 0; while (cond) { __builtin_amdgcn_s_sleep(1); \
    if ((++_sp & 255u) == 0u) { if (xb_ld(&(bar)[XB_TMO])) break; if (_sp > XB_SPIN_CAP) { atomicAdd(&(bar)[XB_TMO], 1u); break; } } } } while (0)

struct XcdBarrier {
    unsigned* bar; unsigned x;
    volatile LAS unsigned* st;
};

__device__ __forceinline__ XcdBarrier xcd_barrier_post(unsigned* bar, volatile LAS unsigned* st) {
    XcdBarrier b; b.bar = bar; b.x = xb_xcc_id(); b.st = st;
    if (threadIdx.x == 0) (void)xb_add(&bar[XB_XCNT(b.x)], 1u);
    return b;
}
__device__ __forceinline__ void xcd_barrier_complete(unsigned* bar, unsigned x, unsigned& nloc, unsigned& nx) {
    const unsigned G = gridDim.x * gridDim.y * gridDim.z;
    unsigned sum, cnt, mine, sp = 0u;
    for (;;) {
        sum = 0u; cnt = 0u; mine = 0u;
#pragma unroll
        for (unsigned j = 0; j < 16; ++j) { const unsigned c = xb_ld(&bar[XB_XCNT(j)]); sum += c; cnt += (c > 0u) ? 1u : 0u; mine = (j == x) ? c : mine; }
        if (sum == G) break;
        __builtin_amdgcn_s_sleep(1);
        if ((++sp & 255u) == 0u) { if (xb_ld(&bar[XB_TMO])) break; if (sp > XB_SPIN_CAP) { atomicAdd(&bar[XB_TMO], 1u); break; } }
    }
    nloc = mine > 0u ? mine : 1u; nx = cnt > 0u ? cnt : 1u;
}

__device__ __forceinline__ void xcd_barrier(const XcdBarrier& b, const bool leader) {
    asm volatile("s_waitcnt vmcnt(0)" ::: "memory");
    __syncthreads();
    if (leader) {
        unsigned* bar = b.bar;
        __builtin_amdgcn_s_waitcnt(0);
        unsigned nloc = b.st[0], nx = b.st[1];
        if (nloc == 0u) { xcd_barrier_complete(bar, b.x, nloc, nx); b.st[0] = nloc; b.st[1] = nx; }
        const unsigned old = xb_add(&bar[XB_XSUB(b.x)], 1u);
        const unsigned gen = old / nloc;
        if (old + 1u == (gen + 1u) * nloc) {
            __builtin_amdgcn_fence(__ATOMIC_RELEASE, "agent");
            asm volatile("s_waitcnt vmcnt(0)" ::: "memory");
            const unsigned og = xb_add(&bar[XB_TOP], 1u);
            const unsigned tg = og / nx;
            if (og + 1u == (tg + 1u) * nx) xb_add(&bar[XB_TOPGEN], 1u);
            else XB_SPIN(xb_ld(&bar[XB_TOPGEN]) == tg, bar);
            __builtin_amdgcn_fence(__ATOMIC_ACQUIRE, "agent");
            xb_add(&bar[XB_XGEN(b.x)], 1u);
            asm volatile("s_waitcnt vmcnt(0)" ::: "memory");
        } else {
            XB_SPIN(xb_ld(&bar[XB_XGEN(b.x)]) == gen, bar);
            __builtin_amdgcn_fence(__ATOMIC_ACQUIRE, "agent");
            asm volatile("s_waitcnt vmcnt(0)" ::: "memory");
        }
    }
    __syncthreads();
}

constexpr int N_PHASES = 2 + 9 * DEPTH;
#ifndef MK_MULTI
#define MK_MULTI 1
#endif
__global__ void __launch_bounds__(NTHR, 2) hybrid_fwd(Args args) {
    extern __shared__ __attribute__((aligned(16))) unsigned char lds_raw[];
    Ctx F;
    F.lds = (LAS unsigned char*)lds_raw; F.tid = threadIdx.x; F.lane = F.tid & 63; F.wave = __builtin_amdgcn_readfirstlane(F.tid >> 6); F.wave0 = F.wave;
    F.bid = blockIdx.x; F.G = gridDim.x; F.out = args.out; F.ws = args.ws; F.A = &args;
#if MK_MULTI
    const int lo = args.ph_lo, hi = args.ph_hi;
#else
    constexpr int lo = 0, hi = N_PHASES;
#endif
#if MK_MULTI
#define SEAM(k) do { } while (0)
#else
    for (int u = F.tid; u < 32; u += NTHR) ((LAS unsigned*)(F.lds + MISC_OFF))[u] = 0u;
    __syncthreads();
    XcdBarrier bar = xcd_barrier_post((unsigned*)(F.ws + WS_CTL) + 4096, (volatile LAS unsigned*)(F.lds + MISC_OFF) + 8);
#define SEAM(k) do { if ((k) + 1 < hi) { XcdBarrier b2_ = bar; asm volatile("" : "+s"(b2_.x)); xcd_barrier(b2_, fresh_tid(F.wave0) == 0); } } while (0)
#endif
#ifndef PHMASK
#define PHMASK 0xFFFFF
#endif
#define FRESH() do { F.tid = fresh_tid(F.wave0); F.lane = F.tid & 63; F.wave = F.wave0; } while (0)
#define IN(k) (((PHMASK >> (k)) & 1) && lo <= (k) && (k) < hi)
#define INL(j) (((PHMASK >> (2 + (j))) & 1) && lo <= (pb + (j)) && (pb + (j)) < hi)
#ifndef REPMASK
#define REPMASK 0
#endif
#define REPS(k) for (int rep_ = 0; rep_ < ((((REPMASK) >> (k)) & 1) ? 2 : 1); ++rep_)
    const float* MOD = (const float*)(F.ws + WS_MOD); float* SS = (float*)(F.ws + WS_SS); const float* CV = (const float*)(F.ws + WS_CV);
    if (IN(0)) { REPS(0) { FRESH(); ph_prologue(F); __syncthreads(); } SEAM(0); }
    if (IN(1)) { REPS(1) { FRESH(); ph_filters(F); FRESH(); ph_cvec(F); FRESH(); ph_xn0(F, MOD); __syncthreads(); } SEAM(1); }
#pragma unroll 1
    for (int l = 0; l < DEPTH; ++l) {
        const int pb = 2 + 9 * l; unsigned char* wb = F.ws + WS_W + (size_t)l * W_LAYER; const float* mod_l = MOD + (size_t)l * NB * 6144; const float* cv_l = CV + (size_t)l * NB * CVP;
        float* ss_in = SS + (size_t)(2 * l) * MTOK; float* ss_ff = SS + (size_t)(2 * l + 1) * MTOK; float* ss_nx = SS + (size_t)(2 * l + 2) * MTOK;
        if (INL(0)) { REPS(2) { FRESH();
            pg8::Gemm g{(const pg8::bf16_t*)(F.ws + WS_XN), (const pg8::bf16_t*)(wb + W_IN_OFF), MTOK, UL, DM};
            pg8::DualOrder S; S.init(MTOK, UL, NTR, MTOK, F.G, F.bid, (const pg8::bf16_t*)(wb + W_HY_OFF), (const pg8::bf16_t*)(F.ws + WS_XN));
            pg8::EpiDualIn E{{(pg8::bf16_t*)(F.ws + WS_U), UL, ss_in, cv_l}, {(pg8::bf16_t*)(F.ws + WS_UHT), TP, ss_in, cv_l + 2816}};
            pg8::gemm_phase<pg8::EpiDualIn, pg8::DualOrder, true, true>(F.lds, g, S, E, F.wave0);
            __syncthreads(); }
            SEAM(pb + 0);
        }
        if (INL(1)) { REPS(3) { FRESH(); ph_prepass(F, l); } SEAM(pb + 1); }
        if (INL(2)) { REPS(4) { FRESH(); ph_mixers(F, l, rep_); } SEAM(pb + 2); }
        if (INL(3)) { REPS(5) { FRESH(); ph_finalize(F, l); } SEAM(pb + 3); }
        if (INL(4)) { FRESH();
            pg8::Gemm g{(const pg8::bf16_t*)(F.ws + WS_XN), (const pg8::bf16_t*)(wb + W_OUT_OFF), MTOK, DM, DM}; pg8::StaticOrder S; S.init(MTOK, DM, F.G, F.bid);
            pg8::EpiResidN E{l == 0 ? INP(0) : (const float*)F.out, F.out, mod_l + 2048, mod_l + 4096, (pg8::bf16_t*)(F.ws + WS_XN2), ss_ff};
            pg8::gemm_phase<pg8::EpiResidN, pg8::StaticOrder, true, true>(F.lds, g, S, E, F.wave0);
            SEAM(pb + 4);
        }
        if (INL(6)) { REPS(8) { FRESH();
            pg8::Gemm g{(const pg8::bf16_t*)(F.ws + WS_XN2), (const pg8::bf16_t*)(wb + W_GU_OFF), MTOK, 2 * FFH, DM}; pg8::StaticOrder S; S.init(MTOK, 2 * FFH, F.G, F.bid);
            pg8::EpiSwigluN E{(pg8::bf16_t*)(F.ws + WS_U), FFH, ss_ff, cv_l + 3840}; pg8::gemm_phase<pg8::EpiSwigluN, pg8::StaticOrder, true, true>(F.lds, g, S, E, F.wave0); __syncthreads(); }
            SEAM(pb + 6);
        }
        if (INL(7)) { FRESH();
            pg8::Gemm g{(const pg8::bf16_t*)(F.ws + WS_U), (const pg8::bf16_t*)(wb + W_DN_OFF), MTOK, DM, FFH}; pg8::StaticOrder S; S.init(MTOK, DM, F.G, F.bid);
            pg8::EpiResidN E{(const float*)F.out, F.out, mod_l + 5120, mod_l + (size_t)NB * 6144 + 1024, l + 1 < DEPTH ? (pg8::bf16_t*)(F.ws + WS_XN) : nullptr, ss_nx};
            pg8::gemm_phase<pg8::EpiResidN, pg8::StaticOrder, true, true>(F.lds, g, S, E, F.wave0);
            SEAM(pb + 7);
        }
        if (INL(8)) { if (l + 1 == DEPTH) { FRESH(); ph_final(F); } }
    }
#undef IN
#undef INL
#undef SEAM
}

extern "C" void kernel_launch(void* const* d_in, const int* in_sizes, int n_in, void* d_out, int out_size, void* d_ws, size_t ws_size, hipStream_t stream) {
    static int grid = 0;
    if (grid == 0) {
        if (n_in != 31 || out_size != MTOK * DM || ws_size < WS_END) { fprintf(stderr, "kernel_launch: unexpected problem shape (n_in %d out %d ws %zu)\n", n_in, out_size, ws_size); grid = -1; return; }
        int dev = 0, cus = 0, per_cu = 0;
        hipGetDevice(&dev); hipDeviceGetAttribute(&cus, hipDeviceAttributeMultiprocessorCount, dev);
        if (hipFuncSetAttribute((const void*)hybrid_fwd, hipFuncAttributeMaxDynamicSharedMemorySize, LDS_BYTES) != hipSuccess) { fprintf(stderr, "kernel_launch: hipFuncSetAttribute failed\n"); grid = -1; return; }
        if (hipOccupancyMaxActiveBlocksPerMultiprocessor(&per_cu, (const void*)hybrid_fwd, NTHR, LDS_BYTES) != hipSuccess || per_cu < 1) { fprintf(stderr, "kernel_launch: occupancy query says %d blocks per CU\n", per_cu); grid = -1; (void)hipGetLastError(); return; }
        grid = cus;
    }
    if (grid < 0) return;
    hipMemsetAsync((char*)d_ws + WS_CTL, 0, CTL_ZERO_BYTES, stream);
    Args a{};
    for (int i = 0; i < 31; ++i) a.in[i] = (const float*)d_in[i];
    a.out = (float*)d_out; a.ws = (unsigned char*)d_ws;
#if MK_MULTI
    for (int p = 0; p < N_PHASES; ++p) { a.ph_lo = p; a.ph_hi = p + 1; hipLaunchKernelGGL(hybrid_fwd, dim3(grid), dim3(NTHR), LDS_BYTES, stream, a); }
#else
    a.ph_lo = 0; a.ph_hi = N_PHASES;
    hipLaunchKernelGGL(hybrid_fwd, dim3(grid), dim3(NTHR), LDS_BYTES, stream, a);
#endif
}
```
